# Optimizing an MI355X kernel written in HIP

```python
import math
import jax
import jax.numpy as jnp
from jax import lax
import numpy as np

D_MODEL = 1024
BATCH = 16
SEQ = 256
DEPTH = 4
DEC_BATCH = 2
DEC_SEQ = 4096
PAST_LEN = 512

GRID_W = 64
N_BRANCH = 3
HY_WIDTH = 256
HY_ORDER = 2
HY_SHORT_K = 3
HY_POS_EMB = 33
HY_POS_BANDS = (HY_POS_EMB - 1) // 2
HY_FILTER_HIDDEN = 64
HY_DECAY_FAST = -math.log(1e-2) / 0.3
HY_DECAY_SLOW = -math.log(1e-2) / 1.5
S5_WIDTH = 256
S5_GROUP = 16
S5_GROUPS = S5_WIDTH // S5_GROUP
S5_STATE = 64
N_HEADS = 8
N_KV_HEADS = 2
Q_PER_KV = N_HEADS // N_KV_HEADS
HEAD_DIM = 64
ATTN_WIDTH = N_HEADS * HEAD_DIM
KV_WIDTH = N_KV_HEADS * HEAD_DIM
WINDOW = 128
BLOCK = 128
ROPE_BASE = 10000.0
FFN_HIDDEN = ((8 * D_MODEL // 3 + 255) // 256) * 256
HY_IN = (HY_ORDER + 1) * HY_WIDTH
GATE_IN = N_BRANCH * D_MODEL
W_IN_COLS = HY_IN + S5_WIDTH + ATTN_WIDTH + 2 * KV_WIDTH + GATE_IN
SPLIT_S5 = HY_IN
SPLIT_Q = SPLIT_S5 + S5_WIDTH
SPLIT_K = SPLIT_Q + ATTN_WIDTH
SPLIT_V = SPLIT_K + KV_WIDTH
SPLIT_G = SPLIT_V + KV_WIDTH
IN_SPLITS = (SPLIT_S5, SPLIT_Q, SPLIT_K, SPLIT_V, SPLIT_G)

F32 = jnp.float32
EPS = 1e-6
NEG_INF = -1e30

kernel_name = 'hybrid_diffusion_trunk_step'


def _rmsnorm(x, g):
    xf = x.astype(F32)
    xf = xf * lax.rsqrt(jnp.mean(xf * xf, axis=-1, keepdims=True) + EPS)
    return (xf * g.astype(F32)).astype(x.dtype)


def _short_conv(u, w, b):
    L = u.shape[1]
    pad = HY_SHORT_K // 2
    up = jnp.pad(u, ((0, 0), (pad, pad), (0, 0)))
    w = w.astype(u.dtype)
    out = b.astype(u.dtype)
    for j in range(HY_SHORT_K):
        out = out + up[:, j:j + L] * w[j]
    return out


def _hyena_filters_fft(L, p):
    t = jnp.linspace(0.0, 1.0, L, dtype=F32)
    w = 2.0 * math.pi * jnp.arange(L, dtype=F32) / L
    bands = jnp.linspace(1e-4, HY_POS_BANDS - 1, HY_POS_BANDS, dtype=F32)
    ang = w[:, None] * bands[None, :]
    feat = jnp.concatenate([t[:, None], jnp.cos(ang), -jnp.sin(ang)], axis=-1)
    freq = p['hy_sin_freq'].astype(F32)
    h = jnp.sin(freq * (feat @ p['hy_pos_w1'].astype(F32) + p['hy_pos_b1'].astype(F32)))
    h = jnp.sin(freq * (h @ p['hy_pos_w2'].astype(F32) + p['hy_pos_b2'].astype(F32)))
    h = h @ p['hy_pos_w3'].astype(F32)
    h = h * jnp.exp(-t[:, None] * jnp.abs(p['hy_decay'].astype(F32)))
    h = h.reshape(L, HY_ORDER, 2, HY_WIDTH)
    h_fwd, h_bwd = h[:, :, 0], h[:, :, 1]
    k2 = jnp.concatenate([h_fwd, jnp.zeros((1, HY_ORDER, HY_WIDTH), F32), jnp.flip(h_bwd[1:], axis=0)], axis=0)
    k2 = k2 / jnp.sum(jnp.abs(k2), axis=0, keepdims=True)
    return jnp.fft.rfft(k2, axis=0)


def _fft_conv(u, kf):
    L = u.shape[1]
    uf = jnp.fft.rfft(u, n=2 * L, axis=1)
    return jnp.fft.irfft(uf * kf[None], n=2 * L, axis=1)[:, :L]


def _hyena(zh, p):
    L = zh.shape[1]
    u = _short_conv(zh, p['hy_conv_w'], p['hy_conv_b']).astype(F32)
    v, *gates = jnp.split(u, HY_ORDER + 1, axis=-1)
    kf = _hyena_filters_fft(L, p)
    skip = p['hy_skip'].astype(F32)
    z = v
    for o, gate in enumerate(gates):
        z = gate * (_fft_conv(z, kf[:, o]) + skip[o] * z)
    return z.astype(zh.dtype)


def _linear_combine(e1, e2):
    a1, b1 = e1
    a2, b2 = e2
    return a1 * a2, a2 * b1 + b2


def _s5(zb, p, h0):
    B, L, _ = zb.shape
    u = zb.astype(F32).reshape(B, L, S5_GROUPS, S5_GROUP)
    uc = u.astype(jnp.complex64)
    y = u * p['s5_skip'].astype(F32).reshape(S5_GROUPS, S5_GROUP)
    finals = []
    for d in range(2):
        lam = lax.complex(p['s5_lam_re'][d].astype(F32), p['s5_lam_im'][d].astype(F32))
        step = jnp.exp(p['s5_log_step'][d].astype(F32))[:, None]
        lam_bar = jnp.exp(lam * step)
        b_mat = lax.complex(p['s5_b_re'][d].astype(F32), p['s5_b_im'][d].astype(F32))
        b_bar = ((lam_bar - 1.0) / lam)[..., None] * b_mat
        bu = jnp.einsum('blgc,gpc->blgp', uc, b_bar)
        reverse = d == 1
        edge = L - 1 if reverse else 0
        if h0 is not None:
            bu = bu.at[:, edge].add(lam_bar * h0[:, d])
        a = jnp.broadcast_to(lam_bar, bu.shape)
        _, hs = lax.associative_scan(_linear_combine, (a, bu), reverse=reverse, axis=1)
        finals.append(hs[:, L - 1 - edge])
        c_mat = lax.complex(p['s5_c_re'][d].astype(F32), p['s5_c_im'][d].astype(F32))
        y = y + jnp.real(jnp.einsum('blgp,gcp->blgc', hs, c_mat))
    y = y.reshape(B, L, S5_WIDTH)
    a_lin, b_gate = jnp.split(y @ p['s5_glu_w'].astype(F32) + p['s5_glu_b'].astype(F32), 2, axis=-1)
    out = a_lin * jax.nn.sigmoid(b_gate)
    return out.astype(zb.dtype), jnp.stack(finals, axis=1)


def _axial_rope(x):
    L = x.shape[1]
    rows = L // GRID_W
    row = jnp.repeat(jnp.arange(rows, dtype=F32), GRID_W)
    col = jnp.tile(jnp.arange(GRID_W, dtype=F32), rows)
    n_freq = HEAD_DIM // 4
    inv = ROPE_BASE ** (-jnp.arange(n_freq, dtype=F32) / n_freq)

    def rot(xp, pos):
        ang = pos[:, None] * inv
        cos = jnp.cos(ang)[None, :, None, :]
        sin = jnp.sin(ang)[None, :, None, :]
        x1, x2 = jnp.split(xp.astype(F32), 2, axis=-1)
        return jnp.concatenate([x1 * cos - x2 * sin, x1 * sin + x2 * cos], axis=-1)

    half = HEAD_DIM // 2
    return jnp.concatenate([rot(x[..., :half], row), rot(x[..., half:], col)], axis=-1).astype(x.dtype)


def _attend(q, k, v, sink, mask):
    s = jnp.einsum('bqgrd,bkgd->bgrqk', q, k).astype(F32) * (HEAD_DIM ** -0.5)
    if mask is not None:
        s = jnp.where(mask, s, NEG_INF)
    sk = jnp.broadcast_to(sink.astype(F32)[None, :, :, None, None], s.shape[:-1] + (1,))
    pr = jax.nn.softmax(jnp.concatenate([s, sk], axis=-1), axis=-1)[..., :-1]
    return jnp.einsum('bgrqk,bkgd->bqgrd', pr.astype(v.dtype), v)


def _context_attention(q, k, v, sink):
    B, L = q.shape[:2]
    nb = L // BLOCK
    qb = q.reshape(B, nb, BLOCK, N_KV_HEADS, Q_PER_KV, HEAD_DIM).swapaxes(0, 1)
    out = lax.map(lambda qi: _attend(qi, k, v, sink, None), qb)
    return out.swapaxes(0, 1).reshape(B, L, ATTN_WIDTH)


def _latent_attention(q, k, v, kc, vc, sink):
    B, L = q.shape[:2]
    nb = L // BLOCK
    span = BLOCK + 2 * WINDOW
    lc = kc.shape[1]
    idx = jnp.arange(nb)[:, None] * BLOCK + jnp.arange(span)[None, :]
    kp = jnp.pad(k, ((0, 0), (WINDOW, WINDOW), (0, 0), (0, 0)))
    vp = jnp.pad(v, ((0, 0), (WINDOW, WINDOW), (0, 0), (0, 0)))
    kw = kp[:, idx].swapaxes(0, 1)
    vw = vp[:, idx].swapaxes(0, 1)
    qpos = jnp.arange(nb)[:, None] * BLOCK + jnp.arange(BLOCK)[None, :]
    kpos = idx - WINDOW
    win = (kpos[:, None, :] >= 0) & (kpos[:, None, :] < L) & (jnp.abs(qpos[:, :, None] - kpos[:, None, :]) <= WINDOW)
    mask = jnp.concatenate([jnp.ones((nb, BLOCK, lc), dtype=bool), win], axis=-1)
    qb = q.reshape(B, nb, BLOCK, N_KV_HEADS, Q_PER_KV, HEAD_DIM).swapaxes(0, 1)

    def one(args):
        qi, kwi, vwi, mi = args
        return _attend(qi, jnp.concatenate([kc, kwi], axis=1), jnp.concatenate([vc, vwi], axis=1), sink, mi)

    out = lax.map(one, (qb, kw, vw, mask))
    return out.swapaxes(0, 1).reshape(B, L, ATTN_WIDTH)


def _layer(x, mod, p, ctx_kv, s5_h0):
    B, L, _ = x.shape
    shift1, scale1, gate1, shift2, scale2, gate2 = jnp.split(mod, 6, axis=-1)
    h = _rmsnorm(x, p['norm1_g']) * (1 + scale1) + shift1
    z = h @ p['w_in']
    za, zb, zq, zk, zv, zg = jnp.split(z, IN_SPLITS, axis=-1)
    ya = _hyena(za, p)
    yb, s5_final = _s5(zb, p, s5_h0)
    q = zq.reshape(B, L, N_HEADS, HEAD_DIM)
    k = zk.reshape(B, L, N_KV_HEADS, HEAD_DIM)
    v = zv.reshape(B, L, N_KV_HEADS, HEAD_DIM)
    sink = p['attn_sink'].reshape(N_KV_HEADS, Q_PER_KV)
    if ctx_kv is None:
        yc = _context_attention(q.reshape(B, L, N_KV_HEADS, Q_PER_KV, HEAD_DIM), k, v, sink)
    else:
        q_rot = _axial_rope(q).reshape(B, L, N_KV_HEADS, Q_PER_KV, HEAD_DIM)
        yc = _latent_attention(q_rot, _axial_rope(k), v, ctx_kv[0], ctx_kv[1], sink)
    ga, gb, gc = jnp.split(jax.nn.sigmoid(zg), N_BRANCH, axis=-1)
    merged = ga * (ya @ p['proj_a']) + gb * (yb @ p['proj_b']) + gc * (yc @ p['proj_c'])
    x = x + gate1 * (merged @ p['w_out'])
    h = _rmsnorm(x, p['norm2_g']) * (1 + scale2) + shift2
    x = x + gate2 * ((jax.nn.silu(h @ p['ffn_w_gate']) * (h @ p['ffn_w_up'])) @ p['ffn_w_down'])
    return x, k, v, s5_final


def setup_inputs(seed: int = 0) -> dict:
    key = jax.random.key(seed)
    ks = iter(jax.random.split(key, 48))

    def nrm(shape, scale=1.0):
        return jax.random.normal(next(ks), shape, F32) * scale

    D = D_MODEL
    hy_decay = jnp.tile(jnp.linspace(HY_DECAY_FAST, HY_DECAY_SLOW, HY_WIDTH, dtype=F32), (DEPTH, 2 * HY_ORDER))
    lam_im = jnp.broadcast_to(math.pi * jnp.arange(S5_STATE, dtype=F32), (DEPTH, 2, S5_GROUPS, S5_STATE))
    return {
        'x_prompt': nrm((BATCH, SEQ, D)),
        'x_sample': nrm((DEC_BATCH, DEC_SEQ, D)),
        'cache_k': nrm((DEC_BATCH, DEPTH, PAST_LEN, N_KV_HEADS, HEAD_DIM)),
        'cache_v': nrm((DEC_BATCH, DEPTH, PAST_LEN, N_KV_HEADS, HEAD_DIM)),
        'state_s5_re': nrm((DEC_BATCH, DEPTH, 2, S5_GROUPS, S5_STATE), 0.1),
        'state_s5_im': nrm((DEC_BATCH, DEPTH, 2, S5_GROUPS, S5_STATE), 0.1),
        'c': nrm((DEC_BATCH, D)),
        'c_ctx': nrm((D,)),
        'ada_w': nrm((DEPTH, D, 6 * D), 0.5 * D ** -0.5),
        'ada_b': nrm((DEPTH, 6 * D), 0.01),
        'norm1_g': 1.0 + nrm((DEPTH, D), 0.05),
        'w_in': nrm((DEPTH, D, W_IN_COLS), D ** -0.5),
        'hy_conv_w': nrm((DEPTH, HY_SHORT_K, HY_IN), HY_SHORT_K ** -0.5),
        'hy_conv_b': nrm((DEPTH, HY_IN), 0.01),
        'hy_pos_w1': nrm((DEPTH, HY_POS_EMB, HY_FILTER_HIDDEN), HY_POS_EMB ** -0.5),
        'hy_pos_b1': nrm((DEPTH, HY_FILTER_HIDDEN), 0.1),
        'hy_pos_w2': nrm((DEPTH, HY_FILTER_HIDDEN, HY_FILTER_HIDDEN), HY_FILTER_HIDDEN ** -0.5),
        'hy_pos_b2': nrm((DEPTH, HY_FILTER_HIDDEN), 0.1),
        'hy_pos_w3': nrm((DEPTH, HY_FILTER_HIDDEN, 2 * HY_ORDER * HY_WIDTH), HY_FILTER_HIDDEN ** -0.5),
        'hy_sin_freq': 1.0 + nrm((DEPTH, HY_FILTER_HIDDEN), 0.1),
        'hy_decay': hy_decay + nrm((DEPTH, 2 * HY_ORDER * HY_WIDTH), 0.1),
        'hy_skip': nrm((DEPTH, HY_ORDER, HY_WIDTH)),
        's5_lam_re': -0.5 + nrm((DEPTH, 2, S5_GROUPS, S5_STATE), 0.01),
        's5_lam_im': lam_im + nrm((DEPTH, 2, S5_GROUPS, S5_STATE), 0.01),
        's5_log_step': jax.random.uniform(next(ks), (DEPTH, 2, S5_GROUPS), F32, math.log(1e-3), math.log(1e-1)),
        's5_b_re': nrm((DEPTH, 2, S5_GROUPS, S5_STATE, S5_GROUP), (2 * S5_GROUP) ** -0.5),
        's5_b_im': nrm((DEPTH, 2, S5_GROUPS, S5_STATE, S5_GROUP), (2 * S5_GROUP) ** -0.5),
        's5_c_re': nrm((DEPTH, 2, S5_GROUPS, S5_GROUP, S5_STATE), S5_STATE ** -0.5),
        's5_c_im': nrm((DEPTH, 2, S5_GROUPS, S5_GROUP, S5_STATE), S5_STATE ** -0.5),
        's5_skip': nrm((DEPTH, S5_WIDTH)),
        's5_glu_w': nrm((DEPTH, S5_WIDTH, 2 * S5_WIDTH), S5_WIDTH ** -0.5),
        's5_glu_b': nrm((DEPTH, 2 * S5_WIDTH), 0.01),
        'attn_sink': nrm((DEPTH, N_HEADS), 0.5),
        'proj_a': nrm((DEPTH, HY_WIDTH, D), HY_WIDTH ** -0.5),
        'proj_b': nrm((DEPTH, S5_WIDTH, D), S5_WIDTH ** -0.5),
        'proj_c': nrm((DEPTH, ATTN_WIDTH, D), ATTN_WIDTH ** -0.5),
        'w_out': nrm((DEPTH, D, D), D ** -0.5),
        'norm2_g': 1.0 + nrm((DEPTH, D), 0.05),
        'ffn_w_gate': nrm((DEPTH, D, FFN_HIDDEN), D ** -0.5),
        'ffn_w_up': nrm((DEPTH, D, FFN_HIDDEN), D ** -0.5),
        'ffn_w_down': nrm((DEPTH, FFN_HIDDEN, D), FFN_HIDDEN ** -0.5),
        'final_norm_g': 1.0 + nrm((D,), 0.05),
    }


def reference(x_prompt, x_sample, cache_k, cache_v, state_s5_re, state_s5_im, c, c_ctx,
              ada_w, ada_b, norm1_g, w_in, hy_conv_w, hy_conv_b, hy_pos_w1, hy_pos_b1,
              hy_pos_w2, hy_pos_b2, hy_pos_w3, hy_sin_freq, hy_decay, hy_skip,
              s5_lam_re, s5_lam_im, s5_log_step, s5_b_re, s5_b_im, s5_c_re, s5_c_im,
              s5_skip, s5_glu_w, s5_glu_b, attn_sink, proj_a, proj_b, proj_c, w_out,
              norm2_g, ffn_w_gate, ffn_w_up, ffn_w_down, final_norm_g):
    y_p = x_prompt
    y_s = x_sample
    ks_out, vs_out, sre_out, sim_out = [], [], [], []
    for l in range(DEPTH):
        p = {
            'norm1_g': norm1_g[l], 'w_in': w_in[l],
            'hy_conv_w': hy_conv_w[l], 'hy_conv_b': hy_conv_b[l],
            'hy_pos_w1': hy_pos_w1[l], 'hy_pos_b1': hy_pos_b1[l],
            'hy_pos_w2': hy_pos_w2[l], 'hy_pos_b2': hy_pos_b2[l], 'hy_pos_w3': hy_pos_w3[l],
            'hy_sin_freq': hy_sin_freq[l], 'hy_decay': hy_decay[l], 'hy_skip': hy_skip[l],
            's5_lam_re': s5_lam_re[l], 's5_lam_im': s5_lam_im[l], 's5_log_step': s5_log_step[l],
            's5_b_re': s5_b_re[l], 's5_b_im': s5_b_im[l], 's5_c_re': s5_c_re[l], 's5_c_im': s5_c_im[l],
            's5_skip': s5_skip[l], 's5_glu_w': s5_glu_w[l], 's5_glu_b': s5_glu_b[l],
            'attn_sink': attn_sink[l], 'proj_a': proj_a[l], 'proj_b': proj_b[l], 'proj_c': proj_c[l],
            'w_out': w_out[l], 'norm2_g': norm2_g[l],
            'ffn_w_gate': ffn_w_gate[l], 'ffn_w_up': ffn_w_up[l], 'ffn_w_down': ffn_w_down[l],
        }
        mod_ctx = (jax.nn.silu(c_ctx) @ ada_w[l] + ada_b[l]).reshape(1, 1, 6 * D_MODEL)
        y_p, k_l, v_l, s5_l = _layer(y_p, mod_ctx, p, None, None)
        ks_out.append(k_l)
        vs_out.append(v_l)
        sre_out.append(jnp.real(s5_l).astype(x_prompt.dtype))
        sim_out.append(jnp.imag(s5_l).astype(x_prompt.dtype))
        mod_lat = (jax.nn.silu(c) @ ada_w[l] + ada_b[l])[:, None, :]
        h0 = lax.complex(state_s5_re[:, l].astype(F32), state_s5_im[:, l].astype(F32))
        y_s, _, _, _ = _layer(y_s, mod_lat, p, (cache_k[:, l], cache_v[:, l]), h0)
    y_prompt = _rmsnorm(y_p, final_norm_g)
    y_sample = _rmsnorm(y_s, final_norm_g)
    new_cache_k = jnp.stack(ks_out, axis=1)
    new_cache_v = jnp.stack(vs_out, axis=1)
    new_state_s5_re = jnp.stack(sre_out, axis=1)
    new_state_s5_im = jnp.stack(sim_out, axis=1)
    return (y_prompt, y_sample, new_cache_k, new_cache_v, new_state_s5_re, new_state_s5_im)
```

```cpp
#include <hip/hip_runtime.h>
#include <hip/hip_cooperative_groups.h>
#include <cstdio>
namespace cg = cooperative_groups;

#ifndef MULTI_LAUNCH
#define MULTI_LAUNCH 0
#endif

typedef __attribute__((ext_vector_type(8))) short bf16x8;
typedef __attribute__((ext_vector_type(16))) float f32x16;
typedef unsigned short bfu;

constexpr int NTHR = 512;
constexpr int TT = 12288;
constexpr int LDS_BYTES = 98304;

enum { I_XP = 0, I_XS, I_CK, I_CV, I_SRE, I_SIM, I_C, I_CCTX, I_ADAW, I_ADAB, I_N1G, I_WIN, I_HCW, I_HCB, I_HW1, I_HB1, I_HW2, I_HB2,
       I_HW3, I_HFREQ, I_HDEC, I_HSKIP, I_LRE, I_LIM, I_LSTEP, I_BRE, I_BIM, I_CRE, I_CIM, I_S5SKIP, I_GLUW, I_GLUB, I_SINK,
       I_PA, I_PB, I_PC, I_WOUT, I_N2G, I_FG, I_FU, I_FD, I_FNG };

constexpr size_t OUT_YP = 0, OUT_YS = 4194304, OUT_K = 12582912, OUT_V = 14680064, OUT_SRE = 16777216, OUT_SIM = 16908288;

constexpr size_t OFF_WIN  = 0;
constexpr size_t OFF_WP   = OFF_WIN + (size_t)4864 * 1024 * 2;
constexpr size_t OFF_WO   = OFF_WP + (size_t)1024 * 1024 * 2;
constexpr size_t OFF_WGU  = OFF_WO + (size_t)1024 * 1024 * 2;
constexpr size_t OFF_WDN  = OFF_WGU + (size_t)5632 * 1024 * 2;
constexpr size_t OFF_WGLU = OFF_WDN + (size_t)1024 * 2816 * 2;
constexpr size_t OFF_X    = OFF_WGLU + (size_t)512 * 256 * 2;
constexpr size_t OFF_AB   = OFF_X + (size_t)TT * 1024 * 4;
constexpr size_t OFF_ZAT  = OFF_AB + (size_t)TT * 1024 * 2;
constexpr size_t OFF_ZB   = OFF_ZAT + (size_t)768 * TT * 4;
constexpr size_t OFF_Q    = OFF_ZB + (size_t)TT * 256 * 4;
constexpr size_t OFF_KS   = OFF_Q + (size_t)TT * 512 * 4;
constexpr size_t OFF_VS   = OFF_KS + (size_t)8192 * 128 * 4;
constexpr size_t OFF_G    = OFF_VS + (size_t)8192 * 128 * 4;
constexpr size_t OFF_YCAT = OFF_G + (size_t)TT * 3072 * 2;
constexpr size_t OFF_YS5  = OFF_YCAT + (size_t)TT * 1024 * 2;
constexpr size_t OFF_FS   = OFF_YS5 + (size_t)TT * 256 * 2;
constexpr size_t OFF_FP   = OFF_FS + (size_t)1024 * 4096 * 4;
constexpr size_t OFF_MOD  = OFF_FP + (size_t)1024 * 256 * 4;
constexpr size_t OFF_TW   = OFF_MOD + (size_t)4 * 3 * 6144 * 4;
constexpr size_t OFF_RT   = OFF_TW + (size_t)4096 * 8;
constexpr size_t OFF_LAMB = OFF_RT + (size_t)64 * 16 * 8;
constexpr size_t OFF_BBAR = OFF_LAMB + (size_t)2048 * 8;
constexpr size_t OFF_SE   = OFF_BBAR + (size_t)2048 * 16 * 8;
constexpr size_t WS_END   = OFF_SE + (size_t)384 * 32 * 64 * 8;

struct Params { const float* in[42]; float* out; char* ws; };

__device__ __forceinline__ int tidx() { int t = threadIdx.x; asm volatile("" : "+v"(t)); return t; }
__device__ __forceinline__ bfu f2bf(float f) { unsigned u = __float_as_uint(f); u += 0x7fffu + ((u >> 16) & 1u); return (bfu)(u >> 16); }
__device__ __forceinline__ unsigned pack2(float a, float b) { return (unsigned)f2bf(a) | ((unsigned)f2bf(b) << 16); }
__device__ __forceinline__ float bf2f(bfu v) { return __uint_as_float(((unsigned)v) << 16); }
__device__ __forceinline__ float sigm(float x) { return 1.f / (1.f + __expf(-x)); }
__device__ __forceinline__ float2 cmul(float2 a, float2 b) { return make_float2(a.x * b.x - a.y * b.y, a.x * b.y + a.y * b.x); }
__device__ __forceinline__ int cond_of(int row) { return row < 4096 ? 0 : 1 + ((row - 4096) >> 12); }
__device__ __forceinline__ const float* xrow(const Params& P, int l, int row) {
  if (l > 0) return (const float*)(P.ws + OFF_X) + (size_t)row * 1024;
  return row < 4096 ? P.in[I_XP] + (size_t)row * 1024 : P.in[I_XS] + (size_t)(row - 4096) * 1024;
}

template <int MI>
__device__ __forceinline__ void gemm_core(const bfu* __restrict__ A, int lda, const bfu* __restrict__ B, int ldb, int K,
                                          f32x16 (&acc)[MI][2], char* lds) {
  constexpr int BM = 128 * MI;
  constexpr int A_BYTES = BM * 128, B_BYTES = 128 * 128, STAGE = A_BYTES + B_BYTES;
  const int tid = tidx(), lane = tid & 63, w = tid >> 6;
  const int wm = w & 3, wn = w >> 2, r = lane & 31, h = lane >> 5;
  const int lrow = tid >> 3, lc = tid & 7;
  uint4 ra[2 * MI], rb[2];
  const int nk = K >> 6;
  const bfu* Ap = A + (size_t)lrow * lda + lc * 8;
  const bfu* Bp = B + (size_t)lrow * ldb + lc * 8;
#pragma unroll
  for (int i = 0; i < 2 * MI; ++i) ra[i] = *(const uint4*)(Ap + (size_t)(64 * i) * lda);
#pragma unroll
  for (int i = 0; i < 2; ++i) rb[i] = *(const uint4*)(Bp + (size_t)(64 * i) * ldb);
  {
    char* sa = lds; char* sb = sa + A_BYTES;
#pragma unroll
    for (int i = 0; i < 2 * MI; ++i) { int row = lrow + 64 * i; *(uint4*)(sa + row * 128 + ((lc ^ ((row >> 1) & 7)) << 4)) = ra[i]; }
#pragma unroll
    for (int i = 0; i < 2; ++i) { int row = lrow + 64 * i; *(uint4*)(sb + row * 128 + ((lc ^ ((row >> 1) & 7)) << 4)) = rb[i]; }
  }
  __syncthreads();
  for (int kt = 0; kt < nk; ++kt) {
    if (kt + 1 < nk) {
#pragma unroll
      for (int i = 0; i < 2 * MI; ++i) ra[i] = *(const uint4*)(Ap + (size_t)(64 * i) * lda + (kt + 1) * 64);
#pragma unroll
      for (int i = 0; i < 2; ++i) rb[i] = *(const uint4*)(Bp + (size_t)(64 * i) * ldb + (kt + 1) * 64);
    }
    const char* sa = lds + (kt & 1) * STAGE; const char* sb = sa + A_BYTES;
#pragma unroll
    for (int s = 0; s < 4; ++s) {
      bf16x8 af[MI], bfr[2];
#pragma unroll
      for (int mi = 0; mi < MI; ++mi) { int row = wm * 32 * MI + mi * 32 + r; af[mi] = *(const bf16x8*)(sa + row * 128 + (((2 * s + h) ^ ((row >> 1) & 7)) << 4)); }
#pragma unroll
      for (int ni = 0; ni < 2; ++ni) { int row = wn * 64 + ni * 32 + r; bfr[ni] = *(const bf16x8*)(sb + row * 128 + (((2 * s + h) ^ ((row >> 1) & 7)) << 4)); }
#pragma unroll
      for (int mi = 0; mi < MI; ++mi)
#pragma unroll
        for (int ni = 0; ni < 2; ++ni) acc[mi][ni] = __builtin_amdgcn_mfma_f32_32x32x16_bf16(af[mi], bfr[ni], acc[mi][ni], 0, 0, 0);
    }
    if (kt + 1 < nk) {
      char* da = lds + ((kt + 1) & 1) * STAGE; char* db = da + A_BYTES;
#pragma unroll
      for (int i = 0; i < 2 * MI; ++i) { int row = lrow + 64 * i; *(uint4*)(da + row * 128 + ((lc ^ ((row >> 1) & 7)) << 4)) = ra[i]; }
#pragma unroll
      for (int i = 0; i < 2; ++i) { int row = lrow + 64 * i; *(uint4*)(db + row * 128 + ((lc ^ ((row >> 1) & 7)) << 4)) = rb[i]; }
    }
    __syncthreads();
  }
}

template <int MI>
__device__ __forceinline__ void zero_acc(f32x16 (&acc)[MI][2]) {
#pragma unroll
  for (int mi = 0; mi < MI; ++mi)
#pragma unroll
    for (int ni = 0; ni < 2; ++ni)
#pragma unroll
      for (int i = 0; i < 16; ++i) acc[mi][ni][i] = 0.f;
}

__device__ __forceinline__ int rowmap(int mode, int n) {
  if (mode == 0) return n;
  if (mode == 1) return ((n >> 5) << 6) + (n & 31);
  if (mode == 2) return ((n >> 5) << 6) + 32 + (n & 31);
  if (n < 256) return ((n >> 5) << 6) + (n & 31);
  n -= 256; return ((n >> 5) << 6) + 32 + (n & 31);
}
__device__ __forceinline__ void conv_tile(const float* __restrict__ src, int N, bfu* __restrict__ dst, int ldd, int koff, int mode, int kt, int nt, float* tl) {
  const int tid = tidx();
  {
    int r = tid >> 3, c0 = (tid & 7) * 8;
    const float* s = src + (size_t)(kt * 64 + r) * N + nt * 64 + c0;
    float4 a = *(const float4*)s, b = *(const float4*)(s + 4);
    tl[(c0 + 0) * 65 + r] = a.x; tl[(c0 + 1) * 65 + r] = a.y; tl[(c0 + 2) * 65 + r] = a.z; tl[(c0 + 3) * 65 + r] = a.w;
    tl[(c0 + 4) * 65 + r] = b.x; tl[(c0 + 5) * 65 + r] = b.y; tl[(c0 + 6) * 65 + r] = b.z; tl[(c0 + 7) * 65 + r] = b.w;
  }
  __syncthreads();
  {
    int n = tid >> 3, k0 = (tid & 7) * 8;
    int drow = rowmap(mode, nt * 64 + n);
    const float* t = tl + n * 65 + k0;
    uint4 o; o.x = pack2(t[0], t[1]); o.y = pack2(t[2], t[3]); o.z = pack2(t[4], t[5]); o.w = pack2(t[6], t[7]);
    *(uint4*)(dst + (size_t)drow * ldd + koff + kt * 64 + k0) = o;
  }
  __syncthreads();
}
constexpr int CONV_TILES = 1216 + 64 + 64 + 128 + 256 + 704 + 704 + 704 + 32;
__device__ __forceinline__ void conv_item(const Params& P, int l, int t, char* lds) {
  float* tl = (float*)lds;
  char* ws = P.ws;
  if (t < 1216) { conv_tile(P.in[I_WIN] + (size_t)l * 1024 * 4864, 4864, (bfu*)(ws + OFF_WIN), 1024, 0, 0, t / 76, t % 76, tl); return; }
  t -= 1216;
  if (t < 64) { conv_tile(P.in[I_PA] + (size_t)l * 256 * 1024, 1024, (bfu*)(ws + OFF_WP), 1024, 0, 0, t / 16, t % 16, tl); return; }
  t -= 64;
  if (t < 64) { conv_tile(P.in[I_PB] + (size_t)l * 256 * 1024, 1024, (bfu*)(ws + OFF_WP), 1024, 256, 0, t / 16, t % 16, tl); return; }
  t -= 64;
  if (t < 128) { conv_tile(P.in[I_PC] + (size_t)l * 512 * 1024, 1024, (bfu*)(ws + OFF_WP), 1024, 512, 0, t / 16, t % 16, tl); return; }
  t -= 128;
  if (t < 256) { conv_tile(P.in[I_WOUT] + (size_t)l * 1024 * 1024, 1024, (bfu*)(ws + OFF_WO), 1024, 0, 0, t / 16, t % 16, tl); return; }
  t -= 256;
  if (t < 704) { conv_tile(P.in[I_FG] + (size_t)l * 1024 * 2816, 2816, (bfu*)(ws + OFF_WGU), 1024, 0, 1, t / 44, t % 44, tl); return; }
  t -= 704;
  if (t < 704) { conv_tile(P.in[I_FU] + (size_t)l * 1024 * 2816, 2816, (bfu*)(ws + OFF_WGU), 1024, 0, 2, t / 44, t % 44, tl); return; }
  t -= 704;
  if (t < 704) { conv_tile(P.in[I_FD] + (size_t)l * 2816 * 1024, 1024, (bfu*)(ws + OFF_WDN), 2816, 0, 0, t / 16, t % 16, tl); return; }
  t -= 704;
  conv_tile(P.in[I_GLUW] + (size_t)l * 256 * 512, 512, (bfu*)(ws + OFF_WGLU), 256, 0, 3, t / 8, t % 8, tl);
}

__device__ __forceinline__ void ada_item(const Params& P, int item, char* lds) {
  const int l = item / 96, cc = item % 96;
  float* sc = (float*)lds;
  float* red = sc + 3072;
  const int tid = tidx(), lane = tid & 63, w = tid >> 6;
  for (int i = tid; i < 3072; i += NTHR) {
    int cnd = i >> 10, k = i & 1023;
    float v = cnd == 0 ? P.in[I_CCTX][k] : P.in[I_C][(cnd - 1) * 1024 + k];
    sc[i] = v * sigm(v);
  }
  __syncthreads();
  const float* wp = P.in[I_ADAW] + (size_t)l * 1024 * 6144 + cc * 64 + lane;
  float a0 = 0.f, a1 = 0.f, a2 = 0.f;
#pragma unroll 8
  for (int k = w * 128; k < w * 128 + 128; ++k) {
    float wv = wp[(size_t)k * 6144];
    a0 += sc[k] * wv; a1 += sc[1024 + k] * wv; a2 += sc[2048 + k] * wv;
  }
  red[(w * 3 + 0) * 64 + lane] = a0; red[(w * 3 + 1) * 64 + lane] = a1; red[(w * 3 + 2) * 64 + lane] = a2;
  __syncthreads();
  if (tid < 192) {
    int cnd = tid >> 6, c = tid & 63;
    float s = P.in[I_ADAB][l * 6144 + cc * 64 + c];
#pragma unroll
    for (int ww = 0; ww < 8; ++ww) s += red[(ww * 3 + cnd) * 64 + c];
    ((float*)(P.ws + OFF_MOD))[(l * 3 + cnd) * 6144 + cc * 64 + c] = s;
  }
  __syncthreads();
}

__device__ __forceinline__ void tables_item(const Params& P) {
  float2* tw = (float2*)(P.ws + OFF_TW);
  float2* rt = (float2*)(P.ws + OFF_RT);
  for (int k = tidx(); k < 4096; k += NTHR) { float s, c; sincospif((float)k / 4096.f, &s, &c); tw[k] = make_float2(c, -s); }
  for (int i = tidx(); i < 1024; i += NTHR) {
    int pos = i >> 4, f = i & 15;
    float inv = powf(10000.f, -(float)f / 16.f);
    float ang = (float)pos * inv;
    rt[i] = make_float2(cosf(ang), sinf(ang));
  }
}

__device__ __forceinline__ void filt_item(const Params& P, int l, int item, char* lds) {
  const bool isS = item >= 4;
  const int L = isS ? 4096 : 256;
  const int pb = isS ? item - 4 : item;
  float* F = (float*)(P.ws + (isS ? OFF_FS : OFF_FP));
  float* feat = (float*)lds;
  float* h1 = feat + 64 * 33;
  float* h2 = h1 + 64 * 65;
  const int tid = tidx();
  const int pos0 = pb * 64;
  const float tstep = 1.f / (float)(L - 1);
  for (int idx = tid; idx < 64 * 33; idx += NTHR) {
    int p = idx / 33, f = idx % 33;
    int pos = pos0 + p;
    float val;
    if (f == 0) val = (float)pos * tstep;
    else {
      int bi = (f - 1) & 15;
      float fr = (float)bi / 15.f;
      float band = 1e-4f * (1.f - fr) + 15.f * fr;
      float wv = 2.f * 3.14159265358979323846f * (float)pos / (float)L;
      float ang = wv * band;
      val = (f <= 16) ? cosf(ang) : -sinf(ang);
    }
    feat[idx] = val;
  }
  __syncthreads();
  const float* w1 = P.in[I_HW1] + (size_t)l * 33 * 64;
  const float* b1 = P.in[I_HB1] + l * 64;
  const float* w2 = P.in[I_HW2] + (size_t)l * 64 * 64;
  const float* b2 = P.in[I_HB2] + l * 64;
  const float* fq = P.in[I_HFREQ] + l * 64;
  for (int idx = tid; idx < 4096; idx += NTHR) {
    int p = idx >> 6, u = idx & 63;
    float s = b1[u];
    for (int f = 0; f < 33; ++f) s += feat[p * 33 + f] * w1[f * 64 + u];
    h1[p * 65 + u] = sinf(fq[u] * s);
  }
  __syncthreads();
  for (int idx = tid; idx < 4096; idx += NTHR) {
    int p = idx >> 6, u = idx & 63;
    float s = b2[u];
    for (int k = 0; k < 64; ++k) s += h1[p * 65 + k] * w2[k * 64 + u];
    h2[p * 65 + u] = sinf(fq[u] * s);
  }
  __syncthreads();
  const int lane = tid & 63;
  const int w = __builtin_amdgcn_readfirstlane(tid >> 6);
  float hr[64];
#pragma unroll
  for (int k = 0; k < 64; ++k) hr[k] = h2[lane * 65 + k];
  const float* w3 = P.in[I_HW3] + (size_t)l * 64 * 1024;
  const float* dec = P.in[I_HDEC] + l * 1024;
  const float tpos = (float)(pos0 + lane) * tstep;
  for (int c = w * 128; c < w * 128 + 128; ++c) {
    float s = 0.f;
#pragma unroll
    for (int k = 0; k < 64; ++k) s += hr[k] * w3[k * 1024 + c];
    s *= __expf(-tpos * fabsf(dec[c]));
    F[(size_t)c * L + pos0 + lane] = s;
  }
  __syncthreads();
}

__device__ __forceinline__ void s5pre_item(const Params& P, int l) {
  float2* lamb = (float2*)(P.ws + OFF_LAMB);
  float2* bbar = (float2*)(P.ws + OFF_BBAR);
  for (int idx = tidx(); idx < 2048; idx += NTHR) {
    float lre = P.in[I_LRE][l * 2048 + idx], lim = P.in[I_LIM][l * 2048 + idx];
    float step = expf(P.in[I_LSTEP][l * 32 + (idx >> 6)]);
    float er = expf(lre * step), sn, cs; sincosf(lim * step, &sn, &cs);
    float2 lb = make_float2(er * cs, er * sn);
    lamb[idx] = lb;
    float2 num = make_float2(lb.x - 1.f, lb.y);
    float den = lre * lre + lim * lim;
    float2 coef = make_float2((num.x * lre + num.y * lim) / den, (num.y * lre - num.x * lim) / den);
    const float* br = P.in[I_BRE] + ((size_t)l * 2048 + idx) * 16;
    const float* bi = P.in[I_BIM] + ((size_t)l * 2048 + idx) * 16;
    for (int c = 0; c < 16; ++c) bbar[idx * 16 + c] = cmul(coef, make_float2(br[c], bi[c]));
  }
}

__device__ __forceinline__ void norm_phase(const Params& P, int l, int which) {
  const int lane = tidx() & 63, w = tidx() >> 6;
  const float* gam = P.in[which ? I_N2G : I_N1G] + l * 1024;
  bfu* AB = (bfu*)(P.ws + OFF_AB);
  for (int row = blockIdx.x * 8 + w; row < TT; row += gridDim.x * 8) {
    const float* x = which ? (const float*)(P.ws + OFF_X) + (size_t)row * 1024 : xrow(P, l, row);
    const float* md = (const float*)(P.ws + OFF_MOD) + (l * 3 + cond_of(row)) * 6144 + which * 3072;
    float4 v[4]; float ss = 0.f;
#pragma unroll
    for (int i = 0; i < 4; ++i) { v[i] = *(const float4*)(x + i * 256 + lane * 4); ss += v[i].x * v[i].x + v[i].y * v[i].y + v[i].z * v[i].z + v[i].w * v[i].w; }
#pragma unroll
    for (int o = 32; o > 0; o >>= 1) ss += __shfl_xor(ss, o);
    float rs = rsqrtf(ss * (1.f / 1024.f) + 1e-6f);
#pragma unroll
    for (int i = 0; i < 4; ++i) {
      int c = i * 256 + lane * 4;
      float4 g = *(const float4*)(gam + c), sh = *(const float4*)(md + c), sc = *(const float4*)(md + 1024 + c);
      float o0 = v[i].x * rs * g.x * (1.f + sc.x) + sh.x, o1 = v[i].y * rs * g.y * (1.f + sc.y) + sh.y;
      float o2 = v[i].z * rs * g.z * (1.f + sc.z) + sh.z, o3 = v[i].w * rs * g.w * (1.f + sc.w) + sh.w;
      uint2 o; o.x = pack2(o0, o1); o.y = pack2(o2, o3);
      *(uint2*)(AB + (size_t)row * 1024 + c) = o;
    }
  }
}
__device__ __forceinline__ void final_phase(const Params& P) {
  const int lane = tidx() & 63, w = tidx() >> 6;
  const float* gam = P.in[I_FNG];
  for (int row = blockIdx.x * 8 + w; row < TT; row += gridDim.x * 8) {
    const float* x = (const float*)(P.ws + OFF_X) + (size_t)row * 1024;
    float* y = P.out + (size_t)row * 1024;
    float4 v[4]; float ss = 0.f;
#pragma unroll
    for (int i = 0; i < 4; ++i) { v[i] = *(const float4*)(x + i * 256 + lane * 4); ss += v[i].x * v[i].x + v[i].y * v[i].y + v[i].z * v[i].z + v[i].w * v[i].w; }
#pragma unroll
    for (int o = 32; o > 0; o >>= 1) ss += __shfl_xor(ss, o);
    float rs = rsqrtf(ss * (1.f / 1024.f) + 1e-6f);
#pragma unroll
    for (int i = 0; i < 4; ++i) {
      int c = i * 256 + lane * 4;
      float4 g = *(const float4*)(gam + c);
      *(float4*)(y + c) = make_float4(v[i].x * rs * g.x, v[i].y * rs * g.y, v[i].z * rs * g.z, v[i].w * rs * g.w);
    }
  }
}

#define EPI_ROW(MI_, mi, reg) (wm * 32 * MI_ + (mi) * 32 + ((reg) & 3) + 8 * ((reg) >> 2) + 4 * h)

__device__ __forceinline__ void gemm_in_phase(const Params& P, int l, char* lds) {
  const int tid = tidx(), lane = tid & 63, w = tid >> 6, wm = w & 3, wn = w >> 2, r = lane & 31, h = lane >> 5;
  const bfu* A = (const bfu*)(P.ws + OFF_AB);
  const bfu* B = (const bfu*)(P.ws + OFF_WIN);
  for (int tile = blockIdx.x; tile < 48 * 38; tile += gridDim.x) {
    const int mt = tile % 48, nt = tile / 48;
    const int m0 = mt * 256, n0 = nt * 128;
    f32x16 acc[2][2]; zero_acc<2>(acc);
    gemm_core<2>(A + (size_t)m0 * 1024, 1024, B + (size_t)n0 * 1024, 1024, 1024, acc, lds);
#pragma unroll
    for (int mi = 0; mi < 2; ++mi)
#pragma unroll
      for (int ni = 0; ni < 2; ++ni) {
        const int col = n0 + wn * 64 + ni * 32 + r;
        if (n0 < 768) {
          float* zt = (float*)(P.ws + OFF_ZAT) + (size_t)col * TT;
#pragma unroll
          for (int q4 = 0; q4 < 4; ++q4) {
            int row = m0 + wm * 64 + mi * 32 + 8 * q4 + 4 * h;
            *(float4*)(zt + row) = make_float4(acc[mi][ni][4 * q4], acc[mi][ni][4 * q4 + 1], acc[mi][ni][4 * q4 + 2], acc[mi][ni][4 * q4 + 3]);
          }
        } else {
#pragma unroll
          for (int reg = 0; reg < 16; ++reg) {
            const int row = m0 + EPI_ROW(2, mi, reg);
            const float v = acc[mi][ni][reg];
            if (n0 < 1024) ((float*)(P.ws + OFF_ZB))[(size_t)row * 256 + col - 768] = v;
            else if (n0 < 1536) ((float*)(P.ws + OFF_Q))[(size_t)row * 512 + col - 1024] = v;
            else if (n0 < 1792) {
              const bool isv = n0 >= 1664;
              const int c = col - (isv ? 1664 : 1536);
              if (row < 4096) P.out[(isv ? OUT_V : OUT_K) + ((size_t)((row >> 8) * 4 + l) * 256 + (row & 255)) * 128 + c] = v;
              else ((float*)(P.ws + (isv ? OFF_VS : OFF_KS)))[(size_t)(row - 4096) * 128 + c] = v;
            } else ((bfu*)(P.ws + OFF_G))[(size_t)row * 3072 + col - 1792] = f2bf(sigm(v));
          }
        }
      }
  }
}

__device__ __forceinline__ void glu_phase(const Params& P, int l, char* lds) {
  const int tid = tidx(), lane = tid & 63, w = tid >> 6, wm = w & 3, wn = w >> 2, r = lane & 31, h = lane >> 5;
  const bfu* A = (const bfu*)(P.ws + OFF_YS5);
  const bfu* B = (const bfu*)(P.ws + OFF_WGLU);
  const float* bias = P.in[I_GLUB] + l * 512;
  bfu* YC = (bfu*)(P.ws + OFF_YCAT);
  for (int tile = blockIdx.x; tile < 96 * 4; tile += gridDim.x) {
    const int mt = tile % 96, nt = tile / 96;
    const int m0 = mt * 128;
    f32x16 acc[1][2]; zero_acc<1>(acc);
    gemm_core<1>(A + (size_t)m0 * 256, 256, B + (size_t)(nt * 128) * 256, 256, 256, acc, lds);
    const int cj = nt * 64 + wn * 32 + r;
    const float ba = bias[cj], bg = bias[256 + cj];
#pragma unroll
    for (int reg = 0; reg < 16; ++reg) {
      const int row = m0 + EPI_ROW(1, 0, reg);
      float a = acc[0][0][reg] + ba, g = acc[0][1][reg] + bg;
      YC[(size_t)row * 1024 + 256 + cj] = f2bf(a * sigm(g));
    }
  }
}

__device__ __forceinline__ void proj_phase(const Params& P, int l, char* lds) {
  const int tid = tidx(), lane = tid & 63, w = tid >> 6, wm = w & 3, wn = w >> 2, r = lane & 31, h = lane >> 5;
  const bfu* A = (const bfu*)(P.ws + OFF_YCAT);
  const bfu* B = (const bfu*)(P.ws + OFF_WP);
  const bfu* G = (const bfu*)(P.ws + OFF_G);
  bfu* AB = (bfu*)(P.ws + OFF_AB);
  for (int tile = blockIdx.x; tile < 96 * 8; tile += gridDim.x) {
    const int mt = tile % 96, nt = tile / 96;
    const int m0 = mt * 128, n0 = nt * 128;
    f32x16 mg[2];
#pragma unroll
    for (int ni = 0; ni < 2; ++ni)
#pragma unroll
      for (int i = 0; i < 16; ++i) mg[ni][i] = 0.f;
#pragma unroll 1
    for (int seg = 0; seg < 3; ++seg) {
      const int koff = seg * 256, klen = seg == 2 ? 512 : 256;
      f32x16 acc[1][2]; zero_acc<1>(acc);
      gemm_core<1>(A + (size_t)m0 * 1024 + koff, 1024, B + (size_t)n0 * 1024 + koff, 1024, klen, acc, lds);
#pragma unroll
      for (int ni = 0; ni < 2; ++ni) {
        const int col = n0 + wn * 64 + ni * 32 + r;
#pragma unroll
        for (int reg = 0; reg < 16; ++reg) {
          const int row = m0 + EPI_ROW(1, 0, reg);
          mg[ni][reg] += bf2f(G[(size_t)row * 3072 + seg * 1024 + col]) * acc[0][ni][reg];
        }
      }
    }
#pragma unroll
    for (int ni = 0; ni < 2; ++ni) {
      const int col = n0 + wn * 64 + ni * 32 + r;
#pragma unroll
      for (int reg = 0; reg < 16; ++reg) AB[(size_t)(m0 + EPI_ROW(1, 0, reg)) * 1024 + col] = f2bf(mg[ni][reg]);
    }
  }
}

__device__ __forceinline__ void resid_gemm_phase(const Params& P, int l, int which, char* lds) {
  const int tid = tidx(), lane = tid & 63, w = tid >> 6, wm = w & 3, wn = w >> 2, r = lane & 31, h = lane >> 5;
  const bfu* A = (const bfu*)(P.ws + (which ? OFF_G : OFF_AB));
  const int lda = which ? 2816 : 1024;
  const bfu* B = (const bfu*)(P.ws + (which ? OFF_WDN : OFF_WO));
  float* X = (float*)(P.ws + OFF_X);
  for (int tile = blockIdx.x; tile < 96 * 8; tile += gridDim.x) {
    const int mt = tile % 96, nt = tile / 96;
    const int m0 = mt * 128, n0 = nt * 128;
    f32x16 acc[1][2]; zero_acc<1>(acc);
    gemm_core<1>(A + (size_t)m0 * lda, lda, B + (size_t)n0 * lda, lda, lda, acc, lds);
    const float* gate = (const float*)(P.ws + OFF_MOD) + (l * 3 + cond_of(m0)) * 6144 + (which ? 5120 : 2048);
#pragma unroll
    for (int ni = 0; ni < 2; ++ni) {
      const int col = n0 + wn * 64 + ni * 32 + r;
      const float gv = gate[col];
#pragma unroll
      for (int reg = 0; reg < 16; ++reg) {
        const int row = m0 + EPI_ROW(1, 0, reg);
        const float xin = which ? X[(size_t)row * 1024 + col] : xrow(P, l, row)[col];
        X[(size_t)row * 1024 + col] = xin + gv * acc[0][ni][reg];
      }
    }
  }
}

__device__ __forceinline__ void ffn_up_phase(const Params& P, int l, char* lds) {
  const int tid = tidx(), lane = tid & 63, w = tid >> 6, wm = w & 3, wn = w >> 2, r = lane & 31, h = lane >> 5;
  const bfu* A = (const bfu*)(P.ws + OFF_AB);
  const bfu* B = (const bfu*)(P.ws + OFF_WGU);
  bfu* HID = (bfu*)(P.ws + OFF_G);
  for (int tile = blockIdx.x; tile < 48 * 44; tile += gridDim.x) {
    const int mt = tile % 48, nt = tile / 48;
    const int m0 = mt * 256;
    f32x16 acc[2][2]; zero_acc<2>(acc);
    gemm_core<2>(A + (size_t)m0 * 1024, 1024, B + (size_t)(nt * 128) * 1024, 1024, 1024, acc, lds);
    const int cj = nt * 64 + wn * 32 + r;
#pragma unroll
    for (int mi = 0; mi < 2; ++mi)
#pragma unroll
      for (int reg = 0; reg < 16; ++reg) {
        const int row = m0 + EPI_ROW(2, mi, reg);
        float g = acc[mi][0][reg], u = acc[mi][1][reg];
        HID[(size_t)row * 2816 + cj] = f2bf(g * sigm(g) * u);
      }
  }
}

__device__ __forceinline__ float short_conv(const float* __restrict__ z, int t, int L, float w0, float w1, float w2, float b) {
  float s = b + w1 * z[t];
  if (t > 0) s += w0 * z[t - 1];
  if (t < L - 1) s += w2 * z[t + 1];
  return s;
}

__device__ __forceinline__ void fft_fwd(float2* data, const float2* tw) {
  const int tid = tidx();
  for (int s = 12; s >= 0; --s) {
    const int half = 1 << s;
#pragma unroll
    for (int it = 0; it < 8; ++it) {
      int i = tid + it * NTHR;
      int j = i & (half - 1);
      int base = ((i >> s) << (s + 1)) | j;
      float2 a = data[base], b = data[base + half], wv = tw[j << (12 - s)];
      data[base] = make_float2(a.x + b.x, a.y + b.y);
      data[base + half] = cmul(make_float2(a.x - b.x, a.y - b.y), wv);
    }
    __syncthreads();
  }
}
__device__ __forceinline__ void fft_inv(float2* data, const float2* tw) {
  const int tid = tidx();
  for (int s = 0; s <= 12; ++s) {
    const int half = 1 << s;
#pragma unroll
    for (int it = 0; it < 8; ++it) {
      int i = tid + it * NTHR;
      int j = i & (half - 1);
      int base = ((i >> s) << (s + 1)) | j;
      float2 wv = tw[j << (12 - s)]; wv.y = -wv.y;
      float2 a = data[base], b = cmul(data[base + half], wv);
      data[base] = make_float2(a.x + b.x, a.y + b.y);
      data[base + half] = make_float2(a.x - b.x, a.y - b.y);
    }
    __syncthreads();
  }
}
__device__ __forceinline__ float block_sum(float v, float* red) {
  const int lane = tidx() & 63, w = tidx() >> 6;
#pragma unroll
  for (int o = 32; o > 0; o >>= 1) v += __shfl_xor(v, o);
  __syncthreads();
  if (lane == 0) red[w] = v;
  __syncthreads();
  float s = 0.f;
#pragma unroll
  for (int i = 0; i < 8; ++i) s += red[i];
  return s;
}

__device__ __forceinline__ void hyena_sample_item(const Params& P, int l, int c, char* lds) {
  float2* data = (float2*)lds;
  float2* tw = data + 8192;
  __shared__ float red[8];
  const int tid = tidx();
  const int L = 4096;
  const float* FS = (const float*)(P.ws + OFF_FS);
  const float* ZAT = (const float*)(P.ws + OFF_ZAT);
  const float* cw = P.in[I_HCW] + l * 3 * 768;
  const float* cb = P.in[I_HCB] + l * 768;
  {
    const float2* twg = (const float2*)(P.ws + OFF_TW);
    for (int i = tid; i < 4096; i += NTHR) tw[i] = twg[i];
  }
  float2 vreg[8];
#pragma unroll
  for (int o = 0; o < 2; ++o) {
    const float* hf = FS + (size_t)((o * 2 + 0) * 256 + c) * L;
    const float* hb = FS + (size_t)((o * 2 + 1) * 256 + c) * L;
    float asum = 0.f;
#pragma unroll
    for (int m = 0; m < 16; ++m) {
      int n = tid + m * NTHR;
      float v = n < L ? hf[n] : (n == L ? 0.f : hb[2 * L - n]);
      asum += fabsf(v);
      data[n] = make_float2(v, 0.f);
    }
    float nrm = block_sum(asum, red);
    fft_fwd(data, tw);
    float2 Kf[16];
    const float ksc = 1.f / (nrm * 8192.f);
#pragma unroll
    for (int m = 0; m < 16; ++m) { float2 v = data[tid + m * NTHR]; Kf[m] = make_float2(v.x * ksc, v.y * ksc); }
    __syncthreads();
    if (o == 0) {
      const float w0 = cw[c], w1 = cw[768 + c], w2 = cw[1536 + c], b = cb[c];
      const float* z0 = ZAT + (size_t)c * TT + 4096;
#pragma unroll
      for (int m = 0; m < 8; ++m) {
        int t = tid + m * NTHR;
        vreg[m] = make_float2(short_conv(z0, t, L, w0, w1, w2, b), short_conv(z0 + 4096, t, L, w0, w1, w2, b));
      }
    }
#pragma unroll
    for (int m = 0; m < 8; ++m) { int t = tid + m * NTHR; data[t] = vreg[m]; data[t + L] = make_float2(0.f, 0.f); }
    __syncthreads();
    fft_fwd(data, tw);
#pragma unroll
    for (int m = 0; m < 16; ++m) { int n = tid + m * NTHR; data[n] = cmul(data[n], Kf[m]); }
    __syncthreads();
    fft_inv(data, tw);
    {
      const int gc = (o + 1) * 256 + c;
      const float w0 = cw[gc], w1 = cw[768 + gc], w2 = cw[1536 + gc], b = cb[gc];
      const float* zg = ZAT + (size_t)gc * TT + 4096;
      const float sk = P.in[I_HSKIP][(l * 2 + o) * 256 + c];
#pragma unroll
      for (int m = 0; m < 8; ++m) {
        int t = tid + m * NTHR;
        float2 y = data[t];
        float g0 = short_conv(zg, t, L, w0, w1, w2, b), g1 = short_conv(zg + 4096, t, L, w0, w1, w2, b);
        vreg[m] = make_float2(g0 * (y.x + sk * vreg[m].x), g1 * (y.y + sk * vreg[m].y));
      }
    }
    __syncthreads();
  }
  bfu* YC = (bfu*)(P.ws + OFF_YCAT);
#pragma unroll
  for (int m = 0; m < 8; ++m) {
    int t = tid + m * NTHR;
    YC[(size_t)(4096 + t) * 1024 + c] = f2bf(vreg[m].x);
    YC[(size_t)(8192 + t) * 1024 + c] = f2bf(vreg[m].y);
  }
}

__device__ __forceinline__ void hyena_prompt_item(const Params& P, int l, int c, char* lds) {
  float* V = (float*)lds;
  float* KF = V + 4096;
  __shared__ float red[8];
  const int tid = tidx();
  const int L = 256;
  const float* FP = (const float*)(P.ws + OFF_FP);
  const float* ZAT = (const float*)(P.ws + OFF_ZAT);
  const float* cw = P.in[I_HCW] + l * 3 * 768;
  const float* cb = P.in[I_HCB] + l * 768;
#pragma unroll
  for (int o = 0; o < 2; ++o) {
    const float* hf = FP + (size_t)((o * 2 + 0) * 256 + c) * L;
    const float* hb = FP + (size_t)((o * 2 + 1) * 256 + c) * L;
    int d = tid - 255;
    float v = (tid == 511) ? 0.f : (d >= 0 ? hf[d] : hb[-d]);
    float nrm = block_sum(fabsf(v), red);
    KF[o * 512 + tid] = v / nrm;
  }
  const int seq = tid >> 5, t0 = (tid & 31) * 8;
  float vr[8];
  {
    const float w0 = cw[c], w1 = cw[768 + c], w2 = cw[1536 + c], b = cb[c];
    const float* z0 = ZAT + (size_t)c * TT + seq * 256;
#pragma unroll
    for (int i = 0; i < 8; ++i) { vr[i] = short_conv(z0, t0 + i, L, w0, w1, w2, b); V[seq * 256 + t0 + i] = vr[i]; }
  }
  __syncthreads();
#pragma unroll
  for (int o = 0; o < 2; ++o) {
    float acc[8];
#pragma unroll
    for (int i = 0; i < 8; ++i) acc[i] = 0.f;
    const float* kf = KF + o * 512;
    const float* u = V + seq * 256;
    for (int s0 = 0; s0 < 256; s0 += 8) {
      float kk[16], uu[8];
      const int kb = 248 + t0 - s0;
#pragma unroll
      for (int i = 0; i < 4; ++i) { float4 t4 = *(const float4*)(kf + kb + 4 * i); kk[4 * i] = t4.x; kk[4 * i + 1] = t4.y; kk[4 * i + 2] = t4.z; kk[4 * i + 3] = t4.w; }
#pragma unroll
      for (int i = 0; i < 2; ++i) { float4 t4 = *(const float4*)(u + s0 + 4 * i); uu[4 * i] = t4.x; uu[4 * i + 1] = t4.y; uu[4 * i + 2] = t4.z; uu[4 * i + 3] = t4.w; }
#pragma unroll
      for (int a = 0; a < 8; ++a)
#pragma unroll
        for (int i = 0; i < 8; ++i) acc[i] += kk[i - a + 7] * uu[a];
    }
    const int gc = (o + 1) * 256 + c;
    const float w0 = cw[gc], w1 = cw[768 + gc], w2 = cw[1536 + gc], b = cb[gc];
    const float* zg = ZAT + (size_t)gc * TT + seq * 256;
    const float sk = P.in[I_HSKIP][(l * 2 + o) * 256 + c];
    __syncthreads();
#pragma unroll
    for (int i = 0; i < 8; ++i) {
      float g = short_conv(zg, t0 + i, L, w0, w1, w2, b);
      vr[i] = g * (acc[i] + sk * vr[i]);
      V[seq * 256 + t0 + i] = vr[i];
    }
    __syncthreads();
  }
  bfu* YC = (bfu*)(P.ws + OFF_YCAT);
#pragma unroll
  for (int i = 0; i < 8; ++i) YC[(size_t)(seq * 256 + t0 + i) * 1024 + c] = f2bf(vr[i]);
}

__device__ __forceinline__ void attn_item(const Params& P, int l, int seq, int g, int qb, char* lds) {
  char* Kl = lds;
  char* Vt = lds + 8192;
  const int tid = tidx(), lane = tid & 63, w = tid >> 6;
  const bool isS = seq >= 16;
  const int b = isS ? seq - 16 : seq;
  const int L = isS ? 4096 : 256;
  const int tok0 = isS ? 4096 + b * 4096 : b * 256;
  const int q0 = qb * 64;
  const int rr = w >> 1, qs = w & 1, ql = lane & 31, h = lane >> 5;
  const int tq = q0 + qs * 32 + ql;
  const int head = g * 4 + rr;
  const float2* RT = (const float2*)(P.ws + OFF_RT);
  bf16x8 qf[4];
  {
    const float* qp = (const float*)(P.ws + OFF_Q) + (size_t)(tok0 + tq) * 512 + head * 64 + 8 * h;
    float qv[4][8];
#pragma unroll
    for (int s = 0; s < 4; ++s) {
      float4 a = *(const float4*)(qp + 16 * s), bq = *(const float4*)(qp + 16 * s + 4);
      qv[s][0] = a.x; qv[s][1] = a.y; qv[s][2] = a.z; qv[s][3] = a.w; qv[s][4] = bq.x; qv[s][5] = bq.y; qv[s][6] = bq.z; qv[s][7] = bq.w;
    }
    if (isS) {
#pragma unroll
      for (int hp = 0; hp < 2; ++hp) {
        const int pos = hp == 0 ? (tq >> 6) : (tq & 63);
#pragma unroll
        for (int j = 0; j < 8; ++j) {
          float2 cs = RT[pos * 16 + 8 * h + j];
          float x1 = qv[2 * hp][j], x2 = qv[2 * hp + 1][j];
          qv[2 * hp][j] = x1 * cs.x - x2 * cs.y;
          qv[2 * hp + 1][j] = x1 * cs.y + x2 * cs.x;
        }
      }
    }
#pragma unroll
    for (int s = 0; s < 4; ++s) {
      union { bf16x8 v; unsigned u[4]; } cv;
#pragma unroll
      for (int j = 0; j < 4; ++j) cv.u[j] = pack2(qv[s][2 * j] * 0.125f, qv[s][2 * j + 1] * 0.125f);
      qf[s] = cv.v;
    }
  }
  float mrun = P.in[I_SINK][l * 8 + head];
  float lsum = h == 0 ? 1.f : 0.f;
  f32x16 oacc[2];
#pragma unroll
  for (int dt = 0; dt < 2; ++dt)
#pragma unroll
    for (int i = 0; i < 16; ++i) oacc[dt][i] = 0.f;

  const int ntile = isS ? 13 : 4;
  const int lk = tid & 63, lc = tid >> 6;
  for (int ti = 0; ti < ntile; ++ti) {
    int kstart = 0; bool win = false;
    const float* kbase; const float* vbase;
    if (!isS) {
      kstart = ti * 64;
      kbase = P.out + OUT_K + ((size_t)(b * 4 + l) * 256 + kstart) * 128 + g * 64;
      vbase = P.out + OUT_V + ((size_t)(b * 4 + l) * 256 + kstart) * 128 + g * 64;
    } else if (ti < 8) {
      kstart = ti * 64;
      kbase = P.in[I_CK] + ((size_t)(b * 4 + l) * 512 + kstart) * 128 + g * 64;
      vbase = P.in[I_CV] + ((size_t)(b * 4 + l) * 512 + kstart) * 128 + g * 64;
    } else {
      kstart = q0 - 128 + (ti - 8) * 64; win = true;
      if (kstart < 0 || kstart >= L) continue;
      kbase = (const float*)(P.ws + OFF_KS) + ((size_t)b * 4096 + kstart) * 128 + g * 64;
      vbase = (const float*)(P.ws + OFF_VS) + ((size_t)b * 4096 + kstart) * 128 + g * 64;
    }
    __syncthreads();
    {
      const float* kp = kbase + (size_t)lk * 128 + lc * 8;
      float4 a = *(const float4*)kp, bq = *(const float4*)(kp + 4);
      float kv[8] = {a.x, a.y, a.z, a.w, bq.x, bq.y, bq.z, bq.w};
      if (win) {
        const float* pp = kbase + (size_t)lk * 128 + (lc ^ 2) * 8;
        float4 pa = *(const float4*)pp, pb = *(const float4*)(pp + 4);
        float pv[8] = {pa.x, pa.y, pa.z, pa.w, pb.x, pb.y, pb.z, pb.w};
        const int kpos = kstart + lk;
        const int pos = lc < 4 ? (kpos >> 6) : (kpos & 63);
#pragma unroll
        for (int j = 0; j < 8; ++j) {
          float2 cs = RT[pos * 16 + (lc & 1) * 8 + j];
          kv[j] = (lc & 2) ? (pv[j] * cs.y + kv[j] * cs.x) : (kv[j] * cs.x - pv[j] * cs.y);
        }
      }
      uint4 o; o.x = pack2(kv[0], kv[1]); o.y = pack2(kv[2], kv[3]); o.z = pack2(kv[4], kv[5]); o.w = pack2(kv[6], kv[7]);
      *(uint4*)(Kl + lk * 128 + ((lc ^ ((lk >> 1) & 7)) << 4)) = o;
      const float* vp = vbase + (size_t)lk * 128 + lc * 8;
      float4 va = *(const float4*)vp, vb = *(const float4*)(vp + 4);
      float vv[8] = {va.x, va.y, va.z, va.w, vb.x, vb.y, vb.z, vb.w};
#pragma unroll
      for (int j = 0; j < 8; ++j) *(bfu*)(Vt + (lc * 8 + j) * 136 + lk * 2) = f2bf(vv[j]);
    }
    __syncthreads();
    f32x16 st[2];
#pragma unroll
    for (int k2 = 0; k2 < 2; ++k2) {
#pragma unroll
      for (int i = 0; i < 16; ++i) st[k2][i] = 0.f;
      const int row = k2 * 32 + ql;
#pragma unroll
      for (int s = 0; s < 4; ++s) {
        bf16x8 a = *(const bf16x8*)(Kl + row * 128 + (((2 * s + h) ^ ((row >> 1) & 7)) << 4));
        st[k2] = __builtin_amdgcn_mfma_f32_32x32x16_bf16(a, qf[s], st[k2], 0, 0, 0);
      }
    }
    if (win) {
#pragma unroll
      for (int k2 = 0; k2 < 2; ++k2)
#pragma unroll
        for (int i = 0; i < 16; ++i) {
          int kpos = kstart + k2 * 32 + (i & 3) + 8 * (i >> 2) + 4 * h;
          int dd = tq - kpos;
          if (dd > 128 || dd < -128) st[k2][i] = -1e30f;
        }
    }
    float mx = -1e30f;
#pragma unroll
    for (int k2 = 0; k2 < 2; ++k2)
#pragma unroll
      for (int i = 0; i < 16; ++i) mx = fmaxf(mx, st[k2][i]);
    mx = fmaxf(mx, __shfl_xor(mx, 32));
    const float mnew = fmaxf(mrun, mx);
    const float alpha = __expf(mrun - mnew);
    mrun = mnew;
    float ps = 0.f;
    bf16x8 pf[2][2];
#pragma unroll
    for (int k2 = 0; k2 < 2; ++k2) {
      float pv[16];
#pragma unroll
      for (int i = 0; i < 16; ++i) { pv[i] = __expf(st[k2][i] - mnew); ps += pv[i]; }
#pragma unroll
      for (int s2 = 0; s2 < 2; ++s2) {
        union { bf16x8 v; unsigned u[4]; } cv;
#pragma unroll
        for (int j = 0; j < 4; ++j) cv.u[j] = pack2(pv[8 * s2 + 2 * j], pv[8 * s2 + 2 * j + 1]);
        pf[k2][s2] = cv.v;
      }
    }
    lsum = lsum * alpha + ps;
#pragma unroll
    for (int dt = 0; dt < 2; ++dt) {
#pragma unroll
      for (int i = 0; i < 16; ++i) oacc[dt][i] *= alpha;
      const char* vrow = Vt + (dt * 32 + ql) * 136;
#pragma unroll
      for (int k2 = 0; k2 < 2; ++k2)
#pragma unroll
        for (int s2 = 0; s2 < 2; ++s2) {
          const int kb = k2 * 32 + 16 * s2 + 4 * h;
          union { bf16x8 v; uint2 u[2]; } av;
          av.u[0] = *(const uint2*)(vrow + kb * 2);
          av.u[1] = *(const uint2*)(vrow + (kb + 8) * 2);
          oacc[dt] = __builtin_amdgcn_mfma_f32_32x32x16_bf16(av.v, pf[k2][s2], oacc[dt], 0, 0, 0);
        }
    }
  }
  const float ltot = lsum + __shfl_xor(lsum, 32);
  const float inv = 1.f / ltot;
  bfu* yo = (bfu*)(P.ws + OFF_YCAT) + (size_t)(tok0 + tq) * 1024 + 512 + head * 64;
#pragma unroll
  for (int dt = 0; dt < 2; ++dt)
#pragma unroll
    for (int q4 = 0; q4 < 4; ++q4) {
      uint2 o; o.x = pack2(oacc[dt][4 * q4] * inv, oacc[dt][4 * q4 + 1] * inv); o.y = pack2(oacc[dt][4 * q4 + 2] * inv, oacc[dt][4 * q4 + 3] * inv);
      *(uint2*)(yo + dt * 32 + 8 * q4 + 4 * h) = o;
    }
  __syncthreads();
}

__device__ __forceinline__ void s5_chunk_info(int ci, bool& isS, int& b, int& ch, int& nch, int& tokbase) {
  isS = ci >= 128;
  if (isS) { b = (ci - 128) >> 7; ch = (ci - 128) & 127; nch = 128; tokbase = 4096 + b * 4096 + ch * 32; }
  else { b = ci >> 3; ch = ci & 7; nch = 8; tokbase = b * 256 + ch * 32; }
}

__device__ __forceinline__ void s5a_item(const Params& P, int l, int ci, char* lds) {
  float* U = (float*)lds;
  bool isS; int b, ch, nch, tokbase; s5_chunk_info(ci, isS, b, ch, nch, tokbase);
  const int tid = tidx(), lane = tid & 63, w = tid >> 6;
  __syncthreads();
  {
    const float4* src = (const float4*)((const float*)(P.ws + OFF_ZB) + (size_t)tokbase * 256);
    for (int i = tid; i < 2048; i += NTHR) ((float4*)U)[i] = src[i];
  }
  __syncthreads();
  const float2* lamb = (const float2*)(P.ws + OFF_LAMB);
  const float2* bbar = (const float2*)(P.ws + OFF_BBAR);
  float2* SE = (float2*)(P.ws + OFF_SE);
#pragma unroll 1
  for (int cb = 0; cb < 4; ++cb) {
    const int g = w * 2 + (cb >> 1), d = cb & 1;
    const int sidx = (d * 16 + g) * 64 + lane;
    float2 Bv[16];
#pragma unroll
    for (int c4 = 0; c4 < 8; ++c4) { float4 t = *(const float4*)(bbar + sidx * 16 + c4 * 2); Bv[2 * c4] = make_float2(t.x, t.y); Bv[2 * c4 + 1] = make_float2(t.z, t.w); }
    const float2 lam = lamb[sidx];
    float2 hs = make_float2(0.f, 0.f);
#pragma unroll 2
    for (int i = 0; i < 32; ++i) {
      const int t = d ? 31 - i : i;
      const float* u = U + t * 256 + g * 16;
      float2 bu = make_float2(0.f, 0.f);
#pragma unroll
      for (int c4 = 0; c4 < 4; ++c4) {
        float4 uv = *(const float4*)(u + 4 * c4);
        bu.x += Bv[4 * c4].x * uv.x + Bv[4 * c4 + 1].x * uv.y + Bv[4 * c4 + 2].x * uv.z + Bv[4 * c4 + 3].x * uv.w;
        bu.y += Bv[4 * c4].y * uv.x + Bv[4 * c4 + 1].y * uv.y + Bv[4 * c4 + 2].y * uv.z + Bv[4 * c4 + 3].y * uv.w;
      }
      float2 t2 = cmul(lam, hs);
      hs = make_float2(t2.x + bu.x, t2.y + bu.y);
    }
    SE[((size_t)ci * 32 + g * 2 + d) * 64 + lane] = hs;
  }
}

__device__ __forceinline__ void s5b_item(const Params& P, int l, int ci, char* lds) {
  float* U = (float*)lds;
  bool isS; int b, ch, nch, tokbase; s5_chunk_info(ci, isS, b, ch, nch, tokbase);
  const int tid = tidx(), lane = tid & 63, w = tid >> 6;
  float2* Hb = (float2*)(lds + 32768) + w * 1024;
  __syncthreads();
  {
    const float4* src = (const float4*)((const float*)(P.ws + OFF_ZB) + (size_t)tokbase * 256);
    for (int i = tid; i < 2048; i += NTHR) ((float4*)U)[i] = src[i];
  }
  __syncthreads();
  const float2* lamb = (const float2*)(P.ws + OFF_LAMB);
  const float2* bbar = (const float2*)(P.ws + OFF_BBAR);
  const float2* SE = (const float2*)(P.ws + OFF_SE);
  const int cbase = ci - ch;
  const int yc = lane & 15, ytq = lane >> 4;
  bfu* YS = (bfu*)(P.ws + OFF_YS5);
#pragma unroll 1
  for (int gi = 0; gi < 2; ++gi) {
    const int g = w * 2 + gi;
    float yacc[2][4];
#pragma unroll
    for (int a = 0; a < 2; ++a)
#pragma unroll
      for (int k = 0; k < 4; ++k) yacc[a][k] = 0.f;
#pragma unroll
    for (int d = 0; d < 2; ++d) {
      const int sidx = (d * 16 + g) * 64 + lane;
      float2 Bv[16];
#pragma unroll
      for (int c4 = 0; c4 < 8; ++c4) { float4 t = *(const float4*)(bbar + sidx * 16 + c4 * 2); Bv[2 * c4] = make_float2(t.x, t.y); Bv[2 * c4 + 1] = make_float2(t.z, t.w); }
      const float2 lam = lamb[sidx];
      float2 lam32 = lam;
#pragma unroll
      for (int i = 0; i < 5; ++i) lam32 = cmul(lam32, lam32);
      float2 hs = make_float2(0.f, 0.f);
      if (isS) {
        const int hidx = (((b * 4 + l) * 2 + d) * 16 + g) * 64 + lane;
        hs = make_float2(P.in[I_SRE][hidx], P.in[I_SIM][hidx]);
      }
      if (d == 0) {
#pragma unroll 4
        for (int j = 0; j < ch; ++j) { float2 e = SE[((size_t)(cbase + j) * 32 + g * 2) * 64 + lane]; float2 t2 = cmul(lam32, hs); hs = make_float2(t2.x + e.x, t2.y + e.y); }
      } else {
#pragma unroll 4
        for (int j = nch - 1; j > ch; --j) { float2 e = SE[((size_t)(cbase + j) * 32 + g * 2 + 1) * 64 + lane]; float2 t2 = cmul(lam32, hs); hs = make_float2(t2.x + e.x, t2.y + e.y); }
      }
      const float* cre = P.in[I_CRE] + ((size_t)((l * 2 + d) * 16 + g) * 16 + yc) * 64;
      const float* cim = P.in[I_CIM] + ((size_t)((l * 2 + d) * 16 + g) * 16 + yc) * 64;
#pragma unroll
      for (int sc = 0; sc < 2; ++sc) {
#pragma unroll 1
        for (int ii = 0; ii < 16; ++ii) {
          const int i = sc * 16 + ii;
          const int t = d ? 31 - i : i;
          const float* u = U + t * 256 + g * 16;
          float2 bu = make_float2(0.f, 0.f);
#pragma unroll
          for (int c4 = 0; c4 < 4; ++c4) {
            float4 uv = *(const float4*)(u + 4 * c4);
            bu.x += Bv[4 * c4].x * uv.x + Bv[4 * c4 + 1].x * uv.y + Bv[4 * c4 + 2].x * uv.z + Bv[4 * c4 + 3].x * uv.w;
            bu.y += Bv[4 * c4].y * uv.x + Bv[4 * c4 + 1].y * uv.y + Bv[4 * c4 + 2].y * uv.z + Bv[4 * c4 + 3].y * uv.w;
          }
          float2 t2 = cmul(lam, hs);
          hs = make_float2(t2.x + bu.x, t2.y + bu.y);
          Hb[ii * 64 + lane] = hs;
        }
        __builtin_amdgcn_fence(__ATOMIC_ACQ_REL, "workgroup");
        __builtin_amdgcn_wave_barrier();
        const int sc2 = d ? 1 - sc : sc;
#pragma unroll 1
        for (int pc = 0; pc < 8; ++pc) {
          float cr[8], cm[8];
#pragma unroll
          for (int q = 0; q < 2; ++q) {
            float4 a = *(const float4*)(cre + pc * 8 + 4 * q), bb = *(const float4*)(cim + pc * 8 + 4 * q);
            cr[4 * q] = a.x; cr[4 * q + 1] = a.y; cr[4 * q + 2] = a.z; cr[4 * q + 3] = a.w;
            cm[4 * q] = bb.x; cm[4 * q + 1] = bb.y; cm[4 * q + 2] = bb.z; cm[4 * q + 3] = bb.w;
          }
#pragma unroll
          for (int k = 0; k < 4; ++k) {
            const int tl = ytq * 4 + k;
            const int rowi = d ? 15 - tl : tl;
            const float4* hp = (const float4*)(Hb + rowi * 64 + pc * 8);
            float s = 0.f;
#pragma unroll
            for (int q = 0; q < 4; ++q) {
              float4 hv = hp[q];
              s += cr[2 * q] * hv.x - cm[2 * q] * hv.y + cr[2 * q + 1] * hv.z - cm[2 * q + 1] * hv.w;
            }
            yacc[sc2][k] += s;
          }
        }
        __builtin_amdgcn_fence(__ATOMIC_ACQ_REL, "workgroup");
        __builtin_amdgcn_wave_barrier();
      }
      if (!isS && ((d == 0 && ch == nch - 1) || (d == 1 && ch == 0))) {
        const int oidx = (((b * 4 + l) * 2 + d) * 16 + g) * 64 + lane;
        P.out[OUT_SRE + oidx] = hs.x; P.out[OUT_SIM + oidx] = hs.y;
      }
    }
    const float sk = P.in[I_S5SKIP][l * 256 + g * 16 + yc];
#pragma unroll
    for (int a = 0; a < 2; ++a)
#pragma unroll
      for (int k = 0; k < 4; ++k) {
        const int t = a * 16 + ytq * 4 + k;
        float y = yacc[a][k] + U[t * 256 + g * 16 + yc] * sk;
        YS[(size_t)(tokbase + t) * 256 + g * 16 + yc] = f2bf(y);
      }
  }
}

constexpr int N_PHASES = 1 + 4 * 11 + 1;

__device__ __forceinline__ void prep_items(const Params& P, int l, int extra_first, char* lds) {
  const int total = CONV_TILES + 68 + 1;
  for (int it = blockIdx.x; it < total; it += gridDim.x) {
    if (it < 68) filt_item(P, l, it, lds);
    else if (it == 68) s5pre_item(P, l);
    else conv_item(P, l, it - 69, lds);
  }
}

__device__ __forceinline__ void mix_phase(const Params& P, int l, char* lds) {
  const int total = 256 + 256 + 256 + 128 + 384;
  for (int it = blockIdx.x; it < total; it += gridDim.x) {
    int i = it;
    if (i < 256) { hyena_sample_item(P, l, i, lds); continue; }
    i -= 256;
    if (i < 256) { attn_item(P, l, 16 + (i >> 7), (i >> 6) & 1, i & 63, lds); continue; }
    i -= 256;
    if (i < 256) { hyena_prompt_item(P, l, i, lds); continue; }
    i -= 256;
    if (i < 128) { attn_item(P, l, i >> 3, (i >> 2) & 1, i & 3, lds); continue; }
    i -= 128;
    s5a_item(P, l, i, lds);
  }
}

__device__ __forceinline__ void run_phase(const Params& P, int ph, char* lds) {
  if (ph == 0) {
    for (int it = blockIdx.x; it < 385; it += gridDim.x) { if (it < 384) ada_item(P, it, lds); else tables_item(P); }
    return;
  }
  if (ph == N_PHASES - 1) { final_phase(P); return; }
  const int l = (ph - 1) / 11, sp = (ph - 1) % 11;
  switch (sp) {
    case 0: prep_items(P, l, 0, lds); break;
    case 1: norm_phase(P, l, 0); break;
    case 2: gemm_in_phase(P, l, lds); break;
    case 3: mix_phase(P, l, lds); break;
    case 4: for (int it = blockIdx.x; it < 384; it += gridDim.x) s5b_item(P, l, it, lds); break;
    case 5: glu_phase(P, l, lds); break;
    case 6: proj_phase(P, l, lds); break;
    case 7: resid_gemm_phase(P, l, 0, lds); break;
    case 8: norm_phase(P, l, 1); break;
    case 9: ffn_up_phase(P, l, lds); break;
    case 10: resid_gemm_phase(P, l, 1, lds); break;
  }
}

__global__ void __launch_bounds__(NTHR) mk(Params P, int lo, int hi) {
  extern __shared__ __attribute__((aligned(16))) char lds[];
  cg::grid_group grid = cg::this_grid();
  for (int ph = lo; ph < hi; ++ph) {
    run_phase(P, ph, lds);
    if (ph + 1 < hi) grid.sync();
  }
}

extern "C" void kernel_launch(void* const* d_in, const int* in_sizes, int n_in, void* d_out, int out_size, void* d_ws, size_t ws_size,
                              hipStream_t stream) {
  static int grid_blocks = 0;
  if (!grid_blocks) {
    int dev = 0, cus = 0, per_cu = 0;
    hipGetDevice(&dev);
    hipDeviceGetAttribute(&cus, hipDeviceAttributeMultiprocessorCount, dev);
    hipFuncSetAttribute((const void*)mk, hipFuncAttributeMaxDynamicSharedMemorySize, LDS_BYTES);
    hipOccupancyMaxActiveBlocksPerMultiprocessor(&per_cu, (const void*)mk, NTHR, LDS_BYTES);
    if (per_cu < 1) per_cu = 1;
    grid_blocks = cus * per_cu;
    if (ws_size < WS_END) fprintf(stderr, "kernel_launch: workspace too small: %zu < %zu\n", ws_size, (size_t)WS_END);
  }
  Params p{};
  for (int i = 0; i < 42; ++i) p.in[i] = (const float*)d_in[i];
  p.out = (float*)d_out; p.ws = (char*)d_ws;
#if MULTI_LAUNCH
  for (int ph = 0; ph < N_PHASES; ++ph) {
    int lo = ph, hi = ph + 1;
    hipLaunchKernelGGL(mk, dim3(grid_blocks), dim3(NTHR), LDS_BYTES, stream, p, lo, hi);
  }
#else
  int lo = 0, hi = N_PHASES;
  void* args[] = {&p, &lo, &hi};
  hipError_t e = hipLaunchCooperativeKernel((const void*)mk, dim3(grid_blocks), dim3(NTHR), args, LDS_BYTES, stream);
  if (e != hipSuccess) fprintf(stderr, "cooperative launch failed: %s (grid %d)\n", hipGetErrorString(e), grid_blocks);
#endif
}
```

```cpp
#include <hip/hip_runtime.h>
#include <hip/hip_cooperative_groups.h>
#include <cstdio>
namespace cg = cooperative_groups;

#ifndef MULTI_LAUNCH
#define MULTI_LAUNCH 0
#endif

typedef __attribute__((ext_vector_type(8))) short bf16x8;
typedef __attribute__((ext_vector_type(16))) float f32x16;
typedef unsigned short bfu;

constexpr int NTHR = 512;
constexpr int TT = 12288;
constexpr int LDS_BYTES = 98304;

enum { I_XP = 0, I_XS, I_CK, I_CV, I_SRE, I_SIM, I_C, I_CCTX, I_ADAW, I_ADAB, I_N1G, I_WIN, I_HCW, I_HCB, I_HW1, I_HB1, I_HW2, I_HB2,
       I_HW3, I_HFREQ, I_HDEC, I_HSKIP, I_LRE, I_LIM, I_LSTEP, I_BRE, I_BIM, I_CRE, I_CIM, I_S5SKIP, I_GLUW, I_GLUB, I_SINK,
       I_PA, I_PB, I_PC, I_WOUT, I_N2G, I_FG, I_FU, I_FD, I_FNG };

constexpr size_t OUT_YP = 0, OUT_YS = 4194304, OUT_K = 12582912, OUT_V = 14680064, OUT_SRE = 16777216, OUT_SIM = 16908288;

constexpr size_t OFF_WIN  = 0;
constexpr size_t OFF_WP   = OFF_WIN + (size_t)4864 * 1024 * 2;
constexpr size_t OFF_WO   = OFF_WP + (size_t)1024 * 1024 * 2;
constexpr size_t OFF_WGU  = OFF_WO + (size_t)1024 * 1024 * 2;
constexpr size_t OFF_WDN  = OFF_WGU + (size_t)5632 * 1024 * 2;
constexpr size_t OFF_WGLU = OFF_WDN + (size_t)1024 * 2816 * 2;
constexpr size_t OFF_X    = OFF_WGLU + (size_t)512 * 256 * 2;
constexpr size_t OFF_AB   = OFF_X + (size_t)TT * 1024 * 4;
constexpr size_t OFF_ZAT  = OFF_AB + (size_t)TT * 1024 * 2;
constexpr size_t OFF_ZB   = OFF_ZAT + (size_t)768 * TT * 4;
constexpr size_t OFF_Q    = OFF_ZB + (size_t)TT * 256 * 4;
constexpr size_t OFF_KS   = OFF_Q + (size_t)TT * 512 * 4;
constexpr size_t OFF_VS   = OFF_KS + (size_t)8192 * 128 * 4;
constexpr size_t OFF_G    = OFF_VS + (size_t)8192 * 128 * 4;
constexpr size_t OFF_YCAT = OFF_G + (size_t)TT * 3072 * 2;
constexpr size_t OFF_YS5  = OFF_YCAT + (size_t)TT * 1024 * 2;
constexpr size_t OFF_FS   = OFF_YS5 + (size_t)TT * 256 * 2;
constexpr size_t OFF_FP   = OFF_FS + (size_t)1024 * 4096 * 4;
constexpr size_t OFF_MOD  = OFF_FP + (size_t)1024 * 256 * 4;
constexpr size_t OFF_TW   = OFF_MOD + (size_t)4 * 3 * 6144 * 4;
constexpr size_t OFF_RT   = OFF_TW + (size_t)4096 * 8;
constexpr size_t OFF_LAMB = OFF_RT + (size_t)64 * 16 * 8;
constexpr size_t OFF_BBAR = OFF_LAMB + (size_t)2048 * 8;
constexpr size_t OFF_SE   = OFF_BBAR + (size_t)2048 * 16 * 8;
constexpr size_t OFF_CAR  = OFF_SE + (size_t)384 * 32 * 64 * 8;
constexpr size_t WS_END   = OFF_CAR + (size_t)384 * 32 * 64 * 8;

struct Params { const float* in[42]; float* out; char* ws; };

__device__ __forceinline__ int tidx() { int t = threadIdx.x; asm volatile("" : "+v"(t)); return t; }
__device__ __forceinline__ bfu f2bf(float f) { unsigned u = __float_as_uint(f); u += 0x7fffu + ((u >> 16) & 1u); return (bfu)(u >> 16); }
__device__ __forceinline__ unsigned pack2(float a, float b) { return (unsigned)f2bf(a) | ((unsigned)f2bf(b) << 16); }
__device__ __forceinline__ float bf2f(bfu v) { return __uint_as_float(((unsigned)v) << 16); }
__device__ __forceinline__ float sigm(float x) { return 1.f / (1.f + __expf(-x)); }
__device__ __forceinline__ float2 cmul(float2 a, float2 b) { return make_float2(a.x * b.x - a.y * b.y, a.x * b.y + a.y * b.x); }
__device__ __forceinline__ int cond_of(int row) { return row < 4096 ? 0 : 1 + ((row - 4096) >> 12); }
__device__ __forceinline__ const float* xrow(const Params& P, int l, int row) {
  if (l > 0) return (const float*)(P.ws + OFF_X) + (size_t)row * 1024;
  return row < 4096 ? P.in[I_XP] + (size_t)row * 1024 : P.in[I_XS] + (size_t)(row - 4096) * 1024;
}

template <int MI>
__device__ __forceinline__ void gemm_core(const bfu* __restrict__ A, int lda, const bfu* __restrict__ B, int ldb, int K,
                                          f32x16 (&acc)[MI][2], char* lds) {
  constexpr int BM = 128 * MI;
  constexpr int A_BYTES = BM * 128, B_BYTES = 128 * 128, STAGE = A_BYTES + B_BYTES;
  const int tid = tidx(), lane = tid & 63, w = tid >> 6;
  const int wm = w & 3, wn = w >> 2, r = lane & 31, h = lane >> 5;
  const int lrow = tid >> 3, lc = tid & 7;
  uint4 ra[2 * MI], rb[2];
  const int nk = K >> 6;
  const bfu* Ap = A + (size_t)lrow * lda + lc * 8;
  const bfu* Bp = B + (size_t)lrow * ldb + lc * 8;
#pragma unroll
  for (int i = 0; i < 2 * MI; ++i) ra[i] = *(const uint4*)(Ap + (size_t)(64 * i) * lda);
#pragma unroll
  for (int i = 0; i < 2; ++i) rb[i] = *(const uint4*)(Bp + (size_t)(64 * i) * ldb);
  {
    char* sa = lds; char* sb = sa + A_BYTES;
#pragma unroll
    for (int i = 0; i < 2 * MI; ++i) { int row = lrow + 64 * i; *(uint4*)(sa + row * 128 + ((lc ^ ((row >> 1) & 7)) << 4)) = ra[i]; }
#pragma unroll
    for (int i = 0; i < 2; ++i) { int row = lrow + 64 * i; *(uint4*)(sb + row * 128 + ((lc ^ ((row >> 1) & 7)) << 4)) = rb[i]; }
  }
  __syncthreads();
  for (int kt = 0; kt < nk; ++kt) {
    if (kt + 1 < nk) {
#pragma unroll
      for (int i = 0; i < 2 * MI; ++i) ra[i] = *(const uint4*)(Ap + (size_t)(64 * i) * lda + (kt + 1) * 64);
#pragma unroll
      for (int i = 0; i < 2; ++i) rb[i] = *(const uint4*)(Bp + (size_t)(64 * i) * ldb + (kt + 1) * 64);
    }
    const char* sa = lds + (kt & 1) * STAGE; const char* sb = sa + A_BYTES;
#pragma unroll
    for (int s = 0; s < 4; ++s) {
      bf16x8 af[MI], bfr[2];
#pragma unroll
      for (int mi = 0; mi < MI; ++mi) { int row = wm * 32 * MI + mi * 32 + r; af[mi] = *(const bf16x8*)(sa + row * 128 + (((2 * s + h) ^ ((row >> 1) & 7)) << 4)); }
#pragma unroll
      for (int ni = 0; ni < 2; ++ni) { int row = wn * 64 + ni * 32 + r; bfr[ni] = *(const bf16x8*)(sb + row * 128 + (((2 * s + h) ^ ((row >> 1) & 7)) << 4)); }
#pragma unroll
      for (int mi = 0; mi < MI; ++mi)
#pragma unroll
        for (int ni = 0; ni < 2; ++ni) acc[mi][ni] = __builtin_amdgcn_mfma_f32_32x32x16_bf16(af[mi], bfr[ni], acc[mi][ni], 0, 0, 0);
    }
    if (kt + 1 < nk) {
      char* da = lds + ((kt + 1) & 1) * STAGE; char* db = da + A_BYTES;
#pragma unroll
      for (int i = 0; i < 2 * MI; ++i) { int row = lrow + 64 * i; *(uint4*)(da + row * 128 + ((lc ^ ((row >> 1) & 7)) << 4)) = ra[i]; }
#pragma unroll
      for (int i = 0; i < 2; ++i) { int row = lrow + 64 * i; *(uint4*)(db + row * 128 + ((lc ^ ((row >> 1) & 7)) << 4)) = rb[i]; }
    }
    __syncthreads();
  }
}

template <int MI>
__device__ __forceinline__ void zero_acc(f32x16 (&acc)[MI][2]) {
#pragma unroll
  for (int mi = 0; mi < MI; ++mi)
#pragma unroll
    for (int ni = 0; ni < 2; ++ni)
#pragma unroll
      for (int i = 0; i < 16; ++i) acc[mi][ni][i] = 0.f;
}

__device__ __forceinline__ int rowmap(int mode, int n) {
  if (mode == 0) return n;
  if (mode == 1) return ((n >> 5) << 6) + (n & 31);
  if (mode == 2) return ((n >> 5) << 6) + 32 + (n & 31);
  if (n < 256) return ((n >> 5) << 6) + (n & 31);
  n -= 256; return ((n >> 5) << 6) + 32 + (n & 31);
}
__device__ __forceinline__ void conv_tile(const float* __restrict__ src, int N, bfu* __restrict__ dst, int ldd, int koff, int mode, int kt, int nt, float* tl) {
  const int tid = tidx();
  {
    int r = tid >> 3, c0 = (tid & 7) * 8;
    const float* s = src + (size_t)(kt * 64 + r) * N + nt * 64 + c0;
    float4 a = *(const float4*)s, b = *(const float4*)(s + 4);
    tl[(c0 + 0) * 65 + r] = a.x; tl[(c0 + 1) * 65 + r] = a.y; tl[(c0 + 2) * 65 + r] = a.z; tl[(c0 + 3) * 65 + r] = a.w;
    tl[(c0 + 4) * 65 + r] = b.x; tl[(c0 + 5) * 65 + r] = b.y; tl[(c0 + 6) * 65 + r] = b.z; tl[(c0 + 7) * 65 + r] = b.w;
  }
  __syncthreads();
  {
    int n = tid >> 3, k0 = (tid & 7) * 8;
    int drow = rowmap(mode, nt * 64 + n);
    const float* t = tl + n * 65 + k0;
    uint4 o; o.x = pack2(t[0], t[1]); o.y = pack2(t[2], t[3]); o.z = pack2(t[4], t[5]); o.w = pack2(t[6], t[7]);
    *(uint4*)(dst + (size_t)drow * ldd + koff + kt * 64 + k0) = o;
  }
  __syncthreads();
}
constexpr int CONV_TILES = 1216 + 64 + 64 + 128 + 256 + 704 + 704 + 704 + 32;
__device__ __forceinline__ void conv_item(const Params& P, int l, int t, char* lds) {
  float* tl = (float*)lds;
  char* ws = P.ws;
  if (t < 1216) { conv_tile(P.in[I_WIN] + (size_t)l * 1024 * 4864, 4864, (bfu*)(ws + OFF_WIN), 1024, 0, 0, t / 76, t % 76, tl); return; }
  t -= 1216;
  if (t < 64) { conv_tile(P.in[I_PA] + (size_t)l * 256 * 1024, 1024, (bfu*)(ws + OFF_WP), 1024, 0, 0, t / 16, t % 16, tl); return; }
  t -= 64;
  if (t < 64) { conv_tile(P.in[I_PB] + (size_t)l * 256 * 1024, 1024, (bfu*)(ws + OFF_WP), 1024, 256, 0, t / 16, t % 16, tl); return; }
  t -= 64;
  if (t < 128) { conv_tile(P.in[I_PC] + (size_t)l * 512 * 1024, 1024, (bfu*)(ws + OFF_WP), 1024, 512, 0, t / 16, t % 16, tl); return; }
  t -= 128;
  if (t < 256) { conv_tile(P.in[I_WOUT] + (size_t)l * 1024 * 1024, 1024, (bfu*)(ws + OFF_WO), 1024, 0, 0, t / 16, t % 16, tl); return; }
  t -= 256;
  if (t < 704) { conv_tile(P.in[I_FG] + (size_t)l * 1024 * 2816, 2816, (bfu*)(ws + OFF_WGU), 1024, 0, 1, t / 44, t % 44, tl); return; }
  t -= 704;
  if (t < 704) { conv_tile(P.in[I_FU] + (size_t)l * 1024 * 2816, 2816, (bfu*)(ws + OFF_WGU), 1024, 0, 2, t / 44, t % 44, tl); return; }
  t -= 704;
  if (t < 704) { conv_tile(P.in[I_FD] + (size_t)l * 2816 * 1024, 1024, (bfu*)(ws + OFF_WDN), 2816, 0, 0, t / 16, t % 16, tl); return; }
  t -= 704;
  conv_tile(P.in[I_GLUW] + (size_t)l * 256 * 512, 512, (bfu*)(ws + OFF_WGLU), 256, 0, 3, t / 8, t % 8, tl);
}

__device__ __forceinline__ void ada_item(const Params& P, int item, char* lds) {
  const int l = item / 96, cc = item % 96;
  float* sc = (float*)lds;
  float* red = sc + 3072;
  const int tid = tidx(), lane = tid & 63, w = tid >> 6;
  for (int i = tid; i < 3072; i += NTHR) {
    int cnd = i >> 10, k = i & 1023;
    float v = cnd == 0 ? P.in[I_CCTX][k] : P.in[I_C][(cnd - 1) * 1024 + k];
    sc[i] = v * sigm(v);
  }
  __syncthreads();
  const float* wp = P.in[I_ADAW] + (size_t)l * 1024 * 6144 + cc * 64 + lane;
  float a0 = 0.f, a1 = 0.f, a2 = 0.f;
#pragma unroll 8
  for (int k = w * 128; k < w * 128 + 128; ++k) {
    float wv = wp[(size_t)k * 6144];
    a0 += sc[k] * wv; a1 += sc[1024 + k] * wv; a2 += sc[2048 + k] * wv;
  }
  red[(w * 3 + 0) * 64 + lane] = a0; red[(w * 3 + 1) * 64 + lane] = a1; red[(w * 3 + 2) * 64 + lane] = a2;
  __syncthreads();
  if (tid < 192) {
    int cnd = tid >> 6, c = tid & 63;
    float s = P.in[I_ADAB][l * 6144 + cc * 64 + c];
#pragma unroll
    for (int ww = 0; ww < 8; ++ww) s += red[(ww * 3 + cnd) * 64 + c];
    ((float*)(P.ws + OFF_MOD))[(l * 3 + cnd) * 6144 + cc * 64 + c] = s;
  }
  __syncthreads();
}

__device__ __forceinline__ void tables_item(const Params& P) {
  float2* tw = (float2*)(P.ws + OFF_TW);
  float2* rt = (float2*)(P.ws + OFF_RT);
  for (int k = tidx(); k < 4096; k += NTHR) { float s, c; sincospif((float)k / 4096.f, &s, &c); tw[k] = make_float2(c, -s); }
  for (int i = tidx(); i < 1024; i += NTHR) {
    int pos = i >> 4, f = i & 15;
    float inv = powf(10000.f, -(float)f / 16.f);
    float ang = (float)pos * inv;
    rt[i] = make_float2(cosf(ang), sinf(ang));
  }
}

__device__ __forceinline__ void filt_item(const Params& P, int l, int item, char* lds) {
  const bool isS = item >= 4;
  const int L = isS ? 4096 : 256;
  const int pb = isS ? item - 4 : item;
  float* F = (float*)(P.ws + (isS ? OFF_FS : OFF_FP));
  float* feat = (float*)lds;
  float* h1 = feat + 64 * 33;
  float* h2 = h1 + 64 * 65;
  const int tid = tidx();
  const int pos0 = pb * 64;
  const float tstep = 1.f / (float)(L - 1);
  for (int idx = tid; idx < 64 * 33; idx += NTHR) {
    int p = idx / 33, f = idx % 33;
    int pos = pos0 + p;
    float val;
    if (f == 0) val = (float)pos * tstep;
    else {
      int bi = (f - 1) & 15;
      float fr = (float)bi / 15.f;
      float band = 1e-4f * (1.f - fr) + 15.f * fr;
      float wv = 2.f * 3.14159265358979323846f * (float)pos / (float)L;
      float ang = wv * band;
      val = (f <= 16) ? cosf(ang) : -sinf(ang);
    }
    feat[idx] = val;
  }
  __syncthreads();
  const float* w1 = P.in[I_HW1] + (size_t)l * 33 * 64;
  const float* b1 = P.in[I_HB1] + l * 64;
  const float* w2 = P.in[I_HW2] + (size_t)l * 64 * 64;
  const float* b2 = P.in[I_HB2] + l * 64;
  const float* fq = P.in[I_HFREQ] + l * 64;
  for (int idx = tid; idx < 4096; idx += NTHR) {
    int p = idx >> 6, u = idx & 63;
    float s = b1[u];
    for (int f = 0; f < 33; ++f) s += feat[p * 33 + f] * w1[f * 64 + u];
    h1[p * 65 + u] = sinf(fq[u] * s);
  }
  __syncthreads();
  for (int idx = tid; idx < 4096; idx += NTHR) {
    int p = idx >> 6, u = idx & 63;
    float s = b2[u];
    for (int k = 0; k < 64; ++k) s += h1[p * 65 + k] * w2[k * 64 + u];
    h2[p * 65 + u] = sinf(fq[u] * s);
  }
  __syncthreads();
  const int lane = tid & 63, w = tid >> 6;
  float hr[64];
#pragma unroll
  for (int k = 0; k < 64; ++k) hr[k] = h2[lane * 65 + k];
  const float* w3 = P.in[I_HW3] + (size_t)l * 64 * 1024;
  const float* dec = P.in[I_HDEC] + l * 1024;
  const float tpos = (float)(pos0 + lane) * tstep;
  float* Wl = h2 + 64 * 65;
#pragma unroll 1
  for (int chunk = 0; chunk < 8; ++chunk) {
    __syncthreads();
    for (int i = tid; i < 2048; i += NTHR) {
      int k = i >> 5, c4 = i & 31;
      *(float4*)(Wl + k * 128 + c4 * 4) = *(const float4*)(w3 + k * 1024 + chunk * 128 + c4 * 4);
    }
    __syncthreads();
#pragma unroll 1
    for (int cgp = 0; cgp < 4; ++cgp) {
      const int cl = w * 16 + cgp * 4;
      float a0 = 0.f, a1 = 0.f, a2 = 0.f, a3 = 0.f;
#pragma unroll
      for (int k = 0; k < 64; ++k) {
        float4 wv = *(const float4*)(Wl + k * 128 + cl);
        a0 += hr[k] * wv.x; a1 += hr[k] * wv.y; a2 += hr[k] * wv.z; a3 += hr[k] * wv.w;
      }
      const int col = chunk * 128 + cl;
      F[(size_t)(col + 0) * L + pos0 + lane] = a0 * __expf(-tpos * fabsf(dec[col + 0]));
      F[(size_t)(col + 1) * L + pos0 + lane] = a1 * __expf(-tpos * fabsf(dec[col + 1]));
      F[(size_t)(col + 2) * L + pos0 + lane] = a2 * __expf(-tpos * fabsf(dec[col + 2]));
      F[(size_t)(col + 3) * L + pos0 + lane] = a3 * __expf(-tpos * fabsf(dec[col + 3]));
    }
  }
  __syncthreads();
}

__device__ __forceinline__ void s5pre_item(const Params& P, int l) {
  float2* lamb = (float2*)(P.ws + OFF_LAMB);
  float2* bbar = (float2*)(P.ws + OFF_BBAR);
  for (int idx = tidx(); idx < 2048; idx += NTHR) {
    float lre = P.in[I_LRE][l * 2048 + idx], lim = P.in[I_LIM][l * 2048 + idx];
    float step = expf(P.in[I_LSTEP][l * 32 + (idx >> 6)]);
    float er = expf(lre * step), sn, cs; sincosf(lim * step, &sn, &cs);
    float2 lb = make_float2(er * cs, er * sn);
    lamb[idx] = lb;
    float2 num = make_float2(lb.x - 1.f, lb.y);
    float den = lre * lre + lim * lim;
    float2 coef = make_float2((num.x * lre + num.y * lim) / den, (num.y * lre - num.x * lim) / den);
    const float* br = P.in[I_BRE] + ((size_t)l * 2048 + idx) * 16;
    const float* bi = P.in[I_BIM] + ((size_t)l * 2048 + idx) * 16;
    for (int c = 0; c < 16; ++c) bbar[idx * 16 + c] = cmul(coef, make_float2(br[c], bi[c]));
  }
}

__device__ __forceinline__ void norm_phase(const Params& P, int l, int which) {
  const int lane = tidx() & 63, w = tidx() >> 6;
  const float* gam = P.in[which ? I_N2G : I_N1G] + l * 1024;
  bfu* AB = (bfu*)(P.ws + OFF_AB);
  for (int row = blockIdx.x * 8 + w; row < TT; row += gridDim.x * 8) {
    const float* x = which ? (const float*)(P.ws + OFF_X) + (size_t)row * 1024 : xrow(P, l, row);
    const float* md = (const float*)(P.ws + OFF_MOD) + (l * 3 + cond_of(row)) * 6144 + which * 3072;
    float4 v[4]; float ss = 0.f;
#pragma unroll
    for (int i = 0; i < 4; ++i) { v[i] = *(const float4*)(x + i * 256 + lane * 4); ss += v[i].x * v[i].x + v[i].y * v[i].y + v[i].z * v[i].z + v[i].w * v[i].w; }
#pragma unroll
    for (int o = 32; o > 0; o >>= 1) ss += __shfl_xor(ss, o);
    float rs = rsqrtf(ss * (1.f / 1024.f) + 1e-6f);
#pragma unroll
    for (int i = 0; i < 4; ++i) {
      int c = i * 256 + lane * 4;
      float4 g = *(const float4*)(gam + c), sh = *(const float4*)(md + c), sc = *(const float4*)(md + 1024 + c);
      float o0 = v[i].x * rs * g.x * (1.f + sc.x) + sh.x, o1 = v[i].y * rs * g.y * (1.f + sc.y) + sh.y;
      float o2 = v[i].z * rs * g.z * (1.f + sc.z) + sh.z, o3 = v[i].w * rs * g.w * (1.f + sc.w) + sh.w;
      uint2 o; o.x = pack2(o0, o1); o.y = pack2(o2, o3);
      *(uint2*)(AB + (size_t)row * 1024 + c) = o;
    }
  }
}
__device__ __forceinline__ void final_phase(const Params& P) {
  const int lane = tidx() & 63, w = tidx() >> 6;
  const float* gam = P.in[I_FNG];
  for (int row = blockIdx.x * 8 + w; row < TT; row += gridDim.x * 8) {
    const float* x = (const float*)(P.ws + OFF_X) + (size_t)row * 1024;
    float* y = P.out + (size_t)row * 1024;
    float4 v[4]; float ss = 0.f;
#pragma unroll
    for (int i = 0; i < 4; ++i) { v[i] = *(const float4*)(x + i * 256 + lane * 4); ss += v[i].x * v[i].x + v[i].y * v[i].y + v[i].z * v[i].z + v[i].w * v[i].w; }
#pragma unroll
    for (int o = 32; o > 0; o >>= 1) ss += __shfl_xor(ss, o);
    float rs = rsqrtf(ss * (1.f / 1024.f) + 1e-6f);
#pragma unroll
    for (int i = 0; i < 4; ++i) {
      int c = i * 256 + lane * 4;
      float4 g = *(const float4*)(gam + c);
      *(float4*)(y + c) = make_float4(v[i].x * rs * g.x, v[i].y * rs * g.y, v[i].z * rs * g.z, v[i].w * rs * g.w);
    }
  }
}

__device__ __forceinline__ int tile_slots(int MT, int NT) { return (MT >> 3) * ((NT + 3) >> 2) * 32; }
__device__ __forceinline__ bool tile_map(int it, int MT, int NT, int& mt, int& nt) {
  int T = it;
  if (gridDim.x == 256) { const int b = it & 255, j = it >> 8; T = ((j * 8 + (b & 7)) << 5) + (b >> 3); }
  const int patch = T >> 5, ip = T & 31, pmc = MT >> 3;
  mt = (patch % pmc) * 8 + (ip & 7); nt = (patch / pmc) * 4 + (ip >> 3);
  return nt < NT && T < tile_slots(MT, NT);
}
#define TILE_LOOP(MT_, NT_) const int nslots_ = (tile_slots(MT_, NT_) + 255) / 256 * 256; \
  for (int it_ = blockIdx.x; it_ < nslots_; it_ += gridDim.x) { int mt, nt; if (!tile_map(it_, MT_, NT_, mt, nt)) continue;

#define EPI_ROW(MI_, mi, reg) (wm * 32 * MI_ + (mi) * 32 + ((reg) & 3) + 8 * ((reg) >> 2) + 4 * h)

__device__ __forceinline__ void gemm_in_phase(const Params& P, int l, char* lds) {
  const int tid = tidx(), lane = tid & 63, w = tid >> 6, wm = w & 3, wn = w >> 2, r = lane & 31, h = lane >> 5;
  const bfu* A = (const bfu*)(P.ws + OFF_AB);
  const bfu* B = (const bfu*)(P.ws + OFF_WIN);
  TILE_LOOP(48, 38)
    const int m0 = mt * 256, n0 = nt * 128;
    f32x16 acc[2][2]; zero_acc<2>(acc);
    gemm_core<2>(A + (size_t)m0 * 1024, 1024, B + (size_t)n0 * 1024, 1024, 1024, acc, lds);
#pragma unroll
    for (int mi = 0; mi < 2; ++mi)
#pragma unroll
      for (int ni = 0; ni < 2; ++ni) {
        const int col = n0 + wn * 64 + ni * 32 + r;
        if (n0 < 768) {
          float* zt = (float*)(P.ws + OFF_ZAT) + (size_t)col * TT;
#pragma unroll
          for (int q4 = 0; q4 < 4; ++q4) {
            int row = m0 + wm * 64 + mi * 32 + 8 * q4 + 4 * h;
            *(float4*)(zt + row) = make_float4(acc[mi][ni][4 * q4], acc[mi][ni][4 * q4 + 1], acc[mi][ni][4 * q4 + 2], acc[mi][ni][4 * q4 + 3]);
          }
        } else {
#pragma unroll
          for (int reg = 0; reg < 16; ++reg) {
            const int row = m0 + EPI_ROW(2, mi, reg);
            const float v = acc[mi][ni][reg];
            if (n0 < 1024) ((float*)(P.ws + OFF_ZB))[(size_t)row * 256 + col - 768] = v;
            else if (n0 < 1536) ((float*)(P.ws + OFF_Q))[(size_t)row * 512 + col - 1024] = v;
            else if (n0 < 1792) {
              const bool isv = n0 >= 1664;
              const int c = col - (isv ? 1664 : 1536);
              if (row < 4096) P.out[(isv ? OUT_V : OUT_K) + ((size_t)((row >> 8) * 4 + l) * 256 + (row & 255)) * 128 + c] = v;
              else ((float*)(P.ws + (isv ? OFF_VS : OFF_KS)))[(size_t)(row - 4096) * 128 + c] = v;
            } else ((bfu*)(P.ws + OFF_G))[(size_t)row * 3072 + col - 1792] = f2bf(sigm(v));
          }
        }
      }
  }
}

__device__ __forceinline__ void glu_phase(const Params& P, int l, char* lds) {
  const int tid = tidx(), lane = tid & 63, w = tid >> 6, wm = w & 3, wn = w >> 2, r = lane & 31, h = lane >> 5;
  const bfu* A = (const bfu*)(P.ws + OFF_YS5);
  const bfu* B = (const bfu*)(P.ws + OFF_WGLU);
  const float* bias = P.in[I_GLUB] + l * 512;
  bfu* YC = (bfu*)(P.ws + OFF_YCAT);
  TILE_LOOP(96, 4)
    const int m0 = mt * 128;
    f32x16 acc[1][2]; zero_acc<1>(acc);
    gemm_core<1>(A + (size_t)m0 * 256, 256, B + (size_t)(nt * 128) * 256, 256, 256, acc, lds);
    const int cj = nt * 64 + wn * 32 + r;
    const float ba = bias[cj], bg = bias[256 + cj];
#pragma unroll
    for (int reg = 0; reg < 16; ++reg) {
      const int row = m0 + EPI_ROW(1, 0, reg);
      float a = acc[0][0][reg] + ba, g = acc[0][1][reg] + bg;
      YC[(size_t)row * 1024 + 256 + cj] = f2bf(a * sigm(g));
    }
  }
}

__device__ __forceinline__ void proj_phase(const Params& P, int l, char* lds) {
  const int tid = tidx(), lane = tid & 63, w = tid >> 6, wm = w & 3, wn = w >> 2, r = lane & 31, h = lane >> 5;
  const bfu* A = (const bfu*)(P.ws + OFF_YCAT);
  const bfu* B = (const bfu*)(P.ws + OFF_WP);
  const bfu* G = (const bfu*)(P.ws + OFF_G);
  bfu* AB = (bfu*)(P.ws + OFF_AB);
  TILE_LOOP(96, 8)
    const int m0 = mt * 128, n0 = nt * 128;
    f32x16 mg[2];
#pragma unroll
    for (int ni = 0; ni < 2; ++ni)
#pragma unroll
      for (int i = 0; i < 16; ++i) mg[ni][i] = 0.f;
#pragma unroll 1
    for (int seg = 0; seg < 3; ++seg) {
      const int koff = seg * 256, klen = seg == 2 ? 512 : 256;
      f32x16 acc[1][2]; zero_acc<1>(acc);
      gemm_core<1>(A + (size_t)m0 * 1024 + koff, 1024, B + (size_t)n0 * 1024 + koff, 1024, klen, acc, lds);
#pragma unroll
      for (int ni = 0; ni < 2; ++ni) {
        const int col = n0 + wn * 64 + ni * 32 + r;
#pragma unroll
        for (int reg = 0; reg < 16; ++reg) {
          const int row = m0 + EPI_ROW(1, 0, reg);
          mg[ni][reg] += bf2f(G[(size_t)row * 3072 + seg * 1024 + col]) * acc[0][ni][reg];
        }
      }
    }
#pragma unroll
    for (int ni = 0; ni < 2; ++ni) {
      const int col = n0 + wn * 64 + ni * 32 + r;
#pragma unroll
      for (int reg = 0; reg < 16; ++reg) AB[(size_t)(m0 + EPI_ROW(1, 0, reg)) * 1024 + col] = f2bf(mg[ni][reg]);
    }
  }
}

__device__ __forceinline__ void resid_gemm_phase(const Params& P, int l, int which, char* lds) {
  const int tid = tidx(), lane = tid & 63, w = tid >> 6, wm = w & 3, wn = w >> 2, r = lane & 31, h = lane >> 5;
  const bfu* A = (const bfu*)(P.ws + (which ? OFF_G : OFF_AB));
  const int lda = which ? 2816 : 1024;
  const bfu* B = (const bfu*)(P.ws + (which ? OFF_WDN : OFF_WO));
  float* X = (float*)(P.ws + OFF_X);
  TILE_LOOP(96, 8)
    const int m0 = mt * 128, n0 = nt * 128;
    f32x16 acc[1][2]; zero_acc<1>(acc);
    gemm_core<1>(A + (size_t)m0 * lda, lda, B + (size_t)n0 * lda, lda, lda, acc, lds);
    const float* gate = (const float*)(P.ws + OFF_MOD) + (l * 3 + cond_of(m0)) * 6144 + (which ? 5120 : 2048);
#pragma unroll
    for (int ni = 0; ni < 2; ++ni) {
      const int col = n0 + wn * 64 + ni * 32 + r;
      const float gv = gate[col];
#pragma unroll
      for (int reg = 0; reg < 16; ++reg) {
        const int row = m0 + EPI_ROW(1, 0, reg);
        const float xin = which ? X[(size_t)row * 1024 + col] : xrow(P, l, row)[col];
        X[(size_t)row * 1024 + col] = xin + gv * acc[0][ni][reg];
      }
    }
  }
}

__device__ __forceinline__ void ffn_up_phase(const Params& P, int l, char* lds) {
  const int tid = tidx(), lane = tid & 63, w = tid >> 6, wm = w & 3, wn = w >> 2, r = lane & 31, h = lane >> 5;
  const bfu* A = (const bfu*)(P.ws + OFF_AB);
  const bfu* B = (const bfu*)(P.ws + OFF_WGU);
  bfu* HID = (bfu*)(P.ws + OFF_G);
  TILE_LOOP(48, 44)
    const int m0 = mt * 256;
    f32x16 acc[2][2]; zero_acc<2>(acc);
    gemm_core<2>(A + (size_t)m0 * 1024, 1024, B + (size_t)(nt * 128) * 1024, 1024, 1024, acc, lds);
    const int cj = nt * 64 + wn * 32 + r;
#pragma unroll
    for (int mi = 0; mi < 2; ++mi)
#pragma unroll
      for (int reg = 0; reg < 16; ++reg) {
        const int row = m0 + EPI_ROW(2, mi, reg);
        float g = acc[mi][0][reg], u = acc[mi][1][reg];
        HID[(size_t)row * 2816 + cj] = f2bf(g * sigm(g) * u);
      }
  }
}

__device__ __forceinline__ float short_conv(const float* __restrict__ z, int t, int L, float w0, float w1, float w2, float b) {
  float s = b + w1 * z[t];
  if (t > 0) s += w0 * z[t - 1];
  if (t < L - 1) s += w2 * z[t + 1];
  return s;
}

__device__ __forceinline__ void fft_fwd(float2* data, const float2* tw) {
  const int tid = tidx();
  for (int s = 12; s >= 0; --s) {
    const int half = 1 << s;
#pragma unroll
    for (int it = 0; it < 8; ++it) {
      int i = tid + it * NTHR;
      int j = i & (half - 1);
      int base = ((i >> s) << (s + 1)) | j;
      float2 a = data[base], b = data[base + half], wv = tw[j << (12 - s)];
      data[base] = make_float2(a.x + b.x, a.y + b.y);
      data[base + half] = cmul(make_float2(a.x - b.x, a.y - b.y), wv);
    }
    __syncthreads();
  }
}
__device__ __forceinline__ void fft_inv(float2* data, const float2* tw) {
  const int tid = tidx();
  for (int s = 0; s <= 12; ++s) {
    const int half = 1 << s;
#pragma unroll
    for (int it = 0; it < 8; ++it) {
      int i = tid + it * NTHR;
      int j = i & (half - 1);
      int base = ((i >> s) << (s + 1)) | j;
      float2 wv = tw[j << (12 - s)]; wv.y = -wv.y;
      float2 a = data[base], b = cmul(data[base + half], wv);
      data[base] = make_float2(a.x + b.x, a.y + b.y);
      data[base + half] = make_float2(a.x - b.x, a.y - b.y);
    }
    __syncthreads();
  }
}
__device__ __forceinline__ float block_sum(float v, float* red) {
  const int lane = tidx() & 63, w = tidx() >> 6;
#pragma unroll
  for (int o = 32; o > 0; o >>= 1) v += __shfl_xor(v, o);
  __syncthreads();
  if (lane == 0) red[w] = v;
  __syncthreads();
  float s = 0.f;
#pragma unroll
  for (int i = 0; i < 8; ++i) s += red[i];
  return s;
}

__device__ __forceinline__ void hyena_sample_item(const Params& P, int l, int c, char* lds) {
  float2* data = (float2*)lds;
  float2* tw = data + 8192;
  __shared__ float red[8];
  const int tid = tidx();
  const int L = 4096;
  const float* FS = (const float*)(P.ws + OFF_FS);
  const float* ZAT = (const float*)(P.ws + OFF_ZAT);
  const float* cw = P.in[I_HCW] + l * 3 * 768;
  const float* cb = P.in[I_HCB] + l * 768;
  {
    const float2* twg = (const float2*)(P.ws + OFF_TW);
    for (int i = tid; i < 4096; i += NTHR) tw[i] = twg[i];
  }
  float2 vreg[8];
#pragma unroll
  for (int o = 0; o < 2; ++o) {
    const float* hf = FS + (size_t)((o * 2 + 0) * 256 + c) * L;
    const float* hb = FS + (size_t)((o * 2 + 1) * 256 + c) * L;
    float asum = 0.f;
#pragma unroll
    for (int m = 0; m < 16; ++m) {
      int n = tid + m * NTHR;
      float v = n < L ? hf[n] : (n == L ? 0.f : hb[2 * L - n]);
      asum += fabsf(v);
      data[n] = make_float2(v, 0.f);
    }
    float nrm = block_sum(asum, red);
    fft_fwd(data, tw);
    float2 Kf[16];
    const float ksc = 1.f / (nrm * 8192.f);
#pragma unroll
    for (int m = 0; m < 16; ++m) { float2 v = data[tid + m * NTHR]; Kf[m] = make_float2(v.x * ksc, v.y * ksc); }
    __syncthreads();
    if (o == 0) {
      const float w0 = cw[c], w1 = cw[768 + c], w2 = cw[1536 + c], b = cb[c];
      const float* z0 = ZAT + (size_t)c * TT + 4096;
#pragma unroll
      for (int m = 0; m < 8; ++m) {
        int t = tid + m * NTHR;
        vreg[m] = make_float2(short_conv(z0, t, L, w0, w1, w2, b), short_conv(z0 + 4096, t, L, w0, w1, w2, b));
      }
    }
#pragma unroll
    for (int m = 0; m < 8; ++m) { int t = tid + m * NTHR; data[t] = vreg[m]; data[t + L] = make_float2(0.f, 0.f); }
    __syncthreads();
    fft_fwd(data, tw);
#pragma unroll
    for (int m = 0; m < 16; ++m) { int n = tid + m * NTHR; data[n] = cmul(data[n], Kf[m]); }
    __syncthreads();
    fft_inv(data, tw);
    {
      const int gc = (o + 1) * 256 + c;
      const float w0 = cw[gc], w1 = cw[768 + gc], w2 = cw[1536 + gc], b = cb[gc];
      const float* zg = ZAT + (size_t)gc * TT + 4096;
      const float sk = P.in[I_HSKIP][(l * 2 + o) * 256 + c];
#pragma unroll
      for (int m = 0; m < 8; ++m) {
        int t = tid + m * NTHR;
        float2 y = data[t];
        float g0 = short_conv(zg, t, L, w0, w1, w2, b), g1 = short_conv(zg + 4096, t, L, w0, w1, w2, b);
        vreg[m] = make_float2(g0 * (y.x + sk * vreg[m].x), g1 * (y.y + sk * vreg[m].y));
      }
    }
    __syncthreads();
  }
  bfu* YC = (bfu*)(P.ws + OFF_YCAT);
#pragma unroll
  for (int m = 0; m < 8; ++m) {
    int t = tid + m * NTHR;
    YC[(size_t)(4096 + t) * 1024 + c] = f2bf(vreg[m].x);
    YC[(size_t)(8192 + t) * 1024 + c] = f2bf(vreg[m].y);
  }
}

__device__ __forceinline__ void hyena_prompt_item(const Params& P, int l, int c, char* lds) {
  float* V = (float*)lds;
  float* KF = V + 4096;
  __shared__ float red[8];
  const int tid = tidx();
  const int L = 256;
  const float* FP = (const float*)(P.ws + OFF_FP);
  const float* ZAT = (const float*)(P.ws + OFF_ZAT);
  const float* cw = P.in[I_HCW] + l * 3 * 768;
  const float* cb = P.in[I_HCB] + l * 768;
#pragma unroll
  for (int o = 0; o < 2; ++o) {
    const float* hf = FP + (size_t)((o * 2 + 0) * 256 + c) * L;
    const float* hb = FP + (size_t)((o * 2 + 1) * 256 + c) * L;
    int d = tid - 255;
    float v = (tid == 511) ? 0.f : (d >= 0 ? hf[d] : hb[-d]);
    float nrm = block_sum(fabsf(v), red);
    KF[o * 512 + tid] = v / nrm;
  }
  const int seq = tid >> 5, t0 = (tid & 31) * 8;
  float vr[8];
  {
    const float w0 = cw[c], w1 = cw[768 + c], w2 = cw[1536 + c], b = cb[c];
    const float* z0 = ZAT + (size_t)c * TT + seq * 256;
#pragma unroll
    for (int i = 0; i < 8; ++i) { vr[i] = short_conv(z0, t0 + i, L, w0, w1, w2, b); V[seq * 256 + t0 + i] = vr[i]; }
  }
  __syncthreads();
#pragma unroll
  for (int o = 0; o < 2; ++o) {
    float acc[8];
#pragma unroll
    for (int i = 0; i < 8; ++i) acc[i] = 0.f;
    const float* kf = KF + o * 512;
    const float* u = V + seq * 256;
    for (int s0 = 0; s0 < 256; s0 += 8) {
      float kk[16], uu[8];
      const int kb = 248 + t0 - s0;
#pragma unroll
      for (int i = 0; i < 4; ++i) { float4 t4 = *(const float4*)(kf + kb + 4 * i); kk[4 * i] = t4.x; kk[4 * i + 1] = t4.y; kk[4 * i + 2] = t4.z; kk[4 * i + 3] = t4.w; }
#pragma unroll
      for (int i = 0; i < 2; ++i) { float4 t4 = *(const float4*)(u + s0 + 4 * i); uu[4 * i] = t4.x; uu[4 * i + 1] = t4.y; uu[4 * i + 2] = t4.z; uu[4 * i + 3] = t4.w; }
#pragma unroll
      for (int a = 0; a < 8; ++a)
#pragma unroll
        for (int i = 0; i < 8; ++i) acc[i] += kk[i - a + 7] * uu[a];
    }
    const int gc = (o + 1) * 256 + c;
    const float w0 = cw[gc], w1 = cw[768 + gc], w2 = cw[1536 + gc], b = cb[gc];
    const float* zg = ZAT + (size_t)gc * TT + seq * 256;
    const float sk = P.in[I_HSKIP][(l * 2 + o) * 256 + c];
    __syncthreads();
#pragma unroll
    for (int i = 0; i < 8; ++i) {
      float g = short_conv(zg, t0 + i, L, w0, w1, w2, b);
      vr[i] = g * (acc[i] + sk * vr[i]);
      V[seq * 256 + t0 + i] = vr[i];
    }
    __syncthreads();
  }
  bfu* YC = (bfu*)(P.ws + OFF_YCAT);
#pragma unroll
  for (int i = 0; i < 8; ++i) YC[(size_t)(seq * 256 + t0 + i) * 1024 + c] = f2bf(vr[i]);
}

__device__ __forceinline__ void attn_item(const Params& P, int l, int seq, int g, int qb, char* lds) {
  char* Kl = lds;
  char* Vt = lds + 8192;
  const int tid = tidx(), lane = tid & 63, w = tid >> 6;
  const bool isS = seq >= 16;
  const int b = isS ? seq - 16 : seq;
  const int L = isS ? 4096 : 256;
  const int tok0 = isS ? 4096 + b * 4096 : b * 256;
  const int q0 = qb * 64;
  const int rr = w >> 1, qs = w & 1, ql = lane & 31, h = lane >> 5;
  const int tq = q0 + qs * 32 + ql;
  const int head = g * 4 + rr;
  const float2* RT = (const float2*)(P.ws + OFF_RT);
  bf16x8 qf[4];
  {
    const float* qp = (const float*)(P.ws + OFF_Q) + (size_t)(tok0 + tq) * 512 + head * 64 + 8 * h;
    float qv[4][8];
#pragma unroll
    for (int s = 0; s < 4; ++s) {
      float4 a = *(const float4*)(qp + 16 * s), bq = *(const float4*)(qp + 16 * s + 4);
      qv[s][0] = a.x; qv[s][1] = a.y; qv[s][2] = a.z; qv[s][3] = a.w; qv[s][4] = bq.x; qv[s][5] = bq.y; qv[s][6] = bq.z; qv[s][7] = bq.w;
    }
    if (isS) {
#pragma unroll
      for (int hp = 0; hp < 2; ++hp) {
        const int pos = hp == 0 ? (tq >> 6) : (tq & 63);
#pragma unroll
        for (int j = 0; j < 8; ++j) {
          float2 cs = RT[pos * 16 + 8 * h + j];
          float x1 = qv[2 * hp][j], x2 = qv[2 * hp + 1][j];
          qv[2 * hp][j] = x1 * cs.x - x2 * cs.y;
          qv[2 * hp + 1][j] = x1 * cs.y + x2 * cs.x;
        }
      }
    }
#pragma unroll
    for (int s = 0; s < 4; ++s) {
      union { bf16x8 v; unsigned u[4]; } cv;
#pragma unroll
      for (int j = 0; j < 4; ++j) cv.u[j] = pack2(qv[s][2 * j] * 0.125f, qv[s][2 * j + 1] * 0.125f);
      qf[s] = cv.v;
    }
  }
  float mrun = P.in[I_SINK][l * 8 + head];
  float lsum = h == 0 ? 1.f : 0.f;
  f32x16 oacc[2];
#pragma unroll
  for (int dt = 0; dt < 2; ++dt)
#pragma unroll
    for (int i = 0; i < 16; ++i) oacc[dt][i] = 0.f;

  const int ntile = isS ? 13 : 4;
  const int lk = tid & 63, lc = tid >> 6;
  for (int ti = 0; ti < ntile; ++ti) {
    int kstart = 0; bool win = false;
    const float* kbase; const float* vbase;
    if (!isS) {
      kstart = ti * 64;
      kbase = P.out + OUT_K + ((size_t)(b * 4 + l) * 256 + kstart) * 128 + g * 64;
      vbase = P.out + OUT_V + ((size_t)(b * 4 + l) * 256 + kstart) * 128 + g * 64;
    } else if (ti < 8) {
      kstart = ti * 64;
      kbase = P.in[I_CK] + ((size_t)(b * 4 + l) * 512 + kstart) * 128 + g * 64;
      vbase = P.in[I_CV] + ((size_t)(b * 4 + l) * 512 + kstart) * 128 + g * 64;
    } else {
      kstart = q0 - 128 + (ti - 8) * 64; win = true;
      if (kstart < 0 || kstart >= L) continue;
      kbase = (const float*)(P.ws + OFF_KS) + ((size_t)b * 4096 + kstart) * 128 + g * 64;
      vbase = (const float*)(P.ws + OFF_VS) + ((size_t)b * 4096 + kstart) * 128 + g * 64;
    }
    __syncthreads();
    {
      const float* kp = kbase + (size_t)lk * 128 + lc * 8;
      float4 a = *(const float4*)kp, bq = *(const float4*)(kp + 4);
      float kv[8] = {a.x, a.y, a.z, a.w, bq.x, bq.y, bq.z, bq.w};
      if (win) {
        const float* pp = kbase + (size_t)lk * 128 + (lc ^ 2) * 8;
        float4 pa = *(const float4*)pp, pb = *(const float4*)(pp + 4);
        float pv[8] = {pa.x, pa.y, pa.z, pa.w, pb.x, pb.y, pb.z, pb.w};
        const int kpos = kstart + lk;
        const int pos = lc < 4 ? (kpos >> 6) : (kpos & 63);
#pragma unroll
        for (int j = 0; j < 8; ++j) {
          float2 cs = RT[pos * 16 + (lc & 1) * 8 + j];
          kv[j] = (lc & 2) ? (pv[j] * cs.y + kv[j] * cs.x) : (kv[j] * cs.x - pv[j] * cs.y);
        }
      }
      uint4 o; o.x = pack2(kv[0], kv[1]); o.y = pack2(kv[2], kv[3]); o.z = pack2(kv[4], kv[5]); o.w = pack2(kv[6], kv[7]);
      *(uint4*)(Kl + lk * 128 + ((lc ^ ((lk >> 1) & 7)) << 4)) = o;
      const float* vp = vbase + (size_t)lk * 128 + lc * 8;
      float4 va = *(const float4*)vp, vb = *(const float4*)(vp + 4);
      float vv[8] = {va.x, va.y, va.z, va.w, vb.x, vb.y, vb.z, vb.w};
#pragma unroll
      for (int j = 0; j < 8; ++j) *(bfu*)(Vt + (lc * 8 + j) * 136 + lk * 2) = f2bf(vv[j]);
    }
    __syncthreads();
    f32x16 st[2];
#pragma unroll
    for (int k2 = 0; k2 < 2; ++k2) {
#pragma unroll
      for (int i = 0; i < 16; ++i) st[k2][i] = 0.f;
      const int row = k2 * 32 + ql;
#pragma unroll
      for (int s = 0; s < 4; ++s) {
        bf16x8 a = *(const bf16x8*)(Kl + row * 128 + (((2 * s + h) ^ ((row >> 1) & 7)) << 4));
        st[k2] = __builtin_amdgcn_mfma_f32_32x32x16_bf16(a, qf[s], st[k2], 0, 0, 0);
      }
    }
    if (win) {
#pragma unroll
      for (int k2 = 0; k2 < 2; ++k2)
#pragma unroll
        for (int i = 0; i < 16; ++i) {
          int kpos = kstart + k2 * 32 + (i & 3) + 8 * (i >> 2) + 4 * h;
          int dd = tq - kpos;
          if (dd > 128 || dd < -128) st[k2][i] = -1e30f;
        }
    }
    float mx = -1e30f;
#pragma unroll
    for (int k2 = 0; k2 < 2; ++k2)
#pragma unroll
      for (int i = 0; i < 16; ++i) mx = fmaxf(mx, st[k2][i]);
    mx = fmaxf(mx, __shfl_xor(mx, 32));
    const float mnew = fmaxf(mrun, mx);
    const float alpha = __expf(mrun - mnew);
    mrun = mnew;
    float ps = 0.f;
    bf16x8 pf[2][2];
#pragma unroll
    for (int k2 = 0; k2 < 2; ++k2) {
      float pv[16];
#pragma unroll
      for (int i = 0; i < 16; ++i) { pv[i] = __expf(st[k2][i] - mnew); ps += pv[i]; }
#pragma unroll
      for (int s2 = 0; s2 < 2; ++s2) {
        union { bf16x8 v; unsigned u[4]; } cv;
#pragma unroll
        for (int j = 0; j < 4; ++j) cv.u[j] = pack2(pv[8 * s2 + 2 * j], pv[8 * s2 + 2 * j + 1]);
        pf[k2][s2] = cv.v;
      }
    }
    lsum = lsum * alpha + ps;
#pragma unroll
    for (int dt = 0; dt < 2; ++dt) {
#pragma unroll
      for (int i = 0; i < 16; ++i) oacc[dt][i] *= alpha;
      const char* vrow = Vt + (dt * 32 + ql) * 136;
#pragma unroll
      for (int k2 = 0; k2 < 2; ++k2)
#pragma unroll
        for (int s2 = 0; s2 < 2; ++s2) {
          const int kb = k2 * 32 + 16 * s2 + 4 * h;
          union { bf16x8 v; uint2 u[2]; } av;
          av.u[0] = *(const uint2*)(vrow + kb * 2);
          av.u[1] = *(const uint2*)(vrow + (kb + 8) * 2);
          oacc[dt] = __builtin_amdgcn_mfma_f32_32x32x16_bf16(av.v, pf[k2][s2], oacc[dt], 0, 0, 0);
        }
    }
  }
  const float ltot = lsum + __shfl_xor(lsum, 32);
  const float inv = 1.f / ltot;
  bfu* yo = (bfu*)(P.ws + OFF_YCAT) + (size_t)(tok0 + tq) * 1024 + 512 + head * 64;
#pragma unroll
  for (int dt = 0; dt < 2; ++dt)
#pragma unroll
    for (int q4 = 0; q4 < 4; ++q4) {
      uint2 o; o.x = pack2(oacc[dt][4 * q4] * inv, oacc[dt][4 * q4 + 1] * inv); o.y = pack2(oacc[dt][4 * q4 + 2] * inv, oacc[dt][4 * q4 + 3] * inv);
      *(uint2*)(yo + dt * 32 + 8 * q4 + 4 * h) = o;
    }
  __syncthreads();
}

__device__ __forceinline__ void s5_chunk_info(int ci, bool& isS, int& b, int& ch, int& nch, int& tokbase) {
  isS = ci >= 128;
  if (isS) { b = (ci - 128) >> 7; ch = (ci - 128) & 127; nch = 128; tokbase = 4096 + b * 4096 + ch * 32; }
  else { b = ci >> 3; ch = ci & 7; nch = 8; tokbase = b * 256 + ch * 32; }
}

__device__ __forceinline__ void s5a_item(const Params& P, int l, int ci, char* lds) {
  float* U = (float*)lds;
  bool isS; int b, ch, nch, tokbase; s5_chunk_info(ci, isS, b, ch, nch, tokbase);
  const int tid = tidx(), lane = tid & 63, w = tid >> 6;
  __syncthreads();
  {
    const float4* src = (const float4*)((const float*)(P.ws + OFF_ZB) + (size_t)tokbase * 256);
    for (int i = tid; i < 2048; i += NTHR) ((float4*)U)[i] = src[i];
  }
  __syncthreads();
  const float2* lamb = (const float2*)(P.ws + OFF_LAMB);
  const float2* bbar = (const float2*)(P.ws + OFF_BBAR);
  float2* SE = (float2*)(P.ws + OFF_SE);
#pragma unroll 1
  for (int cb = 0; cb < 4; ++cb) {
    const int g = w * 2 + (cb >> 1), d = cb & 1;
    const int sidx = (d * 16 + g) * 64 + lane;
    float2 Bv[16];
#pragma unroll
    for (int c4 = 0; c4 < 8; ++c4) { float4 t = *(const float4*)(bbar + sidx * 16 + c4 * 2); Bv[2 * c4] = make_float2(t.x, t.y); Bv[2 * c4 + 1] = make_float2(t.z, t.w); }
    const float2 lam = lamb[sidx];
    float2 hs = make_float2(0.f, 0.f);
#pragma unroll 2
    for (int i = 0; i < 32; ++i) {
      const int t = d ? 31 - i : i;
      const float* u = U + t * 256 + g * 16;
      float2 bu = make_float2(0.f, 0.f);
#pragma unroll
      for (int c4 = 0; c4 < 4; ++c4) {
        float4 uv = *(const float4*)(u + 4 * c4);
        bu.x += Bv[4 * c4].x * uv.x + Bv[4 * c4 + 1].x * uv.y + Bv[4 * c4 + 2].x * uv.z + Bv[4 * c4 + 3].x * uv.w;
        bu.y += Bv[4 * c4].y * uv.x + Bv[4 * c4 + 1].y * uv.y + Bv[4 * c4 + 2].y * uv.z + Bv[4 * c4 + 3].y * uv.w;
      }
      float2 t2 = cmul(lam, hs);
      hs = make_float2(t2.x + bu.x, t2.y + bu.y);
    }
    SE[((size_t)ci * 32 + g * 2 + d) * 64 + lane] = hs;
  }
}

__device__ __forceinline__ void s5b_item(const Params& P, int l, int ci, char* lds) {
  float* U = (float*)lds;
  bool isS; int b, ch, nch, tokbase; s5_chunk_info(ci, isS, b, ch, nch, tokbase);
  const int tid = tidx(), lane = tid & 63, w = tid >> 6;
  float2* Hb = (float2*)(lds + 32768) + w * 1024;
  __syncthreads();
  {
    const float4* src = (const float4*)((const float*)(P.ws + OFF_ZB) + (size_t)tokbase * 256);
    for (int i = tid; i < 2048; i += NTHR) ((float4*)U)[i] = src[i];
  }
  __syncthreads();
  const float2* lamb = (const float2*)(P.ws + OFF_LAMB);
  const float2* bbar = (const float2*)(P.ws + OFF_BBAR);
  const float2* SE = (const float2*)(P.ws + OFF_SE);
  const int cbase = ci - ch;
  const int yc = lane & 15, ytq = lane >> 4;
  bfu* YS = (bfu*)(P.ws + OFF_YS5);
#pragma unroll 1
  for (int gi = 0; gi < 2; ++gi) {
    const int g = w * 2 + gi;
    float yacc[2][4];
#pragma unroll
    for (int a = 0; a < 2; ++a)
#pragma unroll
      for (int k = 0; k < 4; ++k) yacc[a][k] = 0.f;
#pragma unroll
    for (int d = 0; d < 2; ++d) {
      const int sidx = (d * 16 + g) * 64 + lane;
      float2 Bv[16];
#pragma unroll
      for (int c4 = 0; c4 < 8; ++c4) { float4 t = *(const float4*)(bbar + sidx * 16 + c4 * 2); Bv[2 * c4] = make_float2(t.x, t.y); Bv[2 * c4 + 1] = make_float2(t.z, t.w); }
      const float2 lam = lamb[sidx];
      float2 hs = ((const float2*)(P.ws + OFF_CAR))[((size_t)ci * 32 + g * 2 + d) * 64 + lane];
      const float* cre = P.in[I_CRE] + ((size_t)((l * 2 + d) * 16 + g) * 16 + yc) * 64;
      const float* cim = P.in[I_CIM] + ((size_t)((l * 2 + d) * 16 + g) * 16 + yc) * 64;
#pragma unroll
      for (int sc = 0; sc < 2; ++sc) {
#pragma unroll 1
        for (int ii = 0; ii < 16; ++ii) {
          const int i = sc * 16 + ii;
          const int t = d ? 31 - i : i;
          const float* u = U + t * 256 + g * 16;
          float2 bu = make_float2(0.f, 0.f);
#pragma unroll
          for (int c4 = 0; c4 < 4; ++c4) {
            float4 uv = *(const float4*)(u + 4 * c4);
            bu.x += Bv[4 * c4].x * uv.x + Bv[4 * c4 + 1].x * uv.y + Bv[4 * c4 + 2].x * uv.z + Bv[4 * c4 + 3].x * uv.w;
            bu.y += Bv[4 * c4].y * uv.x + Bv[4 * c4 + 1].y * uv.y + Bv[4 * c4 + 2].y * uv.z + Bv[4 * c4 + 3].y * uv.w;
          }
          float2 t2 = cmul(lam, hs);
          hs = make_float2(t2.x + bu.x, t2.y + bu.y);
          Hb[ii * 64 + lane] = hs;
        }
        __builtin_amdgcn_fence(__ATOMIC_ACQ_REL, "workgroup");
        __builtin_amdgcn_wave_barrier();
        const int sc2 = d ? 1 - sc : sc;
#pragma unroll 1
        for (int pc = 0; pc < 8; ++pc) {
          float cr[8], cm[8];
#pragma unroll
          for (int q = 0; q < 2; ++q) {
            float4 a = *(const float4*)(cre + pc * 8 + 4 * q), bb = *(const float4*)(cim + pc * 8 + 4 * q);
            cr[4 * q] = a.x; cr[4 * q + 1] = a.y; cr[4 * q + 2] = a.z; cr[4 * q + 3] = a.w;
            cm[4 * q] = bb.x; cm[4 * q + 1] = bb.y; cm[4 * q + 2] = bb.z; cm[4 * q + 3] = bb.w;
          }
#pragma unroll
          for (int k = 0; k < 4; ++k) {
            const int tl = ytq * 4 + k;
            const int rowi = d ? 15 - tl : tl;
            const float4* hp = (const float4*)(Hb + rowi * 64 + pc * 8);
            float s = 0.f;
#pragma unroll
            for (int q = 0; q < 4; ++q) {
              float4 hv = hp[q];
              s += cr[2 * q] * hv.x - cm[2 * q] * hv.y + cr[2 * q + 1] * hv.z - cm[2 * q + 1] * hv.w;
            }
            yacc[sc2][k] += s;
          }
        }
        __builtin_amdgcn_fence(__ATOMIC_ACQ_REL, "workgroup");
        __builtin_amdgcn_wave_barrier();
      }
      if (!isS && ((d == 0 && ch == nch - 1) || (d == 1 && ch == 0))) {
        const int oidx = (((b * 4 + l) * 2 + d) * 16 + g) * 64 + lane;
        P.out[OUT_SRE + oidx] = hs.x; P.out[OUT_SIM + oidx] = hs.y;
      }
    }
    const float sk = P.in[I_S5SKIP][l * 256 + g * 16 + yc];
#pragma unroll
    for (int a = 0; a < 2; ++a)
#pragma unroll
      for (int k = 0; k < 4; ++k) {
        const int t = a * 16 + ytq * 4 + k;
        float y = yacc[a][k] + U[t * 256 + g * 16 + yc] * sk;
        YS[(size_t)(tokbase + t) * 256 + g * 16 + yc] = f2bf(y);
      }
  }
}

__device__ __forceinline__ void s5c_phase(const Params& P, int l) {
  const int tid = tidx(), lane = tid & 63, w = tid >> 6;
  const float2* lamb = (const float2*)(P.ws + OFF_LAMB);
  const float2* SE = (const float2*)(P.ws + OFF_SE);
  float2* CAR = (float2*)(P.ws + OFF_CAR);
  for (int wi = blockIdx.x * 8 + w; wi < 18 * 32; wi += gridDim.x * 8) {
    const int seq = wi >> 5, gd = wi & 31, g = gd >> 1, d = gd & 1;
    const bool isS = seq >= 16;
    const int b = isS ? seq - 16 : seq;
    const int nch = isS ? 128 : 8;
    const int cbase = isS ? 128 + b * 128 : b * 8;
    float2 lam32 = lamb[(d * 16 + g) * 64 + lane];
#pragma unroll
    for (int i = 0; i < 5; ++i) lam32 = cmul(lam32, lam32);
    float2 hs = make_float2(0.f, 0.f);
    if (isS) {
      const int hidx = (((b * 4 + l) * 2 + d) * 16 + g) * 64 + lane;
      hs = make_float2(P.in[I_SRE][hidx], P.in[I_SIM][hidx]);
    }
#pragma unroll 8
    for (int jj = 0; jj < nch; ++jj) {
      const int j = d ? nch - 1 - jj : jj;
      const size_t idx = ((size_t)(cbase + j) * 32 + gd) * 64 + lane;
      CAR[idx] = hs;
      float2 e = SE[idx];
      float2 t2 = cmul(lam32, hs);
      hs = make_float2(t2.x + e.x, t2.y + e.y);
    }
  }
}

constexpr int NSP = 12;
constexpr int N_PHASES = 1 + 4 * NSP + 1;

__device__ __forceinline__ void prep_items(const Params& P, int l, int extra_first, char* lds) {
  const int total = CONV_TILES + 68 + 1;
  for (int it = blockIdx.x; it < total; it += gridDim.x) {
    if (it < 68) filt_item(P, l, it, lds);
    else if (it == 68) s5pre_item(P, l);
    else conv_item(P, l, it - 69, lds);
  }
}

__device__ __forceinline__ void mix_phase(const Params& P, int l, char* lds) {
  const int total = 256 + 256 + 256 + 128 + 384;
  for (int it = blockIdx.x; it < total; it += gridDim.x) {
    int i = it;
    if (i < 256) { hyena_sample_item(P, l, i, lds); continue; }
    i -= 256;
    if (i < 256) { attn_item(P, l, 16 + (i >> 7), (i >> 6) & 1, i & 63, lds); continue; }
    i -= 256;
    if (i < 256) { hyena_prompt_item(P, l, i, lds); continue; }
    i -= 256;
    if (i < 128) { attn_item(P, l, i >> 3, (i >> 2) & 1, i & 3, lds); continue; }
    i -= 128;
    s5a_item(P, l, i, lds);
  }
}

__device__ __forceinline__ void run_phase(const Params& P, int ph, char* lds) {
  if (ph == 0) {
    for (int it = blockIdx.x; it < 385; it += gridDim.x) { if (it < 384) ada_item(P, it, lds); else tables_item(P); }
    return;
  }
  if (ph == N_PHASES - 1) { final_phase(P); return; }
  const int l = (ph - 1) / NSP, sp = (ph - 1) % NSP;
  switch (sp) {
    case 0: prep_items(P, l, 0, lds); break;
    case 1: norm_phase(P, l, 0); break;
    case 2: gemm_in_phase(P, l, lds); break;
    case 3: mix_phase(P, l, lds); break;
    case 4: s5c_phase(P, l); break;
    case 5: for (int it = blockIdx.x; it < 384; it += gridDim.x) s5b_item(P, l, it, lds); break;
    case 6: glu_phase(P, l, lds); break;
    case 7: proj_phase(P, l, lds); break;
    case 8: resid_gemm_phase(P, l, 0, lds); break;
    case 9: norm_phase(P, l, 1); break;
    case 10: ffn_up_phase(P, l, lds); break;
    case 11: resid_gemm_phase(P, l, 1, lds); break;
  }
}

__global__ void __launch_bounds__(NTHR) mk(Params P, int lo, int hi) {
  extern __shared__ __attribute__((aligned(16))) char lds[];
  cg::grid_group grid = cg::this_grid();
  for (int ph = lo; ph < hi; ++ph) {
    run_phase(P, ph, lds);
#ifdef REP_SP
    if (ph > 0 && ph < N_PHASES - 1 && (ph - 1) % NSP == REP_SP) {
      for (int rep = 0; rep < REP_N; ++rep) { grid.sync(); run_phase(P, ph, lds); }
    }
#endif
    if (ph + 1 < hi) grid.sync();
  }
}

extern "C" void kernel_launch(void* const* d_in, const int* in_sizes, int n_in, void* d_out, int out_size, void* d_ws, size_t ws_size,
                              hipStream_t stream) {
  static int grid_blocks = 0;
  if (!grid_blocks) {
    int dev = 0, cus = 0, per_cu = 0;
    hipGetDevice(&dev);
    hipDeviceGetAttribute(&cus, hipDeviceAttributeMultiprocessorCount, dev);
    hipFuncSetAttribute((const void*)mk, hipFuncAttributeMaxDynamicSharedMemorySize, LDS_BYTES);
    hipOccupancyMaxActiveBlocksPerMultiprocessor(&per_cu, (const void*)mk, NTHR, LDS_BYTES);
    if (per_cu < 1) per_cu = 1;
    grid_blocks = cus * per_cu;
    if (ws_size < WS_END) fprintf(stderr, "kernel_launch: workspace too small: %zu < %zu\n", ws_size, (size_t)WS_END);
  }
  Params p{};
  for (int i = 0; i < 42; ++i) p.in[i] = (const float*)d_in[i];
  p.out = (float*)d_out; p.ws = (char*)d_ws;
#if MULTI_LAUNCH
  for (int ph = 0; ph < N_PHASES; ++ph) {
    int lo = ph, hi = ph + 1;
    hipLaunchKernelGGL(mk, dim3(grid_blocks), dim3(NTHR), LDS_BYTES, stream, p, lo, hi);
  }
#else
  int lo = 0, hi = N_PHASES;
  void* args[] = {&p, &lo, &hi};
  hipError_t e = hipLaunchCooperativeKernel((const void*)mk, dim3(grid_blocks), dim3(NTHR), args, LDS_BYTES, stream);
  if (e != hipSuccess) fprintf(stderr, "cooperative launch failed: %s (grid %d)\n", hipGetErrorString(e), grid_blocks);
#endif
}
```

```cpp
#include <hip/hip_runtime.h>
#include <hip/hip_cooperative_groups.h>
#include <cstdio>
namespace cg = cooperative_groups;

#ifndef MULTI_LAUNCH
#define MULTI_LAUNCH 0
#endif

typedef __attribute__((ext_vector_type(8))) short bf16x8;
typedef __attribute__((ext_vector_type(16))) float f32x16;
typedef unsigned short bfu;
typedef __attribute__((ext_vector_type(4))) unsigned u32x4;

constexpr int NTHR = 512;
constexpr int TT = 12288;
constexpr int LDS_BYTES = 98304;

enum { I_XP = 0, I_XS, I_CK, I_CV, I_SRE, I_SIM, I_C, I_CCTX, I_ADAW, I_ADAB, I_N1G, I_WIN, I_HCW, I_HCB, I_HW1, I_HB1, I_HW2, I_HB2,
       I_HW3, I_HFREQ, I_HDEC, I_HSKIP, I_LRE, I_LIM, I_LSTEP, I_BRE, I_BIM, I_CRE, I_CIM, I_S5SKIP, I_GLUW, I_GLUB, I_SINK,
       I_PA, I_PB, I_PC, I_WOUT, I_N2G, I_FG, I_FU, I_FD, I_FNG };

constexpr size_t OUT_YP = 0, OUT_YS = 4194304, OUT_K = 12582912, OUT_V = 14680064, OUT_SRE = 16777216, OUT_SIM = 16908288;

constexpr size_t OFF_WIN  = 0;
constexpr size_t OFF_WP   = OFF_WIN + (size_t)4864 * 1024 * 2;
constexpr size_t OFF_WO   = OFF_WP + (size_t)1024 * 1024 * 2;
constexpr size_t OFF_WGU  = OFF_WO + (size_t)1024 * 1024 * 2;
constexpr size_t OFF_WDN  = OFF_WGU + (size_t)5632 * 1024 * 2;
constexpr size_t OFF_WGLU = OFF_WDN + (size_t)1024 * 2816 * 2;
constexpr size_t OFF_X    = OFF_WGLU + (size_t)512 * 256 * 2;
constexpr size_t OFF_AB   = OFF_X + (size_t)TT * 1024 * 4;
constexpr size_t OFF_ZAT  = OFF_AB + (size_t)TT * 1024 * 2;
constexpr size_t OFF_ZB   = OFF_ZAT + (size_t)768 * TT * 4;
constexpr size_t OFF_Q    = OFF_ZB + (size_t)TT * 256 * 4;
constexpr size_t OFF_KS   = OFF_Q + (size_t)TT * 512 * 4;
constexpr size_t OFF_VS   = OFF_KS + (size_t)8192 * 128 * 4;
constexpr size_t OFF_G    = OFF_VS + (size_t)8192 * 128 * 4;
constexpr size_t OFF_YCAT = OFF_G + (size_t)TT * 3072 * 2;
constexpr size_t OFF_YS5  = OFF_YCAT + (size_t)TT * 1024 * 2;
constexpr size_t OFF_FS   = OFF_YS5 + (size_t)TT * 256 * 2;
constexpr size_t OFF_FP   = OFF_FS + (size_t)1024 * 4096 * 4;
constexpr size_t OFF_MOD  = OFF_FP + (size_t)1024 * 256 * 4;
constexpr size_t OFF_TW   = OFF_MOD + (size_t)4 * 3 * 6144 * 4;
constexpr size_t OFF_RT   = OFF_TW + (size_t)4096 * 8;
constexpr size_t OFF_LAMB = OFF_RT + (size_t)64 * 16 * 8;
constexpr size_t OFF_BBAR = OFF_LAMB + (size_t)2048 * 8;
constexpr size_t OFF_SE   = OFF_BBAR + (size_t)2048 * 16 * 8;
constexpr size_t OFF_CAR  = OFF_SE + (size_t)384 * 32 * 64 * 8;
constexpr size_t WS_END   = OFF_CAR + (size_t)384 * 32 * 64 * 8;

struct Params { const float* in[42]; float* out; char* ws; };

__device__ __forceinline__ int tidx() { int t = threadIdx.x; asm volatile("" : "+v"(t)); return t; }
__device__ __forceinline__ bfu f2bf(float f) { unsigned u = __float_as_uint(f); u += 0x7fffu + ((u >> 16) & 1u); return (bfu)(u >> 16); }
__device__ __forceinline__ unsigned pack2(float a, float b) { return (unsigned)f2bf(a) | ((unsigned)f2bf(b) << 16); }
__device__ __forceinline__ float bf2f(bfu v) { return __uint_as_float(((unsigned)v) << 16); }
__device__ __forceinline__ float sigm(float x) { return 1.f / (1.f + __expf(-x)); }
__device__ __forceinline__ float2 cmul(float2 a, float2 b) { return make_float2(a.x * b.x - a.y * b.y, a.x * b.y + a.y * b.x); }
__device__ __forceinline__ int cond_of(int row) { return row < 4096 ? 0 : 1 + ((row - 4096) >> 12); }
__device__ __forceinline__ const float* xrow(const Params& P, int l, int row) {
  if (l > 0) return (const float*)(P.ws + OFF_X) + (size_t)row * 1024;
  return row < 4096 ? P.in[I_XP] + (size_t)row * 1024 : P.in[I_XS] + (size_t)(row - 4096) * 1024;
}

template <int N>
__device__ __forceinline__ void g_load(u32x4 (&rg)[N], const bfu* __restrict__ p, int ld) {
#pragma unroll
  for (int i = 0; i < N; ++i) rg[i] = *(const u32x4*)(p + (size_t)(64 * i) * ld);
}
template <int N>
__device__ __forceinline__ void l_store(const u32x4 (&rg)[N], char* base, int lrow, int lc) {
#pragma unroll
  for (int i = 0; i < N; ++i) { int row = lrow + 64 * i; *(u32x4*)(base + row * 128 + ((lc ^ ((row >> 1) & 7)) << 4)) = rg[i]; }
}
template <int MI>
__device__ __forceinline__ void g_compute(const char* sa, const char* sb, f32x16 (&acc)[MI][2], int wm, int wn, int r, int h) {
#pragma unroll
  for (int s = 0; s < 4; ++s) {
    bf16x8 af[MI], bfr[2];
#pragma unroll
    for (int mi = 0; mi < MI; ++mi) { int row = wm * 32 * MI + mi * 32 + r; af[mi] = *(const bf16x8*)(sa + row * 128 + (((2 * s + h) ^ ((row >> 1) & 7)) << 4)); }
#pragma unroll
    for (int ni = 0; ni < 2; ++ni) { int row = wn * 64 + ni * 32 + r; bfr[ni] = *(const bf16x8*)(sb + row * 128 + (((2 * s + h) ^ ((row >> 1) & 7)) << 4)); }
#pragma unroll
    for (int mi = 0; mi < MI; ++mi)
#pragma unroll
      for (int ni = 0; ni < 2; ++ni) acc[mi][ni] = __builtin_amdgcn_mfma_f32_32x32x16_bf16(af[mi], bfr[ni], acc[mi][ni], 0, 0, 0);
  }
}

template <int MI>
__device__ __forceinline__ void gemm_core(const bfu* __restrict__ A, int lda, const bfu* __restrict__ B, int ldb, int K,
                                          f32x16 (&acc)[MI][2], char* lds) {
  constexpr int BM = 128 * MI;
  constexpr int A_BYTES = BM * 128, B_BYTES = 128 * 128, STAGE = A_BYTES + B_BYTES;
  const int tid = tidx(), lane = tid & 63, w = tid >> 6;
  const int wm = w & 3, wn = w >> 2, r = lane & 31, h = lane >> 5;
  const int lrow = tid >> 3, lc = tid & 7;
  u32x4 a0[2 * MI], b0[2], a1[2 * MI], b1[2];
  const int nk = K >> 6;
  const bfu* Ap = A + (size_t)lrow * lda + lc * 8;
  const bfu* Bp = B + (size_t)lrow * ldb + lc * 8;
  g_load(a0, Ap, lda); g_load(b0, Bp, ldb);
  g_load(a1, Ap + 64, lda); g_load(b1, Bp + 64, ldb);
  l_store(a0, lds, lrow, lc); l_store(b0, lds + A_BYTES, lrow, lc);
  if (nk > 2) { g_load(a0, Ap + 128, lda); g_load(b0, Bp + 128, ldb); }
  __syncthreads();
  for (int kt = 0; kt < nk; kt += 2) {
    g_compute<MI>(lds, lds + A_BYTES, acc, wm, wn, r, h);
    l_store(a1, lds + STAGE, lrow, lc); l_store(b1, lds + STAGE + A_BYTES, lrow, lc);
    if (kt + 3 < nk) { g_load(a1, Ap + (kt + 3) * 64, lda); g_load(b1, Bp + (kt + 3) * 64, ldb); }
    __syncthreads();
    g_compute<MI>(lds + STAGE, lds + STAGE + A_BYTES, acc, wm, wn, r, h);
    if (kt + 2 < nk) { l_store(a0, lds, lrow, lc); l_store(b0, lds + A_BYTES, lrow, lc); }
    if (kt + 4 < nk) { g_load(a0, Ap + (kt + 4) * 64, lda); g_load(b0, Bp + (kt + 4) * 64, ldb); }
    __syncthreads();
  }
}

template <int MI>
__device__ __forceinline__ void zero_acc(f32x16 (&acc)[MI][2]) {
#pragma unroll
  for (int mi = 0; mi < MI; ++mi)
#pragma unroll
    for (int ni = 0; ni < 2; ++ni)
#pragma unroll
      for (int i = 0; i < 16; ++i) acc[mi][ni][i] = 0.f;
}

__device__ __forceinline__ int rowmap(int mode, int n) {
  if (mode == 0) return n;
  if (mode == 1) return ((n >> 5) << 6) + (n & 31);
  if (mode == 2) return ((n >> 5) << 6) + 32 + (n & 31);
  if (n < 256) return ((n >> 5) << 6) + (n & 31);
  n -= 256; return ((n >> 5) << 6) + 32 + (n & 31);
}
__device__ __forceinline__ void conv_tile(const float* __restrict__ src, int N, bfu* __restrict__ dst, int ldd, int koff, int mode, int kt, int nt, float* tl) {
  const int tid = tidx();
  {
    int r = tid >> 3, c0 = (tid & 7) * 8;
    const float* s = src + (size_t)(kt * 64 + r) * N + nt * 64 + c0;
    float4 a = *(const float4*)s, b = *(const float4*)(s + 4);
    tl[(c0 + 0) * 65 + r] = a.x; tl[(c0 + 1) * 65 + r] = a.y; tl[(c0 + 2) * 65 + r] = a.z; tl[(c0 + 3) * 65 + r] = a.w;
    tl[(c0 + 4) * 65 + r] = b.x; tl[(c0 + 5) * 65 + r] = b.y; tl[(c0 + 6) * 65 + r] = b.z; tl[(c0 + 7) * 65 + r] = b.w;
  }
  __syncthreads();
  {
    int n = tid >> 3, k0 = (tid & 7) * 8;
    int drow = rowmap(mode, nt * 64 + n);
    const float* t = tl + n * 65 + k0;
    uint4 o; o.x = pack2(t[0], t[1]); o.y = pack2(t[2], t[3]); o.z = pack2(t[4], t[5]); o.w = pack2(t[6], t[7]);
    *(uint4*)(dst + (size_t)drow * ldd + koff + kt * 64 + k0) = o;
  }
  __syncthreads();
}
constexpr int CONV_TILES = 1216 + 64 + 64 + 128 + 256 + 704 + 704 + 704 + 32;
__device__ __forceinline__ void conv_item(const Params& P, int l, int t, char* lds) {
  float* tl = (float*)lds;
  char* ws = P.ws;
  if (t < 1216) { conv_tile(P.in[I_WIN] + (size_t)l * 1024 * 4864, 4864, (bfu*)(ws + OFF_WIN), 1024, 0, 0, t / 76, t % 76, tl); return; }
  t -= 1216;
  if (t < 64) { conv_tile(P.in[I_PA] + (size_t)l * 256 * 1024, 1024, (bfu*)(ws + OFF_WP), 1024, 0, 0, t / 16, t % 16, tl); return; }
  t -= 64;
  if (t < 64) { conv_tile(P.in[I_PB] + (size_t)l * 256 * 1024, 1024, (bfu*)(ws + OFF_WP), 1024, 256, 0, t / 16, t % 16, tl); return; }
  t -= 64;
  if (t < 128) { conv_tile(P.in[I_PC] + (size_t)l * 512 * 1024, 1024, (bfu*)(ws + OFF_WP), 1024, 512, 0, t / 16, t % 16, tl); return; }
  t -= 128;
  if (t < 256) { conv_tile(P.in[I_WOUT] + (size_t)l * 1024 * 1024, 1024, (bfu*)(ws + OFF_WO), 1024, 0, 0, t / 16, t % 16, tl); return; }
  t -= 256;
  if (t < 704) { conv_tile(P.in[I_FG] + (size_t)l * 1024 * 2816, 2816, (bfu*)(ws + OFF_WGU), 1024, 0, 1, t / 44, t % 44, tl); return; }
  t -= 704;
  if (t < 704) { conv_tile(P.in[I_FU] + (size_t)l * 1024 * 2816, 2816, (bfu*)(ws + OFF_WGU), 1024, 0, 2, t / 44, t % 44, tl); return; }
  t -= 704;
  if (t < 704) { conv_tile(P.in[I_FD] + (size_t)l * 2816 * 1024, 1024, (bfu*)(ws + OFF_WDN), 2816, 0, 0, t / 16, t % 16, tl); return; }
  t -= 704;
  conv_tile(P.in[I_GLUW] + (size_t)l * 256 * 512, 512, (bfu*)(ws + OFF_WGLU), 256, 0, 3, t / 8, t % 8, tl);
}

__device__ __forceinline__ void ada_item(const Params& P, int item, char* lds) {
  const int l = item / 96, cc = item % 96;
  float* sc = (float*)lds;
  float* red = sc + 3072;
  const int tid = tidx(), lane = tid & 63, w = tid >> 6;
  for (int i = tid; i < 3072; i += NTHR) {
    int cnd = i >> 10, k = i & 1023;
    float v = cnd == 0 ? P.in[I_CCTX][k] : P.in[I_C][(cnd - 1) * 1024 + k];
    sc[i] = v * sigm(v);
  }
  __syncthreads();
  const float* wp = P.in[I_ADAW] + (size_t)l * 1024 * 6144 + cc * 64 + lane;
  float a0 = 0.f, a1 = 0.f, a2 = 0.f;
#pragma unroll 8
  for (int k = w * 128; k < w * 128 + 128; ++k) {
    float wv = wp[(size_t)k * 6144];
    a0 += sc[k] * wv; a1 += sc[1024 + k] * wv; a2 += sc[2048 + k] * wv;
  }
  red[(w * 3 + 0) * 64 + lane] = a0; red[(w * 3 + 1) * 64 + lane] = a1; red[(w * 3 + 2) * 64 + lane] = a2;
  __syncthreads();
  if (tid < 192) {
    int cnd = tid >> 6, c = tid & 63;
    float s = P.in[I_ADAB][l * 6144 + cc * 64 + c];
#pragma unroll
    for (int ww = 0; ww < 8; ++ww) s += red[(ww * 3 + cnd) * 64 + c];
    ((float*)(P.ws + OFF_MOD))[(l * 3 + cnd) * 6144 + cc * 64 + c] = s;
  }
  __syncthreads();
}

__device__ __forceinline__ void tables_item(const Params& P) {
  float2* tw = (float2*)(P.ws + OFF_TW);
  float2* rt = (float2*)(P.ws + OFF_RT);
  for (int k = tidx(); k < 4096; k += NTHR) { float s, c; sincospif((float)k / 4096.f, &s, &c); tw[k] = make_float2(c, -s); }
  for (int i = tidx(); i < 1024; i += NTHR) {
    int pos = i >> 4, f = i & 15;
    float inv = powf(10000.f, -(float)f / 16.f);
    float ang = (float)pos * inv;
    rt[i] = make_float2(cosf(ang), sinf(ang));
  }
}

__device__ __forceinline__ void filt_item(const Params& P, int l, int item, char* lds) {
  const bool isS = item >= 4;
  const int L = isS ? 4096 : 256;
  const int pb = isS ? item - 4 : item;
  float* F = (float*)(P.ws + (isS ? OFF_FS : OFF_FP));
  float* feat = (float*)lds;
  float* h1 = feat + 64 * 33;
  float* h2 = h1 + 64 * 65;
  const int tid = tidx();
  const int pos0 = pb * 64;
  const float tstep = 1.f / (float)(L - 1);
  for (int idx = tid; idx < 64 * 33; idx += NTHR) {
    int p = idx / 33, f = idx % 33;
    int pos = pos0 + p;
    float val;
    if (f == 0) val = (float)pos * tstep;
    else {
      int bi = (f - 1) & 15;
      float fr = (float)bi / 15.f;
      float band = 1e-4f * (1.f - fr) + 15.f * fr;
      float wv = 2.f * 3.14159265358979323846f * (float)pos / (float)L;
      float ang = wv * band;
      val = (f <= 16) ? cosf(ang) : -sinf(ang);
    }
    feat[idx] = val;
  }
  __syncthreads();
  const float* w1 = P.in[I_HW1] + (size_t)l * 33 * 64;
  const float* b1 = P.in[I_HB1] + l * 64;
  const float* w2 = P.in[I_HW2] + (size_t)l * 64 * 64;
  const float* b2 = P.in[I_HB2] + l * 64;
  const float* fq = P.in[I_HFREQ] + l * 64;
  for (int idx = tid; idx < 4096; idx += NTHR) {
    int p = idx >> 6, u = idx & 63;
    float s = b1[u];
    for (int f = 0; f < 33; ++f) s += feat[p * 33 + f] * w1[f * 64 + u];
    h1[p * 65 + u] = sinf(fq[u] * s);
  }
  __syncthreads();
  for (int idx = tid; idx < 4096; idx += NTHR) {
    int p = idx >> 6, u = idx & 63;
    float s = b2[u];
    for (int k = 0; k < 64; ++k) s += h1[p * 65 + k] * w2[k * 64 + u];
    h2[p * 65 + u] = sinf(fq[u] * s);
  }
  __syncthreads();
  const int lane = tid & 63, w = tid >> 6;
  float hr[64];
#pragma unroll
  for (int k = 0; k < 64; ++k) hr[k] = h2[lane * 65 + k];
  const float* w3 = P.in[I_HW3] + (size_t)l * 64 * 1024;
  const float* dec = P.in[I_HDEC] + l * 1024;
  const float tpos = (float)(pos0 + lane) * tstep;
  float* Wl = h2 + 64 * 65;
#pragma unroll 1
  for (int chunk = 0; chunk < 8; ++chunk) {
    __syncthreads();
    for (int i = tid; i < 2048; i += NTHR) {
      int k = i >> 5, c4 = i & 31;
      *(float4*)(Wl + k * 128 + c4 * 4) = *(const float4*)(w3 + k * 1024 + chunk * 128 + c4 * 4);
    }
    __syncthreads();
#pragma unroll 1
    for (int cgp = 0; cgp < 4; ++cgp) {
      const int cl = w * 16 + cgp * 4;
      float a0 = 0.f, a1 = 0.f, a2 = 0.f, a3 = 0.f;
#pragma unroll
      for (int k = 0; k < 64; ++k) {
        float4 wv = *(const float4*)(Wl + k * 128 + cl);
        a0 += hr[k] * wv.x; a1 += hr[k] * wv.y; a2 += hr[k] * wv.z; a3 += hr[k] * wv.w;
      }
      const int col = chunk * 128 + cl;
      F[(size_t)(col + 0) * L + pos0 + lane] = a0 * __expf(-tpos * fabsf(dec[col + 0]));
      F[(size_t)(col + 1) * L + pos0 + lane] = a1 * __expf(-tpos * fabsf(dec[col + 1]));
      F[(size_t)(col + 2) * L + pos0 + lane] = a2 * __expf(-tpos * fabsf(dec[col + 2]));
      F[(size_t)(col + 3) * L + pos0 + lane] = a3 * __expf(-tpos * fabsf(dec[col + 3]));
    }
  }
  __syncthreads();
}

__device__ __forceinline__ void s5pre_item(const Params& P, int l) {
  float2* lamb = (float2*)(P.ws + OFF_LAMB);
  float2* bbar = (float2*)(P.ws + OFF_BBAR);
  for (int idx = tidx(); idx < 2048; idx += NTHR) {
    float lre = P.in[I_LRE][l * 2048 + idx], lim = P.in[I_LIM][l * 2048 + idx];
    float step = expf(P.in[I_LSTEP][l * 32 + (idx >> 6)]);
    float er = expf(lre * step), sn, cs; sincosf(lim * step, &sn, &cs);
    float2 lb = make_float2(er * cs, er * sn);
    lamb[idx] = lb;
    float2 num = make_float2(lb.x - 1.f, lb.y);
    float den = lre * lre + lim * lim;
    float2 coef = make_float2((num.x * lre + num.y * lim) / den, (num.y * lre - num.x * lim) / den);
    const float* br = P.in[I_BRE] + ((size_t)l * 2048 + idx) * 16;
    const float* bi = P.in[I_BIM] + ((size_t)l * 2048 + idx) * 16;
    for (int c = 0; c < 16; ++c) bbar[idx * 16 + c] = cmul(coef, make_float2(br[c], bi[c]));
  }
}

__device__ __forceinline__ void norm_phase(const Params& P, int l, int which) {
  const int lane = tidx() & 63, w = tidx() >> 6;
  const float* gam = P.in[which ? I_N2G : I_N1G] + l * 1024;
  bfu* AB = (bfu*)(P.ws + OFF_AB);
  for (int row = blockIdx.x * 8 + w; row < TT; row += gridDim.x * 8) {
    const float* x = which ? (const float*)(P.ws + OFF_X) + (size_t)row * 1024 : xrow(P, l, row);
    const float* md = (const float*)(P.ws + OFF_MOD) + (l * 3 + cond_of(row)) * 6144 + which * 3072;
    float4 v[4]; float ss = 0.f;
#pragma unroll
    for (int i = 0; i < 4; ++i) { v[i] = *(const float4*)(x + i * 256 + lane * 4); ss += v[i].x * v[i].x + v[i].y * v[i].y + v[i].z * v[i].z + v[i].w * v[i].w; }
#pragma unroll
    for (int o = 32; o > 0; o >>= 1) ss += __shfl_xor(ss, o);
    float rs = rsqrtf(ss * (1.f / 1024.f) + 1e-6f);
#pragma unroll
    for (int i = 0; i < 4; ++i) {
      int c = i * 256 + lane * 4;
      float4 g = *(const float4*)(gam + c), sh = *(const float4*)(md + c), sc = *(const float4*)(md + 1024 + c);
      float o0 = v[i].x * rs * g.x * (1.f + sc.x) + sh.x, o1 = v[i].y * rs * g.y * (1.f + sc.y) + sh.y;
      float o2 = v[i].z * rs * g.z * (1.f + sc.z) + sh.z, o3 = v[i].w * rs * g.w * (1.f + sc.w) + sh.w;
      uint2 o; o.x = pack2(o0, o1); o.y = pack2(o2, o3);
      *(uint2*)(AB + (size_t)row * 1024 + c) = o;
    }
  }
}
__device__ __forceinline__ void final_phase(const Params& P) {
  const int lane = tidx() & 63, w = tidx() >> 6;
  const float* gam = P.in[I_FNG];
  for (int row = blockIdx.x * 8 + w; row < TT; row += gridDim.x * 8) {
    const float* x = (const float*)(P.ws + OFF_X) + (size_t)row * 1024;
    float* y = P.out + (size_t)row * 1024;
    float4 v[4]; float ss = 0.f;
#pragma unroll
    for (int i = 0; i < 4; ++i) { v[i] = *(const float4*)(x + i * 256 + lane * 4); ss += v[i].x * v[i].x + v[i].y * v[i].y + v[i].z * v[i].z + v[i].w * v[i].w; }
#pragma unroll
    for (int o = 32; o > 0; o >>= 1) ss += __shfl_xor(ss, o);
    float rs = rsqrtf(ss * (1.f / 1024.f) + 1e-6f);
#pragma unroll
    for (int i = 0; i < 4; ++i) {
      int c = i * 256 + lane * 4;
      float4 g = *(const float4*)(gam + c);
      *(float4*)(y + c) = make_float4(v[i].x * rs * g.x, v[i].y * rs * g.y, v[i].z * rs * g.z, v[i].w * rs * g.w);
    }
  }
}

__device__ __forceinline__ int tile_slots(int MT, int NT) { return (MT >> 3) * ((NT + 3) >> 2) * 32; }
__device__ __forceinline__ bool tile_map(int it, int MT, int NT, int& mt, int& nt) {
  int T = it;
  if (gridDim.x == 256) { const int b = it & 255, j = it >> 8; T = ((j * 8 + (b & 7)) << 5) + (b >> 3); }
  const int patch = T >> 5, ip = T & 31, pmc = MT >> 3;
  mt = (patch % pmc) * 8 + (ip & 7); nt = (patch / pmc) * 4 + (ip >> 3);
  return nt < NT && T < tile_slots(MT, NT);
}
#define TILE_LOOP(MT_, NT_) const int nslots_ = (tile_slots(MT_, NT_) + 255) / 256 * 256; \
  for (int it_ = blockIdx.x; it_ < nslots_; it_ += gridDim.x) { int mt, nt; if (!tile_map(it_, MT_, NT_, mt, nt)) continue;

#define EPI_ROW(MI_, mi, reg) (wm * 32 * MI_ + (mi) * 32 + ((reg) & 3) + 8 * ((reg) >> 2) + 4 * h)

__device__ __forceinline__ void gemm_in_phase(const Params& P, int l, char* lds) {
  const int tid = tidx(), lane = tid & 63, w = tid >> 6, wm = w & 3, wn = w >> 2, r = lane & 31, h = lane >> 5;
  const bfu* A = (const bfu*)(P.ws + OFF_AB);
  const bfu* B = (const bfu*)(P.ws + OFF_WIN);
  TILE_LOOP(48, 38)
    const int m0 = mt * 256, n0 = nt * 128;
    f32x16 acc[2][2]; zero_acc<2>(acc);
    gemm_core<2>(A + (size_t)m0 * 1024, 1024, B + (size_t)n0 * 1024, 1024, 1024, acc, lds);
#pragma unroll
    for (int mi = 0; mi < 2; ++mi)
#pragma unroll
      for (int ni = 0; ni < 2; ++ni) {
        const int col = n0 + wn * 64 + ni * 32 + r;
        if (n0 < 768) {
          float* zt = (float*)(P.ws + OFF_ZAT) + (size_t)col * TT;
#pragma unroll
          for (int q4 = 0; q4 < 4; ++q4) {
            int row = m0 + wm * 64 + mi * 32 + 8 * q4 + 4 * h;
            *(float4*)(zt + row) = make_float4(acc[mi][ni][4 * q4], acc[mi][ni][4 * q4 + 1], acc[mi][ni][4 * q4 + 2], acc[mi][ni][4 * q4 + 3]);
          }
        } else {
#pragma unroll
          for (int reg = 0; reg < 16; ++reg) {
            const int row = m0 + EPI_ROW(2, mi, reg);
            const float v = acc[mi][ni][reg];
            if (n0 < 1024) ((float*)(P.ws + OFF_ZB))[(size_t)row * 256 + col - 768] = v;
            else if (n0 < 1536) ((float*)(P.ws + OFF_Q))[(size_t)row * 512 + col - 1024] = v;
            else if (n0 < 1792) {
              const bool isv = n0 >= 1664;
              const int c = col - (isv ? 1664 : 1536);
              if (row < 4096) P.out[(isv ? OUT_V : OUT_K) + ((size_t)((row >> 8) * 4 + l) * 256 + (row & 255)) * 128 + c] = v;
              else ((float*)(P.ws + (isv ? OFF_VS : OFF_KS)))[(size_t)(row - 4096) * 128 + c] = v;
            } else ((bfu*)(P.ws + OFF_G))[(size_t)row * 3072 + col - 1792] = f2bf(sigm(v));
          }
        }
      }
  }
}

__device__ __forceinline__ void glu_phase(const Params& P, int l, char* lds) {
  const int tid = tidx(), lane = tid & 63, w = tid >> 6, wm = w & 3, wn = w >> 2, r = lane & 31, h = lane >> 5;
  const bfu* A = (const bfu*)(P.ws + OFF_YS5);
  const bfu* B = (const bfu*)(P.ws + OFF_WGLU);
  const float* bias = P.in[I_GLUB] + l * 512;
  bfu* YC = (bfu*)(P.ws + OFF_YCAT);
  TILE_LOOP(96, 4)
    const int m0 = mt * 128;
    f32x16 acc[1][2]; zero_acc<1>(acc);
    gemm_core<1>(A + (size_t)m0 * 256, 256, B + (size_t)(nt * 128) * 256, 256, 256, acc, lds);
    const int cj = nt * 64 + wn * 32 + r;
    const float ba = bias[cj], bg = bias[256 + cj];
#pragma unroll
    for (int reg = 0; reg < 16; ++reg) {
      const int row = m0 + EPI_ROW(1, 0, reg);
      float a = acc[0][0][reg] + ba, g = acc[0][1][reg] + bg;
      YC[(size_t)row * 1024 + 256 + cj] = f2bf(a * sigm(g));
    }
  }
}

__device__ __forceinline__ void proj_phase(const Params& P, int l, char* lds) {
  const int tid = tidx(), lane = tid & 63, w = tid >> 6, wm = w & 3, wn = w >> 2, r = lane & 31, h = lane >> 5;
  const bfu* A = (const bfu*)(P.ws + OFF_YCAT);
  const bfu* B = (const bfu*)(P.ws + OFF_WP);
  const bfu* G = (const bfu*)(P.ws + OFF_G);
  bfu* AB = (bfu*)(P.ws + OFF_AB);
  TILE_LOOP(96, 8)
    const int m0 = mt * 128, n0 = nt * 128;
    f32x16 mg[1][2]; zero_acc<1>(mg);
#pragma unroll 1
    for (int seg = 0; seg < 3; ++seg) {
      const int koff = seg * 256, klen = seg == 2 ? 512 : 256;
      f32x16 acc[1][2]; zero_acc<1>(acc);
      gemm_core<1>(A + (size_t)m0 * 1024 + koff, 1024, B + (size_t)n0 * 1024 + koff, 1024, klen, acc, lds);
#pragma unroll
      for (int ni = 0; ni < 2; ++ni) {
        const int col = n0 + wn * 64 + ni * 32 + r;
#pragma unroll
        for (int reg = 0; reg < 16; ++reg) {
          const int row = m0 + EPI_ROW(1, 0, reg);
          mg[0][ni][reg] += bf2f(G[(size_t)row * 3072 + seg * 1024 + col]) * acc[0][ni][reg];
        }
      }
    }
#pragma unroll
    for (int ni = 0; ni < 2; ++ni) {
      const int col = n0 + wn * 64 + ni * 32 + r;
#pragma unroll
      for (int reg = 0; reg < 16; ++reg) AB[(size_t)(m0 + EPI_ROW(1, 0, reg)) * 1024 + col] = f2bf(mg[0][ni][reg]);
    }
  }
}

__device__ __forceinline__ void resid_gemm_phase(const Params& P, int l, int which, char* lds) {
  const int tid = tidx(), lane = tid & 63, w = tid >> 6, wm = w & 3, wn = w >> 2, r = lane & 31, h = lane >> 5;
  const bfu* A = (const bfu*)(P.ws + (which ? OFF_G : OFF_AB));
  const int lda = which ? 2816 : 1024;
  const bfu* B = (const bfu*)(P.ws + (which ? OFF_WDN : OFF_WO));
  float* X = (float*)(P.ws + OFF_X);
  TILE_LOOP(48, 8)
    const int m0 = mt * 256, n0 = nt * 128;
    f32x16 acc[2][2]; zero_acc<2>(acc);
    gemm_core<2>(A + (size_t)m0 * lda, lda, B + (size_t)n0 * lda, lda, lda, acc, lds);
    const float* gate = (const float*)(P.ws + OFF_MOD) + (l * 3 + cond_of(m0)) * 6144 + (which ? 5120 : 2048);
#pragma unroll
    for (int mi = 0; mi < 2; ++mi)
#pragma unroll
      for (int ni = 0; ni < 2; ++ni) {
        const int col = n0 + wn * 64 + ni * 32 + r;
        const float gv = gate[col];
#pragma unroll
        for (int reg = 0; reg < 16; ++reg) {
          const int row = m0 + EPI_ROW(2, mi, reg);
          const float xin = which ? X[(size_t)row * 1024 + col] : xrow(P, l, row)[col];
          X[(size_t)row * 1024 + col] = xin + gv * acc[mi][ni][reg];
        }
      }
  }
}

__device__ __forceinline__ void ffn_up_phase(const Params& P, int l, char* lds) {
  const int tid = tidx(), lane = tid & 63, w = tid >> 6, wm = w & 3, wn = w >> 2, r = lane & 31, h = lane >> 5;
  const bfu* A = (const bfu*)(P.ws + OFF_AB);
  const bfu* B = (const bfu*)(P.ws + OFF_WGU);
  bfu* HID = (bfu*)(P.ws + OFF_G);
  TILE_LOOP(48, 44)
    const int m0 = mt * 256;
    f32x16 acc[2][2]; zero_acc<2>(acc);
    gemm_core<2>(A + (size_t)m0 * 1024, 1024, B + (size_t)(nt * 128) * 1024, 1024, 1024, acc, lds);
    const int cj = nt * 64 + wn * 32 + r;
#pragma unroll
    for (int mi = 0; mi < 2; ++mi)
#pragma unroll
      for (int reg = 0; reg < 16; ++reg) {
        const int row = m0 + EPI_ROW(2, mi, reg);
        float g = acc[mi][0][reg], u = acc[mi][1][reg];
        HID[(size_t)row * 2816 + cj] = f2bf(g * sigm(g) * u);
      }
  }
}

__device__ __forceinline__ float short_conv(const float* __restrict__ z, int t, int L, float w0, float w1, float w2, float b) {
  float s = b + w1 * z[t];
  if (t > 0) s += w0 * z[t - 1];
  if (t < L - 1) s += w2 * z[t + 1];
  return s;
}

__device__ __forceinline__ void fft_fwd(float2* data, const float2* tw) {
  const int tid = tidx();
  for (int s = 12; s >= 0; --s) {
    const int half = 1 << s;
#pragma unroll
    for (int it = 0; it < 8; ++it) {
      int i = tid + it * NTHR;
      int j = i & (half - 1);
      int base = ((i >> s) << (s + 1)) | j;
      float2 a = data[base], b = data[base + half], wv = tw[j << (12 - s)];
      data[base] = make_float2(a.x + b.x, a.y + b.y);
      data[base + half] = cmul(make_float2(a.x - b.x, a.y - b.y), wv);
    }
    __syncthreads();
  }
}
__device__ __forceinline__ void fft_inv(float2* data, const float2* tw) {
  const int tid = tidx();
  for (int s = 0; s <= 12; ++s) {
    const int half = 1 << s;
#pragma unroll
    for (int it = 0; it < 8; ++it) {
      int i = tid + it * NTHR;
      int j = i & (half - 1);
      int base = ((i >> s) << (s + 1)) | j;
      float2 wv = tw[j << (12 - s)]; wv.y = -wv.y;
      float2 a = data[base], b = cmul(data[base + half], wv);
      data[base] = make_float2(a.x + b.x, a.y + b.y);
      data[base + half] = make_float2(a.x - b.x, a.y - b.y);
    }
    __syncthreads();
  }
}
__device__ __forceinline__ float block_sum(float v, float* red) {
  const int lane = tidx() & 63, w = tidx() >> 6;
#pragma unroll
  for (int o = 32; o > 0; o >>= 1) v += __shfl_xor(v, o);
  __syncthreads();
  if (lane == 0) red[w] = v;
  __syncthreads();
  float s = 0.f;
#pragma unroll
  for (int i = 0; i < 8; ++i) s += red[i];
  return s;
}

__device__ __forceinline__ void hyena_sample_item(const Params& P, int l, int c, char* lds) {
  float2* data = (float2*)lds;
  float2* tw = data + 8192;
  __shared__ float red[8];
  const int tid = tidx();
  const int L = 4096;
  const float* FS = (const float*)(P.ws + OFF_FS);
  const float* ZAT = (const float*)(P.ws + OFF_ZAT);
  const float* cw = P.in[I_HCW] + l * 3 * 768;
  const float* cb = P.in[I_HCB] + l * 768;
  {
    const float2* twg = (const float2*)(P.ws + OFF_TW);
    for (int i = tid; i < 4096; i += NTHR) tw[i] = twg[i];
  }
  float2 vreg[8];
#pragma unroll
  for (int o = 0; o < 2; ++o) {
    const float* hf = FS + (size_t)((o * 2 + 0) * 256 + c) * L;
    const float* hb = FS + (size_t)((o * 2 + 1) * 256 + c) * L;
    float asum = 0.f;
#pragma unroll
    for (int m = 0; m < 16; ++m) {
      int n = tid + m * NTHR;
      float v = n < L ? hf[n] : (n == L ? 0.f : hb[2 * L - n]);
      asum += fabsf(v);
      data[n] = make_float2(v, 0.f);
    }
    float nrm = block_sum(asum, red);
    fft_fwd(data, tw);
    float2 Kf[16];
    const float ksc = 1.f / (nrm * 8192.f);
#pragma unroll
    for (int m = 0; m < 16; ++m) { float2 v = data[tid + m * NTHR]; Kf[m] = make_float2(v.x * ksc, v.y * ksc); }
    __syncthreads();
    if (o == 0) {
      const float w0 = cw[c], w1 = cw[768 + c], w2 = cw[1536 + c], b = cb[c];
      const float* z0 = ZAT + (size_t)c * TT + 4096;
#pragma unroll
      for (int m = 0; m < 8; ++m) {
        int t = tid + m * NTHR;
        vreg[m] = make_float2(short_conv(z0, t, L, w0, w1, w2, b), short_conv(z0 + 4096, t, L, w0, w1, w2, b));
      }
    }
#pragma unroll
    for (int m = 0; m < 8; ++m) { int t = tid + m * NTHR; data[t] = vreg[m]; data[t + L] = make_float2(0.f, 0.f); }
    __syncthreads();
    fft_fwd(data, tw);
#pragma unroll
    for (int m = 0; m < 16; ++m) { int n = tid + m * NTHR; data[n] = cmul(data[n], Kf[m]); }
    __syncthreads();
    fft_inv(data, tw);
    {
      const int gc = (o + 1) * 256 + c;
      const float w0 = cw[gc], w1 = cw[768 + gc], w2 = cw[1536 + gc], b = cb[gc];
      const float* zg = ZAT + (size_t)gc * TT + 4096;
      const float sk = P.in[I_HSKIP][(l * 2 + o) * 256 + c];
#pragma unroll
      for (int m = 0; m < 8; ++m) {
        int t = tid + m * NTHR;
        float2 y = data[t];
        float g0 = short_conv(zg, t, L, w0, w1, w2, b), g1 = short_conv(zg + 4096, t, L, w0, w1, w2, b);
        vreg[m] = make_float2(g0 * (y.x + sk * vreg[m].x), g1 * (y.y + sk * vreg[m].y));
      }
    }
    __syncthreads();
  }
  bfu* YC = (bfu*)(P.ws + OFF_YCAT);
#pragma unroll
  for (int m = 0; m < 8; ++m) {
    int t = tid + m * NTHR;
    YC[(size_t)(4096 + t) * 1024 + c] = f2bf(vreg[m].x);
    YC[(size_t)(8192 + t) * 1024 + c] = f2bf(vreg[m].y);
  }
}

__device__ __forceinline__ void hyena_prompt_item(const Params& P, int l, int c, char* lds) {
  float* V = (float*)lds;
  float* KF = V + 4096;
  __shared__ float red[8];
  const int tid = tidx();
  const int L = 256;
  const float* FP = (const float*)(P.ws + OFF_FP);
  const float* ZAT = (const float*)(P.ws + OFF_ZAT);
  const float* cw = P.in[I_HCW] + l * 3 * 768;
  const float* cb = P.in[I_HCB] + l * 768;
#pragma unroll
  for (int o = 0; o < 2; ++o) {
    const float* hf = FP + (size_t)((o * 2 + 0) * 256 + c) * L;
    const float* hb = FP + (size_t)((o * 2 + 1) * 256 + c) * L;
    int d = tid - 255;
    float v = (tid == 511) ? 0.f : (d >= 0 ? hf[d] : hb[-d]);
    float nrm = block_sum(fabsf(v), red);
    KF[o * 512 + tid] = v / nrm;
  }
  const int seq = tid >> 5, t0 = (tid & 31) * 8;
  float vr[8];
  {
    const float w0 = cw[c], w1 = cw[768 + c], w2 = cw[1536 + c], b = cb[c];
    const float* z0 = ZAT + (size_t)c * TT + seq * 256;
#pragma unroll
    for (int i = 0; i < 8; ++i) { vr[i] = short_conv(z0, t0 + i, L, w0, w1, w2, b); V[seq * 256 + t0 + i] = vr[i]; }
  }
  __syncthreads();
#pragma unroll
  for (int o = 0; o < 2; ++o) {
    float acc[8];
#pragma unroll
    for (int i = 0; i < 8; ++i) acc[i] = 0.f;
    const float* kf = KF + o * 512;
    const float* u = V + seq * 256;
    for (int s0 = 0; s0 < 256; s0 += 8) {
      float kk[16], uu[8];
      const int kb = 248 + t0 - s0;
#pragma unroll
      for (int i = 0; i < 4; ++i) { float4 t4 = *(const float4*)(kf + kb + 4 * i); kk[4 * i] = t4.x; kk[4 * i + 1] = t4.y; kk[4 * i + 2] = t4.z; kk[4 * i + 3] = t4.w; }
#pragma unroll
      for (int i = 0; i < 2; ++i) { float4 t4 = *(const float4*)(u + s0 + 4 * i); uu[4 * i] = t4.x; uu[4 * i + 1] = t4.y; uu[4 * i + 2] = t4.z; uu[4 * i + 3] = t4.w; }
#pragma unroll
      for (int a = 0; a < 8; ++a)
#pragma unroll
        for (int i = 0; i < 8; ++i) acc[i] += kk[i - a + 7] * uu[a];
    }
    const int gc = (o + 1) * 256 + c;
    const float w0 = cw[gc], w1 = cw[768 + gc], w2 = cw[1536 + gc], b = cb[gc];
    const float* zg = ZAT + (size_t)gc * TT + seq * 256;
    const float sk = P.in[I_HSKIP][(l * 2 + o) * 256 + c];
    __syncthreads();
#pragma unroll
    for (int i = 0; i < 8; ++i) {
      float g = short_conv(zg, t0 + i, L, w0, w1, w2, b);
      vr[i] = g * (acc[i] + sk * vr[i]);
      V[seq * 256 + t0 + i] = vr[i];
    }
    __syncthreads();
  }
  bfu* YC = (bfu*)(P.ws + OFF_YCAT);
#pragma unroll
  for (int i = 0; i < 8; ++i) YC[(size_t)(seq * 256 + t0 + i) * 1024 + c] = f2bf(vr[i]);
}

__device__ __forceinline__ void attn_item(const Params& P, int l, int seq, int g, int qb, char* lds) {
  char* Kl = lds;
  char* Vt = lds + 8192;
  const int tid = tidx(), lane = tid & 63, w = tid >> 6;
  const bool isS = seq >= 16;
  const int b = isS ? seq - 16 : seq;
  const int L = isS ? 4096 : 256;
  const int tok0 = isS ? 4096 + b * 4096 : b * 256;
  const int q0 = qb * 64;
  const int rr = w >> 1, qs = w & 1, ql = lane & 31, h = lane >> 5;
  const int tq = q0 + qs * 32 + ql;
  const int head = g * 4 + rr;
  const float2* RT = (const float2*)(P.ws + OFF_RT);
  bf16x8 qf[4];
  {
    const float* qp = (const float*)(P.ws + OFF_Q) + (size_t)(tok0 + tq) * 512 + head * 64 + 8 * h;
    float qv[4][8];
#pragma unroll
    for (int s = 0; s < 4; ++s) {
      float4 a = *(const float4*)(qp + 16 * s), bq = *(const float4*)(qp + 16 * s + 4);
      qv[s][0] = a.x; qv[s][1] = a.y; qv[s][2] = a.z; qv[s][3] = a.w; qv[s][4] = bq.x; qv[s][5] = bq.y; qv[s][6] = bq.z; qv[s][7] = bq.w;
    }
    if (isS) {
#pragma unroll
      for (int hp = 0; hp < 2; ++hp) {
        const int pos = hp == 0 ? (tq >> 6) : (tq & 63);
#pragma unroll
        for (int j = 0; j < 8; ++j) {
          float2 cs = RT[pos * 16 + 8 * h + j];
          float x1 = qv[2 * hp][j], x2 = qv[2 * hp + 1][j];
          qv[2 * hp][j] = x1 * cs.x - x2 * cs.y;
          qv[2 * hp + 1][j] = x1 * cs.y + x2 * cs.x;
        }
      }
    }
#pragma unroll
    for (int s = 0; s < 4; ++s) {
      union { bf16x8 v; unsigned u[4]; } cv;
#pragma unroll
      for (int j = 0; j < 4; ++j) cv.u[j] = pack2(qv[s][2 * j] * 0.125f, qv[s][2 * j + 1] * 0.125f);
      qf[s] = cv.v;
    }
  }
  float mrun = P.in[I_SINK][l * 8 + head];
  float lsum = h == 0 ? 1.f : 0.f;
  f32x16 oacc[2];
#pragma unroll
  for (int dt = 0; dt < 2; ++dt)
#pragma unroll
    for (int i = 0; i < 16; ++i) oacc[dt][i] = 0.f;

  const int ntile = isS ? 13 : 4;
  const int lk = tid & 63, lc = tid >> 6;
  for (int ti = 0; ti < ntile; ++ti) {
    int kstart = 0; bool win = false;
    const float* kbase; const float* vbase;
    if (!isS) {
      kstart = ti * 64;
      kbase = P.out + OUT_K + ((size_t)(b * 4 + l) * 256 + kstart) * 128 + g * 64;
      vbase = P.out + OUT_V + ((size_t)(b * 4 + l) * 256 + kstart) * 128 + g * 64;
    } else if (ti < 8) {
      kstart = ti * 64;
      kbase = P.in[I_CK] + ((size_t)(b * 4 + l) * 512 + kstart) * 128 + g * 64;
      vbase = P.in[I_CV] + ((size_t)(b * 4 + l) * 512 + kstart) * 128 + g * 64;
    } else {
      kstart = q0 - 128 + (ti - 8) * 64; win = true;
      if (kstart < 0 || kstart >= L) continue;
      kbase = (const float*)(P.ws + OFF_KS) + ((size_t)b * 4096 + kstart) * 128 + g * 64;
      vbase = (const float*)(P.ws + OFF_VS) + ((size_t)b * 4096 + kstart) * 128 + g * 64;
    }
    __syncthreads();
    {
      const float* kp = kbase + (size_t)lk * 128 + lc * 8;
      float4 a = *(const float4*)kp, bq = *(const float4*)(kp + 4);
      float kv[8] = {a.x, a.y, a.z, a.w, bq.x, bq.y, bq.z, bq.w};
      if (win) {
        const float* pp = kbase + (size_t)lk * 128 + (lc ^ 2) * 8;
        float4 pa = *(const float4*)pp, pb = *(const float4*)(pp + 4);
        float pv[8] = {pa.x, pa.y, pa.z, pa.w, pb.x, pb.y, pb.z, pb.w};
        const int kpos = kstart + lk;
        const int pos = lc < 4 ? (kpos >> 6) : (kpos & 63);
#pragma unroll
        for (int j = 0; j < 8; ++j) {
          float2 cs = RT[pos * 16 + (lc & 1) * 8 + j];
          kv[j] = (lc & 2) ? (pv[j] * cs.y + kv[j] * cs.x) : (kv[j] * cs.x - pv[j] * cs.y);
        }
      }
      uint4 o; o.x = pack2(kv[0], kv[1]); o.y = pack2(kv[2], kv[3]); o.z = pack2(kv[4], kv[5]); o.w = pack2(kv[6], kv[7]);
      *(uint4*)(Kl + lk * 128 + ((lc ^ ((lk >> 1) & 7)) << 4)) = o;
      const float* vp = vbase + (size_t)lk * 128 + lc * 8;
      float4 va = *(const float4*)vp, vb = *(const float4*)(vp + 4);
      float vv[8] = {va.x, va.y, va.z, va.w, vb.x, vb.y, vb.z, vb.w};
#pragma unroll
      for (int j = 0; j < 8; ++j) *(bfu*)(Vt + (lc * 8 + j) * 136 + lk * 2) = f2bf(vv[j]);
    }
    __syncthreads();
    f32x16 st[2];
#pragma unroll
    for (int k2 = 0; k2 < 2; ++k2) {
#pragma unroll
      for (int i = 0; i < 16; ++i) st[k2][i] = 0.f;
      const int row = k2 * 32 + ql;
#pragma unroll
      for (int s = 0; s < 4; ++s) {
        bf16x8 a = *(const bf16x8*)(Kl + row * 128 + (((2 * s + h) ^ ((row >> 1) & 7)) << 4));
        st[k2] = __builtin_amdgcn_mfma_f32_32x32x16_bf16(a, qf[s], st[k2], 0, 0, 0);
      }
    }
    if (win) {
#pragma unroll
      for (int k2 = 0; k2 < 2; ++k2)
#pragma unroll
        for (int i = 0; i < 16; ++i) {
          int kpos = kstart + k2 * 32 + (i & 3) + 8 * (i >> 2) + 4 * h;
          int dd = tq - kpos;
          if (dd > 128 || dd < -128) st[k2][i] = -1e30f;
        }
    }
    float mx = -1e30f;
#pragma unroll
    for (int k2 = 0; k2 < 2; ++k2)
#pragma unroll
      for (int i = 0; i < 16; ++i) mx = fmaxf(mx, st[k2][i]);
    mx = fmaxf(mx, __shfl_xor(mx, 32));
    const float mnew = fmaxf(mrun, mx);
    const float alpha = __expf(mrun - mnew);
    mrun = mnew;
    float ps = 0.f;
    bf16x8 pf[2][2];
#pragma unroll
    for (int k2 = 0; k2 < 2; ++k2) {
      float pv[16];
#pragma unroll
      for (int i = 0; i < 16; ++i) { pv[i] = __expf(st[k2][i] - mnew); ps += pv[i]; }
#pragma unroll
      for (int s2 = 0; s2 < 2; ++s2) {
        union { bf16x8 v; unsigned u[4]; } cv;
#pragma unroll
        for (int j = 0; j < 4; ++j) cv.u[j] = pack2(pv[8 * s2 + 2 * j], pv[8 * s2 + 2 * j + 1]);
        pf[k2][s2] = cv.v;
      }
    }
    lsum = lsum * alpha + ps;
#pragma unroll
    for (int dt = 0; dt < 2; ++dt) {
#pragma unroll
      for (int i = 0; i < 16; ++i) oacc[dt][i] *= alpha;
      const char* vrow = Vt + (dt * 32 + ql) * 136;
#pragma unroll
      for (int k2 = 0; k2 < 2; ++k2)
#pragma unroll
        for (int s2 = 0; s2 < 2; ++s2) {
          const int kb = k2 * 32 + 16 * s2 + 4 * h;
          union { bf16x8 v; uint2 u[2]; } av;
          av.u[0] = *(const uint2*)(vrow + kb * 2);
          av.u[1] = *(const uint2*)(vrow + (kb + 8) * 2);
          oacc[dt] = __builtin_amdgcn_mfma_f32_32x32x16_bf16(av.v, pf[k2][s2], oacc[dt], 0, 0, 0);
        }
    }
  }
  const float ltot = lsum + __shfl_xor(lsum, 32);
  const float inv = 1.f / ltot;
  bfu* yo = (bfu*)(P.ws + OFF_YCAT) + (size_t)(tok0 + tq) * 1024 + 512 + head * 64;
#pragma unroll
  for (int dt = 0; dt < 2; ++dt)
#pragma unroll
    for (int q4 = 0; q4 < 4; ++q4) {
      uint2 o; o.x = pack2(oacc[dt][4 * q4] * inv, oacc[dt][4 * q4 + 1] * inv); o.y = pack2(oacc[dt][4 * q4 + 2] * inv, oacc[dt][4 * q4 + 3] * inv);
      *(uint2*)(yo + dt * 32 + 8 * q4 + 4 * h) = o;
    }
  __syncthreads();
}

__device__ __forceinline__ void s5_chunk_info(int ci, bool& isS, int& b, int& ch, int& nch, int& tokbase) {
  isS = ci >= 128;
  if (isS) { b = (ci - 128) >> 7; ch = (ci - 128) & 127; nch = 128; tokbase = 4096 + b * 4096 + ch * 32; }
  else { b = ci >> 3; ch = ci & 7; nch = 8; tokbase = b * 256 + ch * 32; }
}

__device__ __forceinline__ void s5a_item(const Params& P, int l, int ci, char* lds) {
  float* U = (float*)lds;
  bool isS; int b, ch, nch, tokbase; s5_chunk_info(ci, isS, b, ch, nch, tokbase);
  const int tid = tidx(), lane = tid & 63, w = tid >> 6;
  __syncthreads();
  {
    const float4* src = (const float4*)((const float*)(P.ws + OFF_ZB) + (size_t)tokbase * 256);
    for (int i = tid; i < 2048; i += NTHR) ((float4*)U)[i] = src[i];
  }
  __syncthreads();
  const float2* lamb = (const float2*)(P.ws + OFF_LAMB);
  const float2* bbar = (const float2*)(P.ws + OFF_BBAR);
  float2* SE = (float2*)(P.ws + OFF_SE);
#pragma unroll 1
  for (int cb = 0; cb < 4; ++cb) {
    const int g = w * 2 + (cb >> 1), d = cb & 1;
    const int sidx = (d * 16 + g) * 64 + lane;
    float2 Bv[16];
#pragma unroll
    for (int c4 = 0; c4 < 8; ++c4) { float4 t = *(const float4*)(bbar + sidx * 16 + c4 * 2); Bv[2 * c4] = make_float2(t.x, t.y); Bv[2 * c4 + 1] = make_float2(t.z, t.w); }
    const float2 lam = lamb[sidx];
    float2 hs = make_float2(0.f, 0.f);
#pragma unroll 2
    for (int i = 0; i < 32; ++i) {
      const int t = d ? 31 - i : i;
      const float* u = U + t * 256 + g * 16;
      float2 bu = make_float2(0.f, 0.f);
#pragma unroll
      for (int c4 = 0; c4 < 4; ++c4) {
        float4 uv = *(const float4*)(u + 4 * c4);
        bu.x += Bv[4 * c4].x * uv.x + Bv[4 * c4 + 1].x * uv.y + Bv[4 * c4 + 2].x * uv.z + Bv[4 * c4 + 3].x * uv.w;
        bu.y += Bv[4 * c4].y * uv.x + Bv[4 * c4 + 1].y * uv.y + Bv[4 * c4 + 2].y * uv.z + Bv[4 * c4 + 3].y * uv.w;
      }
      float2 t2 = cmul(lam, hs);
      hs = make_float2(t2.x + bu.x, t2.y + bu.y);
    }
    SE[((size_t)ci * 32 + g * 2 + d) * 64 + lane] = hs;
  }
}

__device__ __forceinline__ void s5b_item(const Params& P, int l, int ci, char* lds) {
  float* U = (float*)lds;
  bool isS; int b, ch, nch, tokbase; s5_chunk_info(ci, isS, b, ch, nch, tokbase);
  const int tid = tidx(), lane = tid & 63, w = tid >> 6;
  float2* Hb = (float2*)(lds + 32768) + w * 1024;
  __syncthreads();
  {
    const float4* src = (const float4*)((const float*)(P.ws + OFF_ZB) + (size_t)tokbase * 256);
    for (int i = tid; i < 2048; i += NTHR) ((float4*)U)[i] = src[i];
  }
  __syncthreads();
  const float2* lamb = (const float2*)(P.ws + OFF_LAMB);
  const float2* bbar = (const float2*)(P.ws + OFF_BBAR);
  const float2* SE = (const float2*)(P.ws + OFF_SE);
  const int cbase = ci - ch;
  const int yc = lane & 15, ytq = lane >> 4;
  bfu* YS = (bfu*)(P.ws + OFF_YS5);
#pragma unroll 1
  for (int gi = 0; gi < 2; ++gi) {
    const int g = w * 2 + gi;
    float yacc[2][4];
#pragma unroll
    for (int a = 0; a < 2; ++a)
#pragma unroll
      for (int k = 0; k < 4; ++k) yacc[a][k] = 0.f;
#pragma unroll
    for (int d = 0; d < 2; ++d) {
      const int sidx = (d * 16 + g) * 64 + lane;
      float2 Bv[16];
#pragma unroll
      for (int c4 = 0; c4 < 8; ++c4) { float4 t = *(const float4*)(bbar + sidx * 16 + c4 * 2); Bv[2 * c4] = make_float2(t.x, t.y); Bv[2 * c4 + 1] = make_float2(t.z, t.w); }
      const float2 lam = lamb[sidx];
      float2 hs = ((const float2*)(P.ws + OFF_CAR))[((size_t)ci * 32 + g * 2 + d) * 64 + lane];
      const float* cre = P.in[I_CRE] + ((size_t)((l * 2 + d) * 16 + g) * 16 + yc) * 64;
      const float* cim = P.in[I_CIM] + ((size_t)((l * 2 + d) * 16 + g) * 16 + yc) * 64;
#pragma unroll
      for (int sc = 0; sc < 2; ++sc) {
#pragma unroll 1
        for (int ii = 0; ii < 16; ++ii) {
          const int i = sc * 16 + ii;
          const int t = d ? 31 - i : i;
          const float* u = U + t * 256 + g * 16;
          float2 bu = make_float2(0.f, 0.f);
#pragma unroll
          for (int c4 = 0; c4 < 4; ++c4) {
            float4 uv = *(const float4*)(u + 4 * c4);
            bu.x += Bv[4 * c4].x * uv.x + Bv[4 * c4 + 1].x * uv.y + Bv[4 * c4 + 2].x * uv.z + Bv[4 * c4 + 3].x * uv.w;
            bu.y += Bv[4 * c4].y * uv.x + Bv[4 * c4 + 1].y * uv.y + Bv[4 * c4 + 2].y * uv.z + Bv[4 * c4 + 3].y * uv.w;
          }
          float2 t2 = cmul(lam, hs);
          hs = make_float2(t2.x + bu.x, t2.y + bu.y);
          Hb[ii * 64 + lane] = hs;
        }
        __builtin_amdgcn_fence(__ATOMIC_ACQ_REL, "workgroup");
        __builtin_amdgcn_wave_barrier();
        const int sc2 = d ? 1 - sc : sc;
#pragma unroll 1
        for (int pc = 0; pc < 8; ++pc) {
          float cr[8], cm[8];
#pragma unroll
          for (int q = 0; q < 2; ++q) {
            float4 a = *(const float4*)(cre + pc * 8 + 4 * q), bb = *(const float4*)(cim + pc * 8 + 4 * q);
            cr[4 * q] = a.x; cr[4 * q + 1] = a.y; cr[4 * q + 2] = a.z; cr[4 * q + 3] = a.w;
            cm[4 * q] = bb.x; cm[4 * q + 1] = bb.y; cm[4 * q + 2] = bb.z; cm[4 * q + 3] = bb.w;
          }
#pragma unroll
          for (int k = 0; k < 4; ++k) {
            const int tl = ytq * 4 + k;
            const int rowi = d ? 15 - tl : tl;
            const float4* hp = (const float4*)(Hb + rowi * 64 + pc * 8);
            float s = 0.f;
#pragma unroll
            for (int q = 0; q < 4; ++q) {
              float4 hv = hp[q];
              s += cr[2 * q] * hv.x - cm[2 * q] * hv.y + cr[2 * q + 1] * hv.z - cm[2 * q + 1] * hv.w;
            }
            yacc[sc2][k] += s;
          }
        }
        __builtin_amdgcn_fence(__ATOMIC_ACQ_REL, "workgroup");
        __builtin_amdgcn_wave_barrier();
      }
      if (!isS && ((d == 0 && ch == nch - 1) || (d == 1 && ch == 0))) {
        const int oidx = (((b * 4 + l) * 2 + d) * 16 + g) * 64 + lane;
        P.out[OUT_SRE + oidx] = hs.x; P.out[OUT_SIM + oidx] = hs.y;
      }
    }
    const float sk = P.in[I_S5SKIP][l * 256 + g * 16 + yc];
#pragma unroll
    for (int a = 0; a < 2; ++a)
#pragma unroll
      for (int k = 0; k < 4; ++k) {
        const int t = a * 16 + ytq * 4 + k;
        float y = yacc[a][k] + U[t * 256 + g * 16 + yc] * sk;
        YS[(size_t)(tokbase + t) * 256 + g * 16 + yc] = f2bf(y);
      }
  }
}

__device__ __forceinline__ void s5c_phase(const Params& P, int l) {
  const int tid = tidx(), lane = tid & 63, w = tid >> 6;
  const float2* lamb = (const float2*)(P.ws + OFF_LAMB);
  const float2* SE = (const float2*)(P.ws + OFF_SE);
  float2* CAR = (float2*)(P.ws + OFF_CAR);
  for (int wi = blockIdx.x * 8 + w; wi < 18 * 32; wi += gridDim.x * 8) {
    const int seq = wi >> 5, gd = wi & 31, g = gd >> 1, d = gd & 1;
    const bool isS = seq >= 16;
    const int b = isS ? seq - 16 : seq;
    const int nch = isS ? 128 : 8;
    const int cbase = isS ? 128 + b * 128 : b * 8;
    float2 lam32 = lamb[(d * 16 + g) * 64 + lane];
#pragma unroll
    for (int i = 0; i < 5; ++i) lam32 = cmul(lam32, lam32);
    float2 hs = make_float2(0.f, 0.f);
    if (isS) {
      const int hidx = (((b * 4 + l) * 2 + d) * 16 + g) * 64 + lane;
      hs = make_float2(P.in[I_SRE][hidx], P.in[I_SIM][hidx]);
    }
#pragma unroll 8
    for (int jj = 0; jj < nch; ++jj) {
      const int j = d ? nch - 1 - jj : jj;
      const size_t idx = ((size_t)(cbase + j) * 32 + gd) * 64 + lane;
      CAR[idx] = hs;
      float2 e = SE[idx];
      float2 t2 = cmul(lam32, hs);
      hs = make_float2(t2.x + e.x, t2.y + e.y);
    }
  }
}

constexpr int NSP = 12;
constexpr int N_PHASES = 1 + 4 * NSP + 1;

__device__ __forceinline__ void prep_items(const Params& P, int l, int extra_first, char* lds) {
  const int total = CONV_TILES + 68 + 1;
  for (int it = blockIdx.x; it < total; it += gridDim.x) {
    if (it < 68) filt_item(P, l, it, lds);
    else if (it == 68) s5pre_item(P, l);
    else conv_item(P, l, it - 69, lds);
  }
}

__device__ __forceinline__ void mix_phase(const Params& P, int l, char* lds) {
  const int total = 256 + 256 + 256 + 128 + 384;
  for (int it = blockIdx.x; it < total; it += gridDim.x) {
    int i = it;
    if (i < 256) { hyena_sample_item(P, l, i, lds); continue; }
    i -= 256;
    if (i < 256) { attn_item(P, l, 16 + (i >> 7), (i >> 6) & 1, i & 63, lds); continue; }
    i -= 256;
    if (i < 256) { hyena_prompt_item(P, l, i, lds); continue; }
    i -= 256;
    if (i < 128) { attn_item(P, l, i >> 3, (i >> 2) & 1, i & 3, lds); continue; }
    i -= 128;
    s5a_item(P, l, i, lds);
  }
}

__device__ __forceinline__ void run_phase(const Params& P, int ph, char* lds) {
  if (ph == 0) {
    for (int it = blockIdx.x; it < 385; it += gridDim.x) { if (it < 384) ada_item(P, it, lds); else tables_item(P); }
    return;
  }
  if (ph == N_PHASES - 1) { final_phase(P); return; }
  const int l = (ph - 1) / NSP, sp = (ph - 1) % NSP;
  switch (sp) {
    case 0: prep_items(P, l, 0, lds); break;
    case 1: norm_phase(P, l, 0); break;
    case 2: gemm_in_phase(P, l, lds); break;
    case 3: mix_phase(P, l, lds); break;
    case 4: s5c_phase(P, l); break;
    case 5: for (int it = blockIdx.x; it < 384; it += gridDim.x) s5b_item(P, l, it, lds); break;
    case 6: glu_phase(P, l, lds); break;
    case 7: proj_phase(P, l, lds); break;
    case 8: resid_gemm_phase(P, l, 0, lds); break;
    case 9: norm_phase(P, l, 1); break;
    case 10: ffn_up_phase(P, l, lds); break;
    case 11: resid_gemm_phase(P, l, 1, lds); break;
  }
}

__global__ void __launch_bounds__(NTHR) mk(Params P, int lo, int hi) {
  extern __shared__ __attribute__((aligned(16))) char lds[];
  cg::grid_group grid = cg::this_grid();
  for (int ph = lo; ph < hi; ++ph) {
    run_phase(P, ph, lds);
#ifdef REP_SP
    if (ph > 0 && ph < N_PHASES - 1 && (ph - 1) % NSP == REP_SP) {
      for (int rep = 0; rep < REP_N; ++rep) { grid.sync(); run_phase(P, ph, lds); }
    }
#endif
    if (ph + 1 < hi) grid.sync();
  }
}

extern "C" void kernel_launch(void* const* d_in, const int* in_sizes, int n_in, void* d_out, int out_size, void* d_ws, size_t ws_size,
                              hipStream_t stream) {
  static int grid_blocks = 0;
  if (!grid_blocks) {
    int dev = 0, cus = 0, per_cu = 0;
    hipGetDevice(&dev);
    hipDeviceGetAttribute(&cus, hipDeviceAttributeMultiprocessorCount, dev);
    hipFuncSetAttribute((const void*)mk, hipFuncAttributeMaxDynamicSharedMemorySize, LDS_BYTES);
    hipOccupancyMaxActiveBlocksPerMultiprocessor(&per_cu, (const void*)mk, NTHR, LDS_BYTES);
    if (per_cu < 1) per_cu = 1;
    grid_blocks = cus * per_cu;
    if (ws_size < WS_END) fprintf(stderr, "kernel_launch: workspace too small: %zu < %zu\n", ws_size, (size_t)WS_END);
  }
  Params p{};
  for (int i = 0; i < 42; ++i) p.in[i] = (const float*)d_in[i];
  p.out = (float*)d_out; p.ws = (char*)d_ws;
#if MULTI_LAUNCH
  for (int ph = 0; ph < N_PHASES; ++ph) {
    int lo = ph, hi = ph + 1;
    hipLaunchKernelGGL(mk, dim3(grid_blocks), dim3(NTHR), LDS_BYTES, stream, p, lo, hi);
  }
#else
  int lo = 0, hi = N_PHASES;
  void* args[] = {&p, &lo, &hi};
  hipError_t e = hipLaunchCooperativeKernel((const void*)mk, dim3(grid_blocks), dim3(NTHR), args, LDS_BYTES, stream);
  if (e != hipSuccess) fprintf(stderr, "cooperative launch failed: %s (grid %d)\n", hipGetErrorString(e), grid_blocks);
#endif
}
```

```cpp
#include <hip/hip_runtime.h>
#include <hip/hip_cooperative_groups.h>
#include <cstdio>
namespace cg = cooperative_groups;

#ifndef MULTI_LAUNCH
#define MULTI_LAUNCH 0
#endif

typedef __attribute__((ext_vector_type(8))) short bf16x8;
typedef __attribute__((ext_vector_type(16))) float f32x16;
typedef unsigned short bfu;
typedef float v2f __attribute__((ext_vector_type(2)));
typedef float v4f __attribute__((ext_vector_type(4)));
typedef __attribute__((ext_vector_type(4))) unsigned u32x4;

constexpr int NTHR = 512;
constexpr int TT = 12288;
constexpr int LDS_BYTES = 131072;

enum { I_XP = 0, I_XS, I_CK, I_CV, I_SRE, I_SIM, I_C, I_CCTX, I_ADAW, I_ADAB, I_N1G, I_WIN, I_HCW, I_HCB, I_HW1, I_HB1, I_HW2, I_HB2,
       I_HW3, I_HFREQ, I_HDEC, I_HSKIP, I_LRE, I_LIM, I_LSTEP, I_BRE, I_BIM, I_CRE, I_CIM, I_S5SKIP, I_GLUW, I_GLUB, I_SINK,
       I_PA, I_PB, I_PC, I_WOUT, I_N2G, I_FG, I_FU, I_FD, I_FNG };

constexpr size_t OUT_YP = 0, OUT_YS = 4194304, OUT_K = 12582912, OUT_V = 14680064, OUT_SRE = 16777216, OUT_SIM = 16908288;

constexpr size_t OFF_WIN  = 0;
constexpr size_t OFF_WP   = OFF_WIN + (size_t)4864 * 1024 * 2;
constexpr size_t OFF_WO   = OFF_WP + (size_t)1024 * 1024 * 2;
constexpr size_t OFF_WGU  = OFF_WO + (size_t)1024 * 1024 * 2;
constexpr size_t OFF_WDN  = OFF_WGU + (size_t)5632 * 1024 * 2;
constexpr size_t OFF_WGLU = OFF_WDN + (size_t)1024 * 2816 * 2;
constexpr size_t OFF_X    = OFF_WGLU + (size_t)512 * 256 * 2;
constexpr size_t OFF_AB   = OFF_X + (size_t)TT * 1024 * 4;
constexpr size_t OFF_ZAT  = OFF_AB + (size_t)TT * 1024 * 2;
constexpr size_t OFF_ZB   = OFF_ZAT + (size_t)768 * TT * 4;
constexpr size_t OFF_Q    = OFF_ZB + (size_t)TT * 256 * 4;
constexpr size_t OFF_KS   = OFF_Q + (size_t)TT * 512 * 4;
constexpr size_t OFF_VS   = OFF_KS + (size_t)8192 * 128 * 4;
constexpr size_t OFF_G    = OFF_VS + (size_t)8192 * 128 * 4;
constexpr size_t OFF_YCAT = OFF_G + (size_t)TT * 3072 * 2;
constexpr size_t OFF_YS5  = OFF_YCAT + (size_t)TT * 1024 * 2;
constexpr size_t OFF_FS   = OFF_YS5 + (size_t)TT * 256 * 2;
constexpr size_t OFF_FP   = OFF_FS + (size_t)1024 * 4096 * 4;
constexpr size_t OFF_MOD  = OFF_FP + (size_t)1024 * 256 * 4;
constexpr size_t OFF_TW   = OFF_MOD + (size_t)4 * 3 * 6144 * 4;
constexpr size_t OFF_RT   = OFF_TW + (size_t)4096 * 8;
constexpr size_t OFF_LAMB = OFF_RT + (size_t)64 * 16 * 8;
constexpr size_t OFF_BBAR = OFF_LAMB + (size_t)2048 * 8;
constexpr size_t OFF_SE   = OFF_BBAR + (size_t)2048 * 16 * 8;
constexpr size_t OFF_CAR  = OFF_SE + (size_t)384 * 32 * 64 * 8;
constexpr size_t OFF_XB   = OFF_CAR + (size_t)384 * 32 * 64 * 8;
constexpr size_t OFF_BAR  = OFF_XB + (size_t)TT * 1024 * 4;
constexpr size_t OFF_YAT  = OFF_BAR + 16384;
constexpr size_t WS_END   = OFF_YAT + (size_t)256 * TT * 2;

struct Params { const float* in[42]; float* out; char* ws; };

__device__ __forceinline__ int bidx() { int b = blockIdx.x; asm volatile("" : "+s"(b)); return b; }
__device__ __forceinline__ int gdim() { int g = gridDim.x; asm volatile("" : "+s"(g)); return g; }
__device__ __forceinline__ int tidx() { int t = threadIdx.x; asm volatile("" : "+v"(t)); return t; }
typedef __bf16 bf16v2 __attribute__((ext_vector_type(2)));
__device__ __forceinline__ unsigned pack2(float a, float b) {
  v2f v = {a, b};
  bf16v2 r = __builtin_convertvector(v, bf16v2);
  return __builtin_bit_cast(unsigned, r);
}
__device__ __forceinline__ bfu f2bf(float f) { return (bfu)(pack2(f, 0.f) & 0xffffu); }
__device__ __forceinline__ float bf2f(bfu v) { return __uint_as_float(((unsigned)v) << 16); }
__device__ __forceinline__ float sigm(float x) { return __builtin_amdgcn_rcpf(1.f + __builtin_amdgcn_exp2f(-1.44269504089f * x)); }
__device__ __forceinline__ float2 cmul(float2 a, float2 b) { return make_float2(a.x * b.x - a.y * b.y, a.x * b.y + a.y * b.x); }
__device__ __forceinline__ int cond_of(int row) { return row < 4096 ? 0 : 1 + ((row - 4096) >> 12); }
__device__ __forceinline__ const float* xrow(const Params& P, int l, int row) {
  if (l > 0) return (const float*)(P.ws + OFF_X) + (size_t)row * 1024;
  return row < 4096 ? P.in[I_XP] + (size_t)row * 1024 : P.in[I_XS] + (size_t)(row - 4096) * 1024;
}

template <int N>
__device__ __forceinline__ void g_load(u32x4 (&rg)[N], const bfu* __restrict__ p, int ld) {
#pragma unroll
  for (int i = 0; i < N; ++i) rg[i] = *(const u32x4*)(p + (size_t)(64 * i) * ld);
}
template <int N>
__device__ __forceinline__ void l_store(const u32x4 (&rg)[N], char* base, int lrow, int lc) {
#pragma unroll
  for (int i = 0; i < N; ++i) { int row = lrow + 64 * i; *(u32x4*)(base + row * 128 + ((lc ^ ((row >> 1) & 7)) << 4)) = rg[i]; }
}
template <int MI>
__device__ __forceinline__ void g_compute(const char* sa, const char* sb, f32x16 (&acc)[MI][2], int wm, int wn, int r, int h) {
#pragma unroll
  for (int s = 0; s < 4; ++s) {
    bf16x8 af[MI], bfr[2];
#pragma unroll
    for (int mi = 0; mi < MI; ++mi) { int row = wm * 32 * MI + mi * 32 + r; af[mi] = *(const bf16x8*)(sa + row * 128 + (((2 * s + h) ^ ((row >> 1) & 7)) << 4)); }
#pragma unroll
    for (int ni = 0; ni < 2; ++ni) { int row = wn * 64 + ni * 32 + r; bfr[ni] = *(const bf16x8*)(sb + row * 128 + (((2 * s + h) ^ ((row >> 1) & 7)) << 4)); }
#pragma unroll
    for (int mi = 0; mi < MI; ++mi)
#pragma unroll
      for (int ni = 0; ni < 2; ++ni) acc[mi][ni] = __builtin_amdgcn_mfma_f32_32x32x16_bf16(af[mi], bfr[ni], acc[mi][ni], 0, 0, 0);
  }
}

template <int MI>
__device__ __forceinline__ void gemm_core(const bfu* __restrict__ A, int lda, const bfu* __restrict__ B, int ldb, int K,
                                          f32x16 (&acc)[MI][2], char* lds) {
  constexpr int BM = 128 * MI;
  constexpr int A_BYTES = BM * 128, B_BYTES = 128 * 128, STAGE = A_BYTES + B_BYTES;
  const int tid = tidx(), lane = tid & 63, w = tid >> 6;
  const int wm = w & 3, wn = w >> 2, r = lane & 31, h = lane >> 5;
  const int lrow = tid >> 3, lc = tid & 7;
  u32x4 a0[2 * MI], b0[2], a1[2 * MI], b1[2];
  const int nk = K >> 6;
  const bfu* Ap = A + (size_t)lrow * lda + lc * 8;
  const bfu* Bp = B + (size_t)lrow * ldb + lc * 8;
  g_load(a0, Ap, lda); g_load(b0, Bp, ldb);
  g_load(a1, Ap + 64, lda); g_load(b1, Bp + 64, ldb);
  l_store(a0, lds, lrow, lc); l_store(b0, lds + A_BYTES, lrow, lc);
  if (nk > 2) { g_load(a0, Ap + 128, lda); g_load(b0, Bp + 128, ldb); }
  __syncthreads();
  for (int kt = 0; kt < nk; kt += 2) {
    g_compute<MI>(lds, lds + A_BYTES, acc, wm, wn, r, h);
    l_store(a1, lds + STAGE, lrow, lc); l_store(b1, lds + STAGE + A_BYTES, lrow, lc);
    if (kt + 3 < nk) { g_load(a1, Ap + (kt + 3) * 64, lda); g_load(b1, Bp + (kt + 3) * 64, ldb); }
    __syncthreads();
    g_compute<MI>(lds + STAGE, lds + STAGE + A_BYTES, acc, wm, wn, r, h);
    if (kt + 2 < nk) { l_store(a0, lds, lrow, lc); l_store(b0, lds + A_BYTES, lrow, lc); }
    if (kt + 4 < nk) { g_load(a0, Ap + (kt + 4) * 64, lda); g_load(b0, Bp + (kt + 4) * 64, ldb); }
    __syncthreads();
  }
}

template <int MI>
__device__ __forceinline__ void zero_acc(f32x16 (&acc)[MI][2]) {
#pragma unroll
  for (int mi = 0; mi < MI; ++mi)
#pragma unroll
    for (int ni = 0; ni < 2; ++ni)
#pragma unroll
      for (int i = 0; i < 16; ++i) acc[mi][ni][i] = 0.f;
}

__device__ __forceinline__ int rowmap(int mode, int n) {
  if (mode == 0) return n;
  if (mode == 1) return ((n >> 4) << 5) + (n & 15);
  if (mode == 2) return ((n >> 4) << 5) + 16 + (n & 15);
  if (n < 256) return ((n >> 5) << 6) + (n & 31);
  n -= 256; return ((n >> 5) << 6) + 32 + (n & 31);
}
constexpr int CONV_TILES = (1216 + 64 + 64 + 128 + 256 + 704 + 704 + 704 + 32) / 2;
struct ConvD { const float* src; bfu* dst; int N, ldd, koff, mode, kt, ntp; };
__device__ __forceinline__ ConvD conv_desc(const Params& P, int l, int t) {
  char* ws = P.ws;
  if (t < 608) return ConvD{P.in[I_WIN] + (size_t)l * 1024 * 4864, (bfu*)(ws + OFF_WIN), 4864, 1024, 0, 0, t / 38, t % 38};
  t -= 608;
  if (t < 32) return ConvD{P.in[I_PA] + (size_t)l * 256 * 1024, (bfu*)(ws + OFF_WP), 1024, 1024, 0, 0, t / 8, t % 8};
  t -= 32;
  if (t < 32) return ConvD{P.in[I_PB] + (size_t)l * 256 * 1024, (bfu*)(ws + OFF_WP), 1024, 1024, 256, 0, t / 8, t % 8};
  t -= 32;
  if (t < 64) return ConvD{P.in[I_PC] + (size_t)l * 512 * 1024, (bfu*)(ws + OFF_WP), 1024, 1024, 512, 0, t / 8, t % 8};
  t -= 64;
  if (t < 128) return ConvD{P.in[I_WOUT] + (size_t)l * 1024 * 1024, (bfu*)(ws + OFF_WO), 1024, 1024, 0, 0, t / 8, t % 8};
  t -= 128;
  if (t < 352) return ConvD{P.in[I_FG] + (size_t)l * 1024 * 2816, (bfu*)(ws + OFF_WGU), 2816, 1024, 0, 1, t / 22, t % 22};
  t -= 352;
  if (t < 352) return ConvD{P.in[I_FU] + (size_t)l * 1024 * 2816, (bfu*)(ws + OFF_WGU), 2816, 1024, 0, 2, t / 22, t % 22};
  t -= 352;
  if (t < 352) return ConvD{P.in[I_FD] + (size_t)l * 2816 * 1024, (bfu*)(ws + OFF_WDN), 1024, 2816, 0, 0, t / 8, t % 8};
  t -= 352;
  return ConvD{P.in[I_GLUW] + (size_t)l * 256 * 512, (bfu*)(ws + OFF_WGLU), 512, 256, 0, 3, t / 4, t % 4};
}
__device__ __forceinline__ void conv_ld(const ConvD& d, int tid, v4f (&r)[4]) {
  const int rr = tid >> 3, c0 = (tid & 7) * 8;
  const float* s0 = d.src + (size_t)(d.kt * 64 + rr) * d.N + d.ntp * 128 + c0;
  r[0] = *(const v4f*)s0; r[1] = *(const v4f*)(s0 + 4); r[2] = *(const v4f*)(s0 + 64); r[3] = *(const v4f*)(s0 + 68);
}
__device__ __forceinline__ void conv_lds_put(int tid, const v4f (&r)[4], float* tl) {
  const int rr = tid >> 3, c0 = (tid & 7) * 8;
  float* t0 = tl + c0 * 65 + rr;
  t0[0] = r[0].x; t0[65] = r[0].y; t0[130] = r[0].z; t0[195] = r[0].w; t0[260] = r[1].x; t0[325] = r[1].y; t0[390] = r[1].z; t0[455] = r[1].w;
  float* t1 = t0 + 64 * 65;
  t1[0] = r[2].x; t1[65] = r[2].y; t1[130] = r[2].z; t1[195] = r[2].w; t1[260] = r[3].x; t1[325] = r[3].y; t1[390] = r[3].z; t1[455] = r[3].w;
}
__device__ __forceinline__ void conv_out(const ConvD& d, int tid, const float* tl) {
#pragma unroll
  for (int hh = 0; hh < 2; ++hh) {
    int n = (tid >> 3) + hh * 64, k0 = (tid & 7) * 8;
    int drow = rowmap(d.mode, d.ntp * 128 + n);
    const float* t = tl + n * 65 + k0;
    uint4 o; o.x = pack2(t[0], t[1]); o.y = pack2(t[2], t[3]); o.z = pack2(t[4], t[5]); o.w = pack2(t[6], t[7]);
    *(uint4*)(d.dst + (size_t)drow * d.ldd + d.koff + d.kt * 64 + k0) = o;
  }
}
__device__ __forceinline__ void conv_stream(const Params& P, int l, int first, int stride, char* lds) {
  float* tl = (float*)lds;
  const int tid = tidx();
  asm volatile("" : "+s"(first), "+s"(stride));
  int it = first;
  v4f r[4];
  ConvD d = conv_desc(P, l, it < CONV_TILES ? it : 0);
  if (it < CONV_TILES) conv_ld(d, tid, r);
  while (it < CONV_TILES) {
    conv_lds_put(tid, r, tl);
    __syncthreads();
    const int nit = it + stride;
    const ConvD nd = conv_desc(P, l, nit < CONV_TILES ? nit : 0);
    if (nit < CONV_TILES) conv_ld(nd, tid, r);
    conv_out(d, tid, tl);
    __syncthreads();
    d = nd; it = nit;
  }
}

__device__ __forceinline__ void ada_item(const Params& P, int item, char* lds) {
  const int l = item / 96, cc = item % 96;
  float* sc = (float*)lds;
  float* red = sc + 3072;
  const int tid = tidx(), lane = tid & 63, w = tid >> 6;
  for (int i = tid; i < 3072; i += NTHR) {
    int cnd = i >> 10, k = i & 1023;
    float v = cnd == 0 ? P.in[I_CCTX][k] : P.in[I_C][(cnd - 1) * 1024 + k];
    sc[i] = v * sigm(v);
  }
  __syncthreads();
  const float* wp = P.in[I_ADAW] + (size_t)l * 1024 * 6144 + cc * 64 + lane;
  float a0 = 0.f, a1 = 0.f, a2 = 0.f;
#pragma unroll 1
  for (int k0 = w * 128; k0 < w * 128 + 128; k0 += 32) {
    float wv[32];
#pragma unroll
    for (int j = 0; j < 32; ++j) wv[j] = __builtin_nontemporal_load(wp + (size_t)(k0 + j) * 6144);
#pragma unroll
    for (int j = 0; j < 32; ++j) { a0 += sc[k0 + j] * wv[j]; a1 += sc[1024 + k0 + j] * wv[j]; a2 += sc[2048 + k0 + j] * wv[j]; }
  }
  red[(w * 3 + 0) * 64 + lane] = a0; red[(w * 3 + 1) * 64 + lane] = a1; red[(w * 3 + 2) * 64 + lane] = a2;
  __syncthreads();
  if (tid < 192) {
    int cnd = tid >> 6, c = tid & 63;
    float s = P.in[I_ADAB][l * 6144 + cc * 64 + c];
#pragma unroll
    for (int ww = 0; ww < 8; ++ww) s += red[(ww * 3 + cnd) * 64 + c];
    ((float*)(P.ws + OFF_MOD))[(l * 3 + cnd) * 6144 + cc * 64 + c] = s;
  }
  __syncthreads();
}

__device__ __forceinline__ void tables_item(const Params& P) {
  float2* tw = (float2*)(P.ws + OFF_TW);
  float2* rt = (float2*)(P.ws + OFF_RT);
  for (int k = tidx(); k < 4096; k += NTHR) { float s, c; sincospif((float)k / 4096.f, &s, &c); tw[k] = make_float2(c, -s); }
  for (int i = tidx(); i < 1024; i += NTHR) {
    int pos = i >> 4, f = i & 15;
    float inv = powf(10000.f, -(float)f / 16.f);
    float ang = (float)pos * inv;
    rt[i] = make_float2(cosf(ang), sinf(ang));
  }
}

__device__ __forceinline__ void filt_item(const Params& P, int l, int item2, char* lds) {
  const int item = item2 >> 1, chalf = item2 & 1;
  const bool isS = item >= 4;
  const int L = isS ? 4096 : 256;
  const int pb = isS ? item - 4 : item;
  float* F = (float*)(P.ws + (isS ? OFF_FS : OFF_FP));
  float* feat = (float*)lds;
  float* h1 = feat + 64 * 33;
  float* h2 = h1 + 64 * 65;
  const int tid = tidx();
  const int pos0 = pb * 64;
  const float tstep = 1.f / (float)(L - 1);
  for (int idx = tid; idx < 64 * 33; idx += NTHR) {
    int p = idx / 33, f = idx % 33;
    int pos = pos0 + p;
    float val;
    if (f == 0) val = (float)pos * tstep;
    else {
      int bi = (f - 1) & 15;
      float fr = (float)bi / 15.f;
      float band = 1e-4f * (1.f - fr) + 15.f * fr;
      float wv = 2.f * 3.14159265358979323846f * (float)pos / (float)L;
      float ang = wv * band;
      val = (f <= 16) ? cosf(ang) : -sinf(ang);
    }
    feat[idx] = val;
  }
  __syncthreads();
  const float* w1 = P.in[I_HW1] + (size_t)l * 33 * 64;
  const float* b1 = P.in[I_HB1] + l * 64;
  const float* w2 = P.in[I_HW2] + (size_t)l * 64 * 64;
  const float* b2 = P.in[I_HB2] + l * 64;
  const float* fq = P.in[I_HFREQ] + l * 64;
  for (int idx = tid; idx < 4096; idx += NTHR) {
    int p = idx >> 6, u = idx & 63;
    float s = b1[u];
    for (int f = 0; f < 33; ++f) s += feat[p * 33 + f] * w1[f * 64 + u];
    h1[p * 65 + u] = sinf(fq[u] * s);
  }
  __syncthreads();
  for (int idx = tid; idx < 4096; idx += NTHR) {
    int p = idx >> 6, u = idx & 63;
    float s = b2[u];
    for (int k = 0; k < 64; ++k) s += h1[p * 65 + k] * w2[k * 64 + u];
    h2[p * 65 + u] = sinf(fq[u] * s);
  }
  __syncthreads();
  const int lane = tid & 63, w = tid >> 6;
  float hr[64];
#pragma unroll
  for (int k = 0; k < 64; ++k) hr[k] = h2[lane * 65 + k];
  const float* w3 = P.in[I_HW3] + (size_t)l * 64 * 1024;
  const float* dec = P.in[I_HDEC] + l * 1024;
  const float tpos = (float)(pos0 + lane) * tstep;
  float* Wl = h2 + 64 * 65;
#pragma unroll 1
  for (int chunk = chalf * 4; chunk < chalf * 4 + 4; ++chunk) {
    __syncthreads();
    for (int i = tid; i < 2048; i += NTHR) {
      int k = i >> 5, c4 = i & 31;
      *(float4*)(Wl + k * 128 + c4 * 4) = *(const float4*)(w3 + k * 1024 + chunk * 128 + c4 * 4);
    }
    __syncthreads();
#pragma unroll 1
    for (int cgp = 0; cgp < 4; ++cgp) {
      const int cl = w * 16 + cgp * 4;
      float a0 = 0.f, a1 = 0.f, a2 = 0.f, a3 = 0.f;
#pragma unroll
      for (int k = 0; k < 64; ++k) {
        float4 wv = *(const float4*)(Wl + k * 128 + cl);
        a0 += hr[k] * wv.x; a1 += hr[k] * wv.y; a2 += hr[k] * wv.z; a3 += hr[k] * wv.w;
      }
      const int col = chunk * 128 + cl;
      F[(size_t)(col + 0) * L + pos0 + lane] = a0 * __expf(-tpos * fabsf(dec[col + 0]));
      F[(size_t)(col + 1) * L + pos0 + lane] = a1 * __expf(-tpos * fabsf(dec[col + 1]));
      F[(size_t)(col + 2) * L + pos0 + lane] = a2 * __expf(-tpos * fabsf(dec[col + 2]));
      F[(size_t)(col + 3) * L + pos0 + lane] = a3 * __expf(-tpos * fabsf(dec[col + 3]));
    }
  }
  __syncthreads();
}

__device__ __forceinline__ void s5pre_item(const Params& P, int l) {
  float2* lamb = (float2*)(P.ws + OFF_LAMB);
  float2* bbar = (float2*)(P.ws + OFF_BBAR);
  for (int idx = tidx(); idx < 2048; idx += NTHR) {
    float lre = P.in[I_LRE][l * 2048 + idx], lim = P.in[I_LIM][l * 2048 + idx];
    float step = expf(P.in[I_LSTEP][l * 32 + (idx >> 6)]);
    float er = expf(lre * step), sn, cs; sincosf(lim * step, &sn, &cs);
    float2 lb = make_float2(er * cs, er * sn);
    lamb[idx] = lb;
    float2 num = make_float2(lb.x - 1.f, lb.y);
    float den = lre * lre + lim * lim;
    float2 coef = make_float2((num.x * lre + num.y * lim) / den, (num.y * lre - num.x * lim) / den);
    const float* br = P.in[I_BRE] + ((size_t)l * 2048 + idx) * 16;
    const float* bi = P.in[I_BIM] + ((size_t)l * 2048 + idx) * 16;
    for (int c = 0; c < 16; ++c) bbar[idx * 16 + c] = cmul(coef, make_float2(br[c], bi[c]));
  }
}

__device__ __forceinline__ void norm_phase(const Params& P, int l, int which) {
  const int lane = tidx() & 63, w = tidx() >> 6;
  const float* gam = P.in[which ? I_N2G : I_N1G] + l * 1024;
  bfu* AB = (bfu*)(P.ws + OFF_AB);
  for (int row = bidx() * 8 + w; row < TT; row += gdim() * 8) {
    const float* x = which ? (const float*)(P.ws + OFF_XB) + (size_t)row * 1024 : xrow(P, l, row);
    const float* md = (const float*)(P.ws + OFF_MOD) + (l * 3 + cond_of(row)) * 6144 + which * 3072;
    float4 v[4]; float ss = 0.f;
#pragma unroll
    for (int i = 0; i < 4; ++i) { v[i] = *(const float4*)(x + i * 256 + lane * 4); ss += v[i].x * v[i].x + v[i].y * v[i].y + v[i].z * v[i].z + v[i].w * v[i].w; }
#pragma unroll
    for (int o = 32; o > 0; o >>= 1) ss += __shfl_xor(ss, o);
    float rs = rsqrtf(ss * (1.f / 1024.f) + 1e-6f);
#pragma unroll
    for (int i = 0; i < 4; ++i) {
      int c = i * 256 + lane * 4;
      float4 g = *(const float4*)(gam + c), sh = *(const float4*)(md + c), sc = *(const float4*)(md + 1024 + c);
      float o0 = v[i].x * rs * g.x * (1.f + sc.x) + sh.x, o1 = v[i].y * rs * g.y * (1.f + sc.y) + sh.y;
      float o2 = v[i].z * rs * g.z * (1.f + sc.z) + sh.z, o3 = v[i].w * rs * g.w * (1.f + sc.w) + sh.w;
      uint2 o; o.x = pack2(o0, o1); o.y = pack2(o2, o3);
      *(uint2*)(AB + (size_t)row * 1024 + c) = o;
    }
  }
}
__device__ __forceinline__ void final_phase(const Params& P) {
  const int lane = tidx() & 63, w = tidx() >> 6;
  const float* gam = P.in[I_FNG];
  for (int row = bidx() * 8 + w; row < TT; row += gdim() * 8) {
    const float* x = (const float*)(P.ws + OFF_X) + (size_t)row * 1024;
    float* y = P.out + (size_t)row * 1024;
    float4 v[4]; float ss = 0.f;
#pragma unroll
    for (int i = 0; i < 4; ++i) { v[i] = *(const float4*)(x + i * 256 + lane * 4); ss += v[i].x * v[i].x + v[i].y * v[i].y + v[i].z * v[i].z + v[i].w * v[i].w; }
#pragma unroll
    for (int o = 32; o > 0; o >>= 1) ss += __shfl_xor(ss, o);
    float rs = rsqrtf(ss * (1.f / 1024.f) + 1e-6f);
#pragma unroll
    for (int i = 0; i < 4; ++i) {
      int c = i * 256 + lane * 4;
      float4 g = *(const float4*)(gam + c);
      *(float4*)(y + c) = make_float4(v[i].x * rs * g.x, v[i].y * rs * g.y, v[i].z * rs * g.z, v[i].w * rs * g.w);
    }
  }
}

namespace pg8 {
#define PG8_LAS __attribute__((address_space(3)))
typedef unsigned short bf16_t;
typedef short bf16x8 __attribute__((ext_vector_type(8)));
typedef float f32x4 __attribute__((ext_vector_type(4)));
typedef unsigned u32x4 __attribute__((ext_vector_type(4)));
constexpr int BM = 256, BK = 64, HALF = 128, HTB = HALF * BK * 2  , STAGE_BYTES = 8 * HTB, NXCD = 8, WGM = 8;

__host__ __device__ __forceinline__ int lds_byte(int r, int c) { const int st = (r >> 4) * 2 + (c >> 5), rr = r & 15, cc = c & 31, ob = rr * 64 + cc * 2; return st * 1024 + (ob ^ (((ob >> 9) & 1) << 5)); }
__host__ __device__ __forceinline__ void stage_rc(int b, int& R, int& C) { const int st = b / 1024, sb = b % 1024, swz = sb ^ (((sb >> 9) & 1) << 5); R = (st >> 1) * 16 + swz / 64; C = (st & 1) * 32 + (swz % 64) / 2; }
__host__ __device__ __forceinline__ int perm32(int rho) { const int n = rho >> 4, i = rho & 15; return 8 * (i >> 2) + 4 * n + (i & 3); }

struct Unit { int pm, pn; };
struct Gemm { const bf16_t* A; const bf16_t* Bt; int M, N, K; };

struct StaticOrder {
    int nM, nN, nwg, G, c;
    __host__ __device__ void init(int M, int N, int G_, int c_) { nM = M / BM; nN = N / BM; nwg = nM * nN; G = G_; c = c_; }
    __host__ __device__ bool next(int i, Unit& u) const {
        const long L = (long)i * G + c; if (L >= nwg) return false;
        int wgid = (int)L; { const int q = nwg / NXCD, r = nwg % NXCD, xcd = wgid % NXCD, off = wgid / NXCD; wgid = (xcd < r ? xcd * (q + 1) : r * (q + 1) + (xcd - r) * q) + off; }
        const int nig = WGM * nN, gid = wgid / nig, fm = gid * WGM, gsz = (nM - fm) < WGM ? (nM - fm) : WGM;
        u.pm = fm + ((wgid % nig) % gsz); u.pn = (wgid % nig) / gsz; return true;
    }
    __device__ __forceinline__ void a_ready(const Unit&) const {}
    __device__ __forceinline__ void done(const Unit&) const {}
};
__device__ __forceinline__ unsigned cvt_pk_bf16(float lo, float hi) { unsigned r; asm volatile("v_cvt_pk_bf16_f32 %0, %1, %2" : "=v"(r) : "v"(lo), "v"(hi)); return r; }
template <class Epi, class Sched, bool STAMP = false>
__device__ __forceinline__ void gemm_phase(PG8_LAS unsigned char* lds, const Gemm g, const Sched& S, const Epi& E, unsigned long long* stamps) {
    const int tid = tidx(), wid = __builtin_amdgcn_readfirstlane(tid >> 6), lane = tid & 63, wr = wid >> 2, wc = wid & 3, fr = lane & 15, fq = lane >> 4;
    const int K = g.K, nt = K / BK;
    int ts_lo = 0, ts_hi = 0, nts = 0; const unsigned long long rt_entry = STAMP ? (unsigned long long)wall_clock64() : 0ull;
#define PG8_STAMP() do { if (STAMP && wid == 0 && nts < 64) { const unsigned long long _c = (unsigned long long)clock64(); \
        ts_lo = (lane == nts) ? (int)(unsigned)_c : ts_lo; ts_hi = (lane == nts) ? (int)(unsigned)(_c >> 32) : ts_hi; ++nts; } } while (0)
    PG8_STAMP();
    unsigned voffA[2], voffB[2];
#pragma unroll
    for (int i = 0; i < 2; ++i) { int R, C; stage_rc(tid * 16 + i * 8192, R, C); const int Rb = Epi::PERM ? ((R & ~31) + perm32(R & 31)) : R;
        voffA[i] = (unsigned)(R * K + C) * 2u; voffB[i] = (unsigned)(Rb * K + C) * 2u; }
    const size_t kstep = (size_t)(BK * 2);
    const size_t hstep = (size_t)HALF * K * 2;
    const size_t tstep = 2 * hstep;
    const unsigned ldsw = (unsigned)wid * 1024u;
    const int aoff = lds_byte(wr * 64 + fr, fq * 8), boff = lds_byte(wc * 32 + fr, fq * 8);
#define PG8_SA(b, h) (((b) * 2 + (h)) * HTB)
#define PG8_SB(b, h) ((4 + (b) * 2 + (h)) * HTB)
#define PG8_STAGE(bufoff, gbase, voff) do { _Pragma("unroll") for (int _i = 0; _i < 2; ++_i) \
        __builtin_amdgcn_global_load_lds((const unsigned*)((const char*)(gbase) + (voff)[_i]), (PG8_LAS unsigned*)(lds + (bufoff) + ldsw + _i * 8192), 16, 0, 0); } while (0)
#define PG8_LDA(dst, b, h) do { _Pragma("unroll") for (int m = 0; m < 4; ++m) _Pragma("unroll") for (int k = 0; k < 2; ++k) dst[m][k] = *(const PG8_LAS bf16x8*)(lds + PG8_SA(b, h) + aoff + m * 2048 + k * 1024); } while (0)
#define PG8_LDB(dst, b, h) do { _Pragma("unroll") for (int n = 0; n < 2; ++n) _Pragma("unroll") for (int k = 0; k < 2; ++k) dst[n][k] = *(const PG8_LAS bf16x8*)(lds + PG8_SB(b, h) + boff + n * 2048 + k * 1024); } while (0)
#define PG8_MMA(ai, bj, At, Bt) do { __builtin_amdgcn_s_setprio(1); _Pragma("unroll") for (int m = 0; m < 4; ++m) _Pragma("unroll") for (int n = 0; n < 2; ++n) _Pragma("unroll") for (int k = 0; k < 2; ++k) \
        acc[ai][bj][m][n] = __builtin_amdgcn_mfma_f32_16x16x32_bf16(Bt[n][k], At[m][k], acc[ai][bj][m][n], 0, 0, 0); __builtin_amdgcn_s_setprio(0); } while (0)
#define PG8_WAIT_V(n) asm volatile("s_waitcnt vmcnt(" #n ")" ::: "memory")
#define PG8_WAIT_L(n) asm volatile("s_waitcnt lgkmcnt(" #n ")" ::: "memory")
#define PG8_BAR __builtin_amdgcn_s_barrier()
#define PG8_SCHED __builtin_amdgcn_sched_barrier(0)
    Unit cur, nxt; int ui = 0;
    if (!S.next(0, cur)) return;
    f32x4 acc[2][2][4][2];
#pragma unroll
    for (int a = 0; a < 2; ++a)
#pragma unroll
        for (int b = 0; b < 2; ++b)
#pragma unroll
            for (int m = 0; m < 4; ++m)
#pragma unroll
                for (int n = 0; n < 2; ++n) acc[a][b][m][n] = (f32x4){0.f, 0.f, 0.f, 0.f};
    bf16x8 At[4][2], B0[2][2], B1[2][2];
    const char* cA = (const char*)g.A + (size_t)cur.pm * tstep; const char* cB = (const char*)g.Bt + (size_t)cur.pn * tstep;
    S.a_ready(cur);
    PG8_STAGE(PG8_SB(0, 0), cB, voffB); PG8_STAGE(PG8_SA(0, 0), cA, voffA); PG8_STAGE(PG8_SB(0, 1), cB + hstep, voffB); PG8_STAGE(PG8_SA(0, 1), cA + hstep, voffA);
    if (wr == 1) PG8_BAR;
    PG8_WAIT_V(4); PG8_BAR;
    PG8_STAGE(PG8_SB(1, 0), cB + kstep, voffB); PG8_STAGE(PG8_SA(1, 0), cA + kstep, voffA); PG8_STAGE(PG8_SB(1, 1), cB + hstep + kstep, voffB);
    PG8_WAIT_V(6); PG8_BAR;
    PG8_STAMP();
    for (;;) {
        const bool has_next = S.next(ui + 1, nxt);
        const char* nA = has_next ? (const char*)g.A + (size_t)nxt.pm * tstep : cA; const char* nB = has_next ? (const char*)g.Bt + (size_t)nxt.pn * tstep : cB;
        for (int t = 0; t < nt; t += 2) {
            const bool last = (t == nt - 2);
            const char* a1 = cA + (size_t)(t + 1) * kstep;
            const char* a2 = last ? nA : cA + (size_t)(t + 2) * kstep; const char* b2 = last ? nB : cB + (size_t)(t + 2) * kstep;
            const char* a3 = a2 + kstep; const char* b3 = b2 + kstep;
            if (last && has_next) S.a_ready(nxt);
            PG8_LDB(B0, 0, 0); PG8_SCHED; PG8_LDA(At, 0, 0); PG8_STAGE(PG8_SA(1, 1), a1 + hstep, voffA);
            PG8_WAIT_L(8); PG8_BAR; PG8_WAIT_L(0); PG8_MMA(0, 0, At, B0); PG8_BAR; PG8_SCHED;
            PG8_LDB(B1, 0, 1); PG8_STAGE(PG8_SB(0, 0), b2, voffB);
            PG8_BAR; PG8_WAIT_L(0); PG8_MMA(0, 1, At, B1); PG8_BAR;
            PG8_LDA(At, 0, 1); PG8_STAGE(PG8_SA(0, 0), a2, voffA);
            PG8_BAR; PG8_WAIT_L(0); PG8_MMA(1, 0, At, B0); PG8_BAR; PG8_SCHED;
            PG8_STAGE(PG8_SB(0, 1), b2 + hstep, voffB);
            PG8_WAIT_V(6); PG8_BAR; PG8_MMA(1, 1, At, B1); PG8_BAR;
            PG8_LDB(B0, 1, 0); PG8_SCHED; PG8_LDA(At, 1, 0); PG8_STAGE(PG8_SA(0, 1), a2 + hstep, voffA);
            PG8_WAIT_L(8); PG8_BAR; PG8_WAIT_L(0); PG8_MMA(0, 0, At, B0); PG8_BAR; PG8_SCHED;
            PG8_LDB(B1, 1, 1); PG8_STAGE(PG8_SB(1, 0), b3, voffB);
            PG8_BAR; PG8_WAIT_L(0); PG8_MMA(0, 1, At, B1); PG8_BAR;
            PG8_LDA(At, 1, 1); PG8_STAGE(PG8_SA(1, 0), a3, voffA);
            PG8_BAR; PG8_WAIT_L(0); PG8_MMA(1, 0, At, B0); PG8_BAR; PG8_SCHED;
            PG8_STAGE(PG8_SB(1, 1), b3 + hstep, voffB);
            PG8_WAIT_V(6); PG8_BAR; PG8_MMA(1, 1, At, B1); PG8_BAR;
        }
        PG8_STAMP();
        if constexpr (!Epi::AFTER_DRAIN) { E(acc, cur, wr, wc, fr, fq); S.done(cur); }
        PG8_STAMP();
        if (!has_next) break;
#pragma unroll
        for (int a = 0; a < 2; ++a)
#pragma unroll
            for (int b = 0; b < 2; ++b)
#pragma unroll
                for (int m = 0; m < 4; ++m)
#pragma unroll
                    for (int n = 0; n < 2; ++n) acc[a][b][m][n] = (f32x4){0.f, 0.f, 0.f, 0.f};
        cur = nxt; cA = nA; cB = nB; ++ui;
    }
    PG8_WAIT_V(0);
    if (wr == 0) PG8_BAR;
    PG8_BAR;
    if constexpr (Epi::AFTER_DRAIN) { E.fused(acc, cur, wr, wc, fr, fq, lds, wid, lane); S.done(cur); }
    PG8_STAMP();
    if (STAMP && wid == 0) { stamps[lane] = lane < nts ? (((unsigned long long)(unsigned)ts_hi << 32) | (unsigned)ts_lo) : 0ull;
        if (lane == 62) stamps[62] = rt_entry; if (lane == 63) stamps[63] = (unsigned long long)wall_clock64(); }
#undef PG8_STAMP
#undef PG8_SA
#undef PG8_SB
#undef PG8_STAGE
#undef PG8_LDA
#undef PG8_LDB
#undef PG8_MMA
#undef PG8_WAIT_V
#undef PG8_WAIT_L
#undef PG8_BAR
#undef PG8_SCHED
}
}

struct EpiIn {
  static constexpr bool PERM = false, AFTER_DRAIN = false;
  const Params* Pp; int l;
  __device__ __forceinline__ void operator()(const pg8::f32x4 (&acc)[2][2][4][2], const pg8::Unit& u, int wr, int wc, int fr, int fq) const {
    const Params& P = *Pp;
    const int row0 = u.pm * 256 + wr * 64 + fr;
#pragma unroll
    for (int bj = 0; bj < 2; ++bj) {
      const int colb = u.pn * 256 + bj * 128;
#pragma unroll
      for (int ai = 0; ai < 2; ++ai)
#pragma unroll
        for (int m = 0; m < 4; ++m) {
          const int row = row0 + ai * 128 + m * 16;
#pragma unroll
          for (int n = 0; n < 2; ++n) {
            const int c = colb + wc * 32 + n * 16 + 4 * fq;
            const pg8::f32x4 v = acc[ai][bj][m][n];
            if (colb < 768) {
              float* zt = (float*)(P.ws + OFF_ZAT) + (size_t)c * TT + row;
              zt[0] = v[0]; zt[TT] = v[1]; zt[2 * (size_t)TT] = v[2]; zt[3 * (size_t)TT] = v[3];
            } else if (colb < 1024) *(pg8::f32x4*)((float*)(P.ws + OFF_ZB) + (size_t)row * 256 + c - 768) = v;
            else if (colb < 1536) *(pg8::f32x4*)((float*)(P.ws + OFF_Q) + (size_t)row * 512 + c - 1024) = v;
            else if (colb < 1792) {
              const bool isv = colb >= 1664;
              const int cc = c - (isv ? 1664 : 1536);
              float* dst = row < 4096 ? P.out + (isv ? OUT_V : OUT_K) + ((size_t)((row >> 8) * 4 + l) * 256 + (row & 255)) * 128 + cc
                                      : (float*)(P.ws + (isv ? OFF_VS : OFF_KS)) + (size_t)(row - 4096) * 128 + cc;
              *(pg8::f32x4*)dst = v;
            } else {
              uint2 o; o.x = pack2(sigm(v[0]), sigm(v[1])); o.y = pack2(sigm(v[2]), sigm(v[3]));
              *(uint2*)((bfu*)(P.ws + OFF_G) + (size_t)row * 3072 + c - 1792) = o;
            }
          }
        }
    }
  }
};
struct EpiFfnUp {
  static constexpr bool PERM = false, AFTER_DRAIN = false;
  bfu* HID;
  __device__ __forceinline__ void operator()(const pg8::f32x4 (&acc)[2][2][4][2], const pg8::Unit& u, int wr, int wc, int fr, int fq) const {
    const int row0 = u.pm * 256 + wr * 64 + fr;
#pragma unroll
    for (int ai = 0; ai < 2; ++ai)
#pragma unroll
      for (int m = 0; m < 4; ++m) {
        const int row = row0 + ai * 128 + m * 16;
#pragma unroll
        for (int bj = 0; bj < 2; ++bj) {
          const int hc = u.pn * 128 + bj * 64 + wc * 16 + 4 * fq;
          const pg8::f32x4 g = acc[ai][bj][m][0], up = acc[ai][bj][m][1];
          uint2 o; o.x = pack2(g[0] * sigm(g[0]) * up[0], g[1] * sigm(g[1]) * up[1]); o.y = pack2(g[2] * sigm(g[2]) * up[2], g[3] * sigm(g[3]) * up[3]);
          *(uint2*)(HID + (size_t)row * 2816 + hc) = o;
        }
      }
  }
};
struct EpiResid {
  static constexpr bool PERM = false, AFTER_DRAIN = false;
  const Params* Pp; int l; int which;
  __device__ __forceinline__ void operator()(const pg8::f32x4 (&acc)[2][2][4][2], const pg8::Unit& u, int wr, int wc, int fr, int fq) const {
    const Params& P = *Pp;
    const int row0 = u.pm * 256 + wr * 64 + fr;
    const float* gate = (const float*)(P.ws + OFF_MOD) + (l * 3 + cond_of(u.pm * 256)) * 6144 + (which ? 5120 : 2048);
    float* XA = (float*)(P.ws + OFF_X);
    float* XB = (float*)(P.ws + OFF_XB);
#pragma unroll
    for (int bj = 0; bj < 2; ++bj)
#pragma unroll
      for (int n = 0; n < 2; ++n) {
        const int c = u.pn * 256 + bj * 128 + wc * 32 + n * 16 + 4 * fq;
        const pg8::f32x4 gv = *(const pg8::f32x4*)(gate + c);
#pragma unroll
        for (int ai = 0; ai < 2; ++ai)
#pragma unroll
          for (int m = 0; m < 4; ++m) {
            const int row = row0 + ai * 128 + m * 16;
            const float* xs = which ? XB + (size_t)row * 1024 + c : xrow(P, l, row) + c;
            float* xd = (which ? XA : XB) + (size_t)row * 1024 + c;
            const pg8::f32x4 xin = *(const pg8::f32x4*)xs;
            *(pg8::f32x4*)xd = xin + gv * acc[ai][bj][m][n];
          }
      }
  }
};

struct EpiAll {
  static constexpr bool PERM = false, AFTER_DRAIN = false;
  const Params* Pp; int l; int mode;
  __device__ __forceinline__ void operator()(const pg8::f32x4 (&acc)[2][2][4][2], const pg8::Unit& u, int wr, int wc, int fr, int fq) const {
    if (mode == 0) { EpiIn e{Pp, l}; e(acc, u, wr, wc, fr, fq); }
    else if (mode == 1) { EpiFfnUp e{(bfu*)(Pp->ws + OFF_G)}; e(acc, u, wr, wc, fr, fq); }
    else { EpiResid e{Pp, l, mode - 2}; e(acc, u, wr, wc, fr, fq); }
  }
};
__device__ __forceinline__ void big_gemm_phase(const Params& P, int l, int mode, char* lds) {
  const bfu* A = (const bfu*)(P.ws + (mode == 3 ? OFF_G : OFF_AB));
  const bfu* B = (const bfu*)(P.ws + (mode == 0 ? OFF_WIN : mode == 1 ? OFF_WGU : mode == 2 ? OFF_WO : OFF_WDN));
  const int N = mode == 0 ? 4864 : mode == 1 ? 5632 : 1024;
  const int K = mode == 3 ? 2816 : 1024;
  pg8::Gemm g{A, B, TT, N, K};
  pg8::StaticOrder S; S.init(TT, N, gdim(), bidx());
  EpiAll E{&P, l, mode};
  pg8::gemm_phase<EpiAll, pg8::StaticOrder, false>((PG8_LAS unsigned char*)lds, g, S, E, nullptr);
}

__device__ __forceinline__ int tile_slots(int MT, int NT) { return (MT >> 3) * ((NT + 3) >> 2) * 32; }
__device__ __forceinline__ bool tile_map(int it, int MT, int NT, int& mt, int& nt) {
  int T = it;
  if (gdim() == 256) { const int b = it & 255, j = it >> 8; T = ((j * 8 + (b & 7)) << 5) + (b >> 3); }
  const int patch = T >> 5, ip = T & 31, pmc = MT >> 3;
  mt = (patch % pmc) * 8 + (ip & 7); nt = (patch / pmc) * 4 + (ip >> 3);
  return nt < NT && T < tile_slots(MT, NT);
}
#define TILE_LOOP(MT_, NT_) const int nslots_ = (tile_slots(MT_, NT_) + 255) / 256 * 256; \
  for (int it_ = bidx(); it_ < nslots_; it_ += gdim()) { int mt, nt; if (!tile_map(it_, MT_, NT_, mt, nt)) continue;

#define EPI_ROW(MI_, mi, reg) (wm * 32 * MI_ + (mi) * 32 + ((reg) & 3) + 8 * ((reg) >> 2) + 4 * h)

__device__ __forceinline__ void glu_phase(const Params& P, int l, char* lds) {
  const int tid = tidx(), lane = tid & 63, w = tid >> 6, wm = w & 3, wn = w >> 2, r = lane & 31, h = lane >> 5;
  const bfu* A = (const bfu*)(P.ws + OFF_YS5);
  const bfu* B = (const bfu*)(P.ws + OFF_WGLU);
  const float* bias = P.in[I_GLUB] + l * 512;
  bfu* YC = (bfu*)(P.ws + OFF_YCAT);
  TILE_LOOP(96, 4)
    const int m0 = mt * 128;
    f32x16 acc[1][2]; zero_acc<1>(acc);
    gemm_core<1>(A + (size_t)m0 * 256, 256, B + (size_t)(nt * 128) * 256, 256, 256, acc, lds);
    const int cj = nt * 64 + wn * 32 + r;
    const float ba = bias[cj], bg = bias[256 + cj];
#pragma unroll
    for (int reg = 0; reg < 16; ++reg) {
      const int row = m0 + EPI_ROW(1, 0, reg);
      float a = acc[0][0][reg] + ba, g = acc[0][1][reg] + bg;
      YC[(size_t)row * 1024 + 256 + cj] = f2bf(a * sigm(g));
    }
  }
}

__device__ __forceinline__ void proj_phase(const Params& P, int l, char* lds) {
  const int tid = tidx(), lane = tid & 63, w = tid >> 6, wm = w & 3, wn = w >> 2, r = lane & 31, h = lane >> 5;
  const bfu* A = (const bfu*)(P.ws + OFF_YCAT);
  const bfu* B = (const bfu*)(P.ws + OFF_WP);
  const bfu* G = (const bfu*)(P.ws + OFF_G);
  bfu* AB = (bfu*)(P.ws + OFF_AB);
  TILE_LOOP(96, 8)
    const int m0 = mt * 128, n0 = nt * 128;
    f32x16 mg[1][2]; zero_acc<1>(mg);
#pragma unroll 1
    for (int seg = 0; seg < 3; ++seg) {
      const int koff = seg * 256, klen = seg == 2 ? 512 : 256;
      float gq[2][16];
#pragma unroll
      for (int ni = 0; ni < 2; ++ni) {
        const int col = n0 + wn * 64 + ni * 32 + r;
#pragma unroll
        for (int reg = 0; reg < 16; ++reg) gq[ni][reg] = bf2f(G[(size_t)(m0 + EPI_ROW(1, 0, reg)) * 3072 + seg * 1024 + col]);
      }
      f32x16 acc[1][2]; zero_acc<1>(acc);
      gemm_core<1>(A + (size_t)m0 * 1024 + koff, 1024, B + (size_t)n0 * 1024 + koff, 1024, klen, acc, lds);
#pragma unroll
      for (int ni = 0; ni < 2; ++ni)
#pragma unroll
        for (int reg = 0; reg < 16; ++reg) mg[0][ni][reg] += gq[ni][reg] * acc[0][ni][reg];
    }
#pragma unroll
    for (int ni = 0; ni < 2; ++ni) {
      const int col = n0 + wn * 64 + ni * 32 + r;
#pragma unroll
      for (int reg = 0; reg < 16; ++reg) AB[(size_t)(m0 + EPI_ROW(1, 0, reg)) * 1024 + col] = f2bf(mg[0][ni][reg]);
    }
  }
}

__device__ __forceinline__ float short_conv(const float* __restrict__ z, int t, int L, float w0, float w1, float w2, float b) {
  float s = b + w1 * z[t];
  if (t > 0) s += w0 * z[t - 1];
  if (t < L - 1) s += w2 * z[t + 1];
  return s;
}

#define TWD(k) tw[(k) + ((k) >> 6)]
__device__ __forceinline__ float2 cadd(float2 a, float2 b) { return make_float2(a.x + b.x, a.y + b.y); }
__device__ __forceinline__ float2 csub(float2 a, float2 b) { return make_float2(a.x - b.x, a.y - b.y); }
__device__ __forceinline__ void fft_fwd(float2* data, const float2* tw) {
  const int tid = tidx();
#pragma unroll
  for (int it = 0; it < 8; ++it) {
    int i = tid + it * NTHR;
    float2 a = data[i], b = data[i + 4096], wv = TWD(i);
    data[i] = cadd(a, b);
    data[i + 4096] = cmul(csub(a, b), wv);
  }
  __syncthreads();
#pragma unroll
  for (int s = 11; s >= 3; s -= 2) {
    const int q = 1 << (s - 1);
#pragma unroll
    for (int it = 0; it < 4; ++it) {
      int i = tid + it * NTHR;
      int j = i & (q - 1);
      int base = ((i >> (s - 1)) << (s + 1)) | j;
      float2 x0 = data[base], x1 = data[base + q], x2 = data[base + 2 * q], x3 = data[base + 3 * q];
      float2 w1 = TWD(j << (12 - s)), w2 = TWD(j << (13 - s));
      float2 a0 = cadd(x0, x2), a2 = cmul(csub(x0, x2), w1), a1 = cadd(x1, x3);
      float2 t3 = cmul(csub(x1, x3), w1); float2 a3 = make_float2(t3.y, -t3.x);
      data[base] = cadd(a0, a1); data[base + q] = cmul(csub(a0, a1), w2);
      data[base + 2 * q] = cadd(a2, a3); data[base + 3 * q] = cmul(csub(a2, a3), w2);
    }
    __syncthreads();
  }
#pragma unroll
  for (int it = 0; it < 4; ++it) {
    int i = tid + it * NTHR;
    float4 p0 = *(float4*)(data + 4 * i), p1 = *(float4*)(data + 4 * i + 2);
    float2 x0 = make_float2(p0.x, p0.y), x1 = make_float2(p0.z, p0.w), x2 = make_float2(p1.x, p1.y), x3 = make_float2(p1.z, p1.w);
    float2 a0 = cadd(x0, x2), a2 = csub(x0, x2), a1 = cadd(x1, x3);
    float2 t3 = csub(x1, x3); float2 a3 = make_float2(t3.y, -t3.x);
    float2 y0 = cadd(a0, a1), y1 = csub(a0, a1), y2 = cadd(a2, a3), y3 = csub(a2, a3);
    *(float4*)(data + 4 * i) = make_float4(y0.x, y0.y, y1.x, y1.y);
    *(float4*)(data + 4 * i + 2) = make_float4(y2.x, y2.y, y3.x, y3.y);
  }
  __syncthreads();
}
__device__ __forceinline__ void fft_inv(float2* data, const float2* tw) {
  const int tid = tidx();
#pragma unroll
  for (int it = 0; it < 4; ++it) {
    int i = tid + it * NTHR;
    float4 p0 = *(float4*)(data + 4 * i), p1 = *(float4*)(data + 4 * i + 2);
    float2 x0 = make_float2(p0.x, p0.y), x1 = make_float2(p0.z, p0.w), x2 = make_float2(p1.x, p1.y), x3 = make_float2(p1.z, p1.w);
    float2 a0 = cadd(x0, x1), a1 = csub(x0, x1), a2 = cadd(x2, x3), a3 = csub(x2, x3);
    float2 c3 = make_float2(-a3.y, a3.x);
    float2 y0 = cadd(a0, a2), y2 = csub(a0, a2), y1 = cadd(a1, c3), y3 = csub(a1, c3);
    *(float4*)(data + 4 * i) = make_float4(y0.x, y0.y, y1.x, y1.y);
    *(float4*)(data + 4 * i + 2) = make_float4(y2.x, y2.y, y3.x, y3.y);
  }
  __syncthreads();
#pragma unroll
  for (int s = 2; s <= 10; s += 2) {
    const int q = 1 << s;
#pragma unroll
    for (int it = 0; it < 4; ++it) {
      int i = tid + it * NTHR;
      int j = i & (q - 1);
      int base = ((i >> s) << (s + 2)) | j;
      float2 x0 = data[base], x1 = data[base + q], x2 = data[base + 2 * q], x3 = data[base + 3 * q];
      float2 w1 = TWD(j << (12 - s)), w2 = TWD(j << (11 - s));
      w1.y = -w1.y; w2.y = -w2.y;
      float2 b1 = cmul(x1, w1), b3 = cmul(x3, w1);
      float2 a0 = cadd(x0, b1), a1 = csub(x0, b1), a2 = cadd(x2, b3), a3 = csub(x2, b3);
      float2 c2 = cmul(a2, w2), t3 = cmul(a3, w2); float2 c3 = make_float2(-t3.y, t3.x);
      data[base] = cadd(a0, c2); data[base + 2 * q] = csub(a0, c2);
      data[base + q] = cadd(a1, c3); data[base + 3 * q] = csub(a1, c3);
    }
    __syncthreads();
  }
#pragma unroll
  for (int it = 0; it < 8; ++it) {
    int i = tid + it * NTHR;
    float2 wv = TWD(i); wv.y = -wv.y;
    float2 a = data[i], b = cmul(data[i + 4096], wv);
    data[i] = cadd(a, b);
    data[i + 4096] = csub(a, b);
  }
  __syncthreads();
}
__device__ __forceinline__ float block_sum(float v, float* red) {
  const int lane = tidx() & 63, w = tidx() >> 6;
#pragma unroll
  for (int o = 32; o > 0; o >>= 1) v += __shfl_xor(v, o);
  __syncthreads();
  if (lane == 0) red[w] = v;
  __syncthreads();
  float s = 0.f;
#pragma unroll
  for (int i = 0; i < 8; ++i) s += red[i];
  return s;
}

__device__ __forceinline__ void hyena_sample_item(const Params& P, int l, int c, char* lds) {
  float2* data = (float2*)lds;
  float2* tw = data + 8192;
  __shared__ float red[8];
  const int tid = tidx();
  const int L = 4096;
  const float* FS = (const float*)(P.ws + OFF_FS);
  const float* ZAT = (const float*)(P.ws + OFF_ZAT);
  const float* cw = P.in[I_HCW] + l * 3 * 768;
  const float* cb = P.in[I_HCB] + l * 768;
  {
    const float2* twg = (const float2*)(P.ws + OFF_TW);
    for (int i = tid; i < 4096; i += NTHR) tw[i + (i >> 6)] = twg[i];
  }
  float2 vreg[8];
  float2 KfA[16], KfB[16];
  {
    const float* hf0 = FS + (size_t)(0 * 256 + c) * L; const float* hb0 = FS + (size_t)(1 * 256 + c) * L;
    const float* hf1 = FS + (size_t)(2 * 256 + c) * L; const float* hb1 = FS + (size_t)(3 * 256 + c) * L;
    float as0 = 0.f, as1 = 0.f;
#pragma unroll
    for (int m = 0; m < 16; ++m) {
      int n = tid + m * NTHR;
      float v0 = n < L ? hf0[n] : (n == L ? 0.f : hb0[2 * L - n]);
      float v1 = n < L ? hf1[n] : (n == L ? 0.f : hb1[2 * L - n]);
      as0 += fabsf(v0); as1 += fabsf(v1);
      data[n] = make_float2(v0, v1);
    }
    const float nrm0 = block_sum(as0, red);
    const float nrm1 = block_sum(as1, red);
    fft_fwd(data, tw);
    const float k0s = 0.5f / (nrm0 * 8192.f), k1s = 0.5f / (nrm1 * 8192.f);
#pragma unroll
    for (int m = 0; m < 16; ++m) {
      const int r = tid + m * NTHR;
      const unsigned n = __brev((unsigned)r) >> 19;
      const unsigned rp = __brev(((8192u - n) & 8191u)) >> 19;
      const float2 A = data[r], Bz = data[rp];
      KfA[m] = make_float2((A.x + Bz.x) * k0s, (A.y - Bz.y) * k0s);
      KfB[m] = make_float2((A.y + Bz.y) * k1s, (Bz.x - A.x) * k1s);
    }
    __syncthreads();
  }
#pragma unroll
  for (int o = 0; o < 2; ++o) {
    float2 Kf[16];
#pragma unroll
    for (int m = 0; m < 16; ++m) Kf[m] = o == 0 ? KfA[m] : KfB[m];
    if (o == 0) {
      const float w0 = cw[c], w1 = cw[768 + c], w2 = cw[1536 + c], b = cb[c];
      const float* z0 = ZAT + (size_t)c * TT + 4096;
#pragma unroll
      for (int m = 0; m < 8; ++m) {
        int t = tid + m * NTHR;
        vreg[m] = make_float2(short_conv(z0, t, L, w0, w1, w2, b), short_conv(z0 + 4096, t, L, w0, w1, w2, b));
      }
    }
#pragma unroll
    for (int m = 0; m < 8; ++m) { int t = tid + m * NTHR; data[t] = vreg[m]; data[t + L] = make_float2(0.f, 0.f); }
    __syncthreads();
    fft_fwd(data, tw);
#pragma unroll
    for (int m = 0; m < 16; ++m) { int n = tid + m * NTHR; data[n] = cmul(data[n], Kf[m]); }
    __syncthreads();
    fft_inv(data, tw);
    {
      const int gc = (o + 1) * 256 + c;
      const float w0 = cw[gc], w1 = cw[768 + gc], w2 = cw[1536 + gc], b = cb[gc];
      const float* zg = ZAT + (size_t)gc * TT + 4096;
      const float sk = P.in[I_HSKIP][(l * 2 + o) * 256 + c];
#pragma unroll
      for (int m = 0; m < 8; ++m) {
        int t = tid + m * NTHR;
        float2 y = data[t];
        float g0 = short_conv(zg, t, L, w0, w1, w2, b), g1 = short_conv(zg + 4096, t, L, w0, w1, w2, b);
        vreg[m] = make_float2(g0 * (y.x + sk * vreg[m].x), g1 * (y.y + sk * vreg[m].y));
      }
    }
    __syncthreads();
  }
  bfu* YAT = (bfu*)(P.ws + OFF_YAT);
#pragma unroll
  for (int m = 0; m < 8; ++m) {
    int t = tid + m * NTHR;
    YAT[(size_t)c * TT + 4096 + t] = f2bf(vreg[m].x);
    YAT[(size_t)c * TT + 8192 + t] = f2bf(vreg[m].y);
  }
}

typedef __attribute__((ext_vector_type(4))) float f32x4_t;
__device__ __forceinline__ void hyena_prompt_item(const Params& P, int l, int c, char* lds) {
  float* V = (float*)lds;
  float* KF = V + 4096;
  bfu* Ub = (bfu*)(KF + 1024);
  bfu* Rc = Ub + 16 * 264;
  __shared__ float red[8];
  const int tid = tidx(), lane = tid & 63, w = tid >> 6;
  const int L = 256;
  const float* FP = (const float*)(P.ws + OFF_FP);
  const float* ZAT = (const float*)(P.ws + OFF_ZAT);
  const float* cw = P.in[I_HCW] + l * 3 * 768;
  const float* cb = P.in[I_HCB] + l * 768;
#pragma unroll
  for (int o = 0; o < 2; ++o) {
    const float* hf = FP + (size_t)((o * 2 + 0) * 256 + c) * L;
    const float* hb = FP + (size_t)((o * 2 + 1) * 256 + c) * L;
    int d = tid - 255;
    float v = (tid == 511) ? 0.f : (d >= 0 ? hf[d] : hb[-d]);
    float nrm = block_sum(fabsf(v), red);
    KF[o * 512 + tid] = v / nrm;
  }
  const int seq = tid >> 5, t0 = (tid & 31) * 8;
  {
    const float w0 = cw[c], w1 = cw[768 + c], w2 = cw[1536 + c], b = cb[c];
    const float* z0 = ZAT + (size_t)c * TT + seq * 256;
    float vr[8];
#pragma unroll
    for (int i = 0; i < 8; ++i) { vr[i] = short_conv(z0, t0 + i, L, w0, w1, w2, b); V[seq * 256 + t0 + i] = vr[i]; }
    uint4 o4; o4.x = pack2(vr[0], vr[1]); o4.y = pack2(vr[2], vr[3]); o4.z = pack2(vr[4], vr[5]); o4.w = pack2(vr[6], vr[7]);
    *(uint4*)(Ub + seq * 264 + t0) = o4;
  }
  __syncthreads();
  for (int i = tid; i < 2 * 8 * 528; i += NTHR) {
    const int o = i / (8 * 528), rem = i % (8 * 528), cc = rem / 528, x = rem % 528;
    const int y = 510 - x - cc;
    Rc[i] = (y >= 0 && y <= 510) ? f2bf(KF[o * 512 + y]) : (bfu)0;
  }
  __syncthreads();
  const int r = lane & 15, hq = lane >> 4;
  const int cc = 7 - (r & 7);
  bfu* YC = (bfu*)(P.ws + OFF_YCAT);
#pragma unroll
  for (int o = 0; o < 2; ++o) {
    f32x4_t acc[2];
#pragma unroll
    for (int i = 0; i < 2; ++i) {
      const int tb = w * 2 + i;
      acc[i] = (f32x4_t){0.f, 0.f, 0.f, 0.f};
      const int t = tb * 16 + r;
#pragma unroll
      for (int sb = 0; sb < 8; ++sb) {
        const int sbase = sb * 32 + 8 * hq;
        const int q = 255 - t + sbase;
        const bf16x8 af = *(const bf16x8*)(Rc + (o * 8 + cc) * 528 + (q - cc));
        const bf16x8 bf = *(const bf16x8*)(Ub + r * 264 + sbase);
        acc[i] = __builtin_amdgcn_mfma_f32_16x16x32_bf16(af, bf, acc[i], 0, 0, 0);
      }
    }
    const int gc = (o + 1) * 256 + c;
    const float w0 = cw[gc], w1 = cw[768 + gc], w2 = cw[1536 + gc], b = cb[gc];
    const float* zg = ZAT + (size_t)gc * TT + r * 256;
    const float sk = P.in[I_HSKIP][(l * 2 + o) * 256 + c];
    float zn[2][4];
#pragma unroll
    for (int i = 0; i < 2; ++i) {
      const int tq = (w * 2 + i) * 16 + 4 * hq;
#pragma unroll
      for (int e = 0; e < 4; ++e) {
        const float g = short_conv(zg, tq + e, L, w0, w1, w2, b);
        zn[i][e] = g * (acc[i][e] + sk * V[r * 256 + tq + e]);
      }
    }
    __syncthreads();
    if (o == 0) {
#pragma unroll
      for (int i = 0; i < 2; ++i) {
        const int tq = (w * 2 + i) * 16 + 4 * hq;
        *(float4*)(V + r * 256 + tq) = make_float4(zn[i][0], zn[i][1], zn[i][2], zn[i][3]);
        uint2 o2; o2.x = pack2(zn[i][0], zn[i][1]); o2.y = pack2(zn[i][2], zn[i][3]);
        *(uint2*)(Ub + r * 264 + tq) = o2;
      }
      __syncthreads();
    } else {
#pragma unroll
      for (int i = 0; i < 2; ++i) {
        const int tq = (w * 2 + i) * 16 + 4 * hq;
        { uint2 o2; o2.x = pack2(zn[i][0], zn[i][1]); o2.y = pack2(zn[i][2], zn[i][3]); *(uint2*)((bfu*)(P.ws + OFF_YAT) + (size_t)c * TT + r * 256 + tq) = o2; }
      }
    }
  }
}

__device__ __forceinline__ void attn_item(const Params& P, int l, int seq, int g, int qb, char* lds) {
  char* Kl = lds;
  char* Vt = lds + 8192;
  const int tid = tidx(), lane = tid & 63, w = tid >> 6;
  const bool isS = seq >= 16;
  const int b = isS ? seq - 16 : seq;
  const int L = isS ? 4096 : 256;
  const int tok0 = isS ? 4096 + b * 4096 : b * 256;
  const int q0 = qb * 64;
  const int rr = w >> 1, qs = w & 1, ql = lane & 31, h = lane >> 5;
  const int tq = q0 + qs * 32 + ql;
  const int head = g * 4 + rr;
  const float2* RT = (const float2*)(P.ws + OFF_RT);
  bf16x8 qf[4];
  {
    const float* qp = (const float*)(P.ws + OFF_Q) + (size_t)(tok0 + tq) * 512 + head * 64 + 8 * h;
    float qv[4][8];
#pragma unroll
    for (int s = 0; s < 4; ++s) {
      float4 a = *(const float4*)(qp + 16 * s), bq = *(const float4*)(qp + 16 * s + 4);
      qv[s][0] = a.x; qv[s][1] = a.y; qv[s][2] = a.z; qv[s][3] = a.w; qv[s][4] = bq.x; qv[s][5] = bq.y; qv[s][6] = bq.z; qv[s][7] = bq.w;
    }
    if (isS) {
#pragma unroll
      for (int hp = 0; hp < 2; ++hp) {
        const int pos = hp == 0 ? (tq >> 6) : (tq & 63);
#pragma unroll
        for (int j = 0; j < 8; ++j) {
          float2 cs = RT[pos * 16 + 8 * h + j];
          float x1 = qv[2 * hp][j], x2 = qv[2 * hp + 1][j];
          qv[2 * hp][j] = x1 * cs.x - x2 * cs.y;
          qv[2 * hp + 1][j] = x1 * cs.y + x2 * cs.x;
        }
      }
    }
#pragma unroll
    for (int s = 0; s < 4; ++s) {
      union { bf16x8 v; unsigned u[4]; } cv;
#pragma unroll
      for (int j = 0; j < 4; ++j) cv.u[j] = pack2(qv[s][2 * j] * 0.125f, qv[s][2 * j + 1] * 0.125f);
      qf[s] = cv.v;
    }
  }
  float mrun = P.in[I_SINK][l * 8 + head];
  float lsum = h == 0 ? 1.f : 0.f;
  f32x16 oacc[2];
#pragma unroll
  for (int dt = 0; dt < 2; ++dt)
#pragma unroll
    for (int i = 0; i < 16; ++i) oacc[dt][i] = 0.f;

  const int ntile = isS ? 13 : 4;
  const int lk = tid & 63, lc = tid >> 6;
  for (int ti = 0; ti < ntile; ++ti) {
    int kstart = 0; bool win = false;
    const float* kbase; const float* vbase;
    if (!isS) {
      kstart = ti * 64;
      kbase = P.out + OUT_K + ((size_t)(b * 4 + l) * 256 + kstart) * 128 + g * 64;
      vbase = P.out + OUT_V + ((size_t)(b * 4 + l) * 256 + kstart) * 128 + g * 64;
    } else if (ti < 8) {
      kstart = ti * 64;
      kbase = P.in[I_CK] + ((size_t)(b * 4 + l) * 512 + kstart) * 128 + g * 64;
      vbase = P.in[I_CV] + ((size_t)(b * 4 + l) * 512 + kstart) * 128 + g * 64;
    } else {
      kstart = q0 - 128 + (ti - 8) * 64; win = true;
      if (kstart < 0 || kstart >= L) continue;
      kbase = (const float*)(P.ws + OFF_KS) + ((size_t)b * 4096 + kstart) * 128 + g * 64;
      vbase = (const float*)(P.ws + OFF_VS) + ((size_t)b * 4096 + kstart) * 128 + g * 64;
    }
    __syncthreads();
    {
      const float* kp = kbase + (size_t)lk * 128 + lc * 8;
      float4 a = *(const float4*)kp, bq = *(const float4*)(kp + 4);
      float kv[8] = {a.x, a.y, a.z, a.w, bq.x, bq.y, bq.z, bq.w};
      if (win) {
        const float* pp = kbase + (size_t)lk * 128 + (lc ^ 2) * 8;
        float4 pa = *(const float4*)pp, pb = *(const float4*)(pp + 4);
        float pv[8] = {pa.x, pa.y, pa.z, pa.w, pb.x, pb.y, pb.z, pb.w};
        const int kpos = kstart + lk;
        const int pos = lc < 4 ? (kpos >> 6) : (kpos & 63);
#pragma unroll
        for (int j = 0; j < 8; ++j) {
          float2 cs = RT[pos * 16 + (lc & 1) * 8 + j];
          kv[j] = (lc & 2) ? (pv[j] * cs.y + kv[j] * cs.x) : (kv[j] * cs.x - pv[j] * cs.y);
        }
      }
      uint4 o; o.x = pack2(kv[0], kv[1]); o.y = pack2(kv[2], kv[3]); o.z = pack2(kv[4], kv[5]); o.w = pack2(kv[6], kv[7]);
      *(uint4*)(Kl + lk * 128 + ((lc ^ ((lk >> 1) & 7)) << 4)) = o;
      const float* vp = vbase + (size_t)lk * 128 + lc * 8;
      float4 va = *(const float4*)vp, vb = *(const float4*)(vp + 4);
      float vv[8] = {va.x, va.y, va.z, va.w, vb.x, vb.y, vb.z, vb.w};
#pragma unroll
      for (int j = 0; j < 8; ++j) *(bfu*)(Vt + (lc * 8 + j) * 136 + lk * 2) = f2bf(vv[j]);
    }
    __syncthreads();
    f32x16 st[2];
#pragma unroll
    for (int k2 = 0; k2 < 2; ++k2) {
#pragma unroll
      for (int i = 0; i < 16; ++i) st[k2][i] = 0.f;
      const int row = k2 * 32 + ql;
#pragma unroll
      for (int s = 0; s < 4; ++s) {
        bf16x8 a = *(const bf16x8*)(Kl + row * 128 + (((2 * s + h) ^ ((row >> 1) & 7)) << 4));
        st[k2] = __builtin_amdgcn_mfma_f32_32x32x16_bf16(a, qf[s], st[k2], 0, 0, 0);
      }
    }
    if (win) {
#pragma unroll
      for (int k2 = 0; k2 < 2; ++k2)
#pragma unroll
        for (int i = 0; i < 16; ++i) {
          int kpos = kstart + k2 * 32 + (i & 3) + 8 * (i >> 2) + 4 * h;
          int dd = tq - kpos;
          if (dd > 128 || dd < -128) st[k2][i] = -1e30f;
        }
    }
    float mx = -1e30f;
#pragma unroll
    for (int k2 = 0; k2 < 2; ++k2)
#pragma unroll
      for (int i = 0; i < 16; ++i) mx = fmaxf(mx, st[k2][i]);
    mx = fmaxf(mx, __shfl_xor(mx, 32));
    const float mnew = fmaxf(mrun, mx);
    const float alpha = __expf(mrun - mnew);
    mrun = mnew;
    float ps = 0.f;
    bf16x8 pf[2][2];
#pragma unroll
    for (int k2 = 0; k2 < 2; ++k2) {
      float pv[16];
#pragma unroll
      for (int i = 0; i < 16; ++i) { pv[i] = __expf(st[k2][i] - mnew); ps += pv[i]; }
#pragma unroll
      for (int s2 = 0; s2 < 2; ++s2) {
        union { bf16x8 v; unsigned u[4]; } cv;
#pragma unroll
        for (int j = 0; j < 4; ++j) cv.u[j] = pack2(pv[8 * s2 + 2 * j], pv[8 * s2 + 2 * j + 1]);
        pf[k2][s2] = cv.v;
      }
    }
    lsum = lsum * alpha + ps;
#pragma unroll
    for (int dt = 0; dt < 2; ++dt) {
#pragma unroll
      for (int i = 0; i < 16; ++i) oacc[dt][i] *= alpha;
      const char* vrow = Vt + (dt * 32 + ql) * 136;
#pragma unroll
      for (int k2 = 0; k2 < 2; ++k2)
#pragma unroll
        for (int s2 = 0; s2 < 2; ++s2) {
          const int kb = k2 * 32 + 16 * s2 + 4 * h;
          union { bf16x8 v; uint2 u[2]; } av;
          av.u[0] = *(const uint2*)(vrow + kb * 2);
          av.u[1] = *(const uint2*)(vrow + (kb + 8) * 2);
          oacc[dt] = __builtin_amdgcn_mfma_f32_32x32x16_bf16(av.v, pf[k2][s2], oacc[dt], 0, 0, 0);
        }
    }
  }
  const float ltot = lsum + __shfl_xor(lsum, 32);
  const float inv = 1.f / ltot;
  __syncthreads();
  bfu* St = (bfu*)lds + w * (32 * 72);
#pragma unroll
  for (int dt = 0; dt < 2; ++dt)
#pragma unroll
    for (int q4 = 0; q4 < 4; ++q4) {
      uint2 o; o.x = pack2(oacc[dt][4 * q4] * inv, oacc[dt][4 * q4 + 1] * inv); o.y = pack2(oacc[dt][4 * q4 + 2] * inv, oacc[dt][4 * q4 + 3] * inv);
      *(uint2*)(St + ql * 72 + dt * 32 + 8 * q4 + 4 * h) = o;
    }
  __builtin_amdgcn_fence(__ATOMIC_ACQ_REL, "workgroup");
  __builtin_amdgcn_wave_barrier();
  {
    const int ck = lane & 7;
    bfu* ybase = (bfu*)(P.ws + OFF_YCAT) + (size_t)(tok0 + q0 + qs * 32) * 1024 + 512 + head * 64 + ck * 8;
#pragma unroll
    for (int ps = 0; ps < 4; ++ps) {
      const int rr = (lane >> 3) + 8 * ps;
      const uint4 v = *(const uint4*)(St + rr * 72 + ck * 8);
      *(uint4*)(ybase + (size_t)rr * 1024) = v;
    }
  }
  __syncthreads();
}

__device__ __forceinline__ void s5_chunk_info(int ci, bool& isS, int& b, int& ch, int& nch, int& tokbase) {
  isS = ci >= 128;
  if (isS) { b = (ci - 128) >> 7; ch = (ci - 128) & 127; nch = 128; tokbase = 4096 + b * 4096 + ch * 32; }
  else { b = ci >> 3; ch = ci & 7; nch = 8; tokbase = b * 256 + ch * 32; }
}

__device__ __forceinline__ void s5a_item(const Params& P, int l, int ci, char* lds) {
  float* U = (float*)lds;
  bool isS; int b, ch, nch, tokbase; s5_chunk_info(ci, isS, b, ch, nch, tokbase);
  const int tid = tidx(), lane = tid & 63, w = tid >> 6;
  __syncthreads();
  {
    const float4* src = (const float4*)((const float*)(P.ws + OFF_ZB) + (size_t)tokbase * 256);
    for (int i = tid; i < 2048; i += NTHR) ((float4*)U)[i] = src[i];
  }
  __syncthreads();
  const float2* lamb = (const float2*)(P.ws + OFF_LAMB);
  const float2* bbar = (const float2*)(P.ws + OFF_BBAR);
  float2* SE = (float2*)(P.ws + OFF_SE);
#pragma unroll 2
  for (int cb = 0; cb < 4; ++cb) {
    const int g = w * 2 + (cb >> 1), d = cb & 1;
    const int sidx = (d * 16 + g) * 64 + lane;
    float2 Bv[16];
#pragma unroll
    for (int c4 = 0; c4 < 8; ++c4) { float4 t = *(const float4*)(bbar + sidx * 16 + c4 * 2); Bv[2 * c4] = make_float2(t.x, t.y); Bv[2 * c4 + 1] = make_float2(t.z, t.w); }
    const float2 lam = lamb[sidx];
    float2 hs = make_float2(0.f, 0.f);
#pragma unroll 2
    for (int i = 0; i < 32; ++i) {
      const int t = d ? 31 - i : i;
      const float* u = U + t * 256 + g * 16;
      float2 bu = make_float2(0.f, 0.f);
#pragma unroll
      for (int c4 = 0; c4 < 4; ++c4) {
        float4 uv = *(const float4*)(u + 4 * c4);
        bu.x += Bv[4 * c4].x * uv.x + Bv[4 * c4 + 1].x * uv.y + Bv[4 * c4 + 2].x * uv.z + Bv[4 * c4 + 3].x * uv.w;
        bu.y += Bv[4 * c4].y * uv.x + Bv[4 * c4 + 1].y * uv.y + Bv[4 * c4 + 2].y * uv.z + Bv[4 * c4 + 3].y * uv.w;
      }
      float2 t2 = cmul(lam, hs);
      hs = make_float2(t2.x + bu.x, t2.y + bu.y);
    }
    SE[((size_t)ci * 32 + g * 2 + d) * 64 + lane] = hs;
  }
}

__device__ __forceinline__ void s5b_item(const Params& P, int l, int ci2, char* lds) {
  float* U = (float*)lds;
  const int ci = ci2 >> 1, gh = ci2 & 1;
  bool isS; int b, ch, nch, tokbase; s5_chunk_info(ci, isS, b, ch, nch, tokbase);
  const int tid = tidx(), lane = tid & 63, w = tid >> 6;
  float2* Hb = (float2*)(lds + 32768) + w * 1024;
  __syncthreads();
  {
    const float4* src = (const float4*)((const float*)(P.ws + OFF_ZB) + (size_t)tokbase * 256);
    for (int i = tid; i < 1024; i += NTHR) { const int idx = (i >> 5) * 64 + gh * 32 + (i & 31); ((float4*)U)[idx] = src[idx]; }
  }
  __syncthreads();
  const float2* lamb = (const float2*)(P.ws + OFF_LAMB);
  const float2* bbar = (const float2*)(P.ws + OFF_BBAR);
  const float2* SE = (const float2*)(P.ws + OFF_SE);
  const int cbase = ci - ch;
  const int yc = lane & 15, ytq = lane >> 4;
  bfu* YS = (bfu*)(P.ws + OFF_YS5);
#pragma unroll 1
  for (int gi = 0; gi < 1; ++gi) {
    const int g = gh * 8 + w;
    float yacc[2][4];
#pragma unroll
    for (int a = 0; a < 2; ++a)
#pragma unroll
      for (int k = 0; k < 4; ++k) yacc[a][k] = 0.f;
#pragma unroll
    for (int d = 0; d < 2; ++d) {
      const int sidx = (d * 16 + g) * 64 + lane;
      float2 Bv[16];
#pragma unroll
      for (int c4 = 0; c4 < 8; ++c4) { float4 t = *(const float4*)(bbar + sidx * 16 + c4 * 2); Bv[2 * c4] = make_float2(t.x, t.y); Bv[2 * c4 + 1] = make_float2(t.z, t.w); }
      const float2 lam = lamb[sidx];
      float2 hs = ((const float2*)(P.ws + OFF_CAR))[((size_t)ci * 32 + g * 2 + d) * 64 + lane];
      const float* cre = P.in[I_CRE] + ((size_t)((l * 2 + d) * 16 + g) * 16 + yc) * 64;
      const float* cim = P.in[I_CIM] + ((size_t)((l * 2 + d) * 16 + g) * 16 + yc) * 64;
#pragma unroll
      for (int sc = 0; sc < 2; ++sc) {
#pragma unroll 1
        for (int ii = 0; ii < 16; ++ii) {
          const int i = sc * 16 + ii;
          const int t = d ? 31 - i : i;
          const float* u = U + t * 256 + g * 16;
          float2 bu = make_float2(0.f, 0.f);
#pragma unroll
          for (int c4 = 0; c4 < 4; ++c4) {
            float4 uv = *(const float4*)(u + 4 * c4);
            bu.x += Bv[4 * c4].x * uv.x + Bv[4 * c4 + 1].x * uv.y + Bv[4 * c4 + 2].x * uv.z + Bv[4 * c4 + 3].x * uv.w;
            bu.y += Bv[4 * c4].y * uv.x + Bv[4 * c4 + 1].y * uv.y + Bv[4 * c4 + 2].y * uv.z + Bv[4 * c4 + 3].y * uv.w;
          }
          float2 t2 = cmul(lam, hs);
          hs = make_float2(t2.x + bu.x, t2.y + bu.y);
          ((float*)Hb)[ii * 64 + lane] = hs.x; ((float*)Hb)[1024 + ii * 64 + lane] = hs.y;
        }
        __builtin_amdgcn_fence(__ATOMIC_ACQ_REL, "workgroup");
        __builtin_amdgcn_wave_barrier();
        const int sc2 = d ? 1 - sc : sc;
#pragma unroll 4
        for (int pc = 0; pc < 8; ++pc) {
          const v4f ca = *(const v4f*)(cre + pc * 8), cb2 = *(const v4f*)(cre + pc * 8 + 4);
          const v4f ma = *(const v4f*)(cim + pc * 8), mb = *(const v4f*)(cim + pc * 8 + 4);
#pragma unroll
          for (int k = 0; k < 4; ++k) {
            const int tl = ytq * 4 + k;
            const int rowi = d ? 15 - tl : tl;
            const float* hre = (const float*)Hb + rowi * 64 + pc * 8;
            const v4f r0 = *(const v4f*)hre, r1 = *(const v4f*)(hre + 4), i0 = *(const v4f*)(hre + 1024), i1 = *(const v4f*)(hre + 1028);
            v2f ac = ca.xy * r0.xy;
            ac += ca.zw * r0.zw; ac += cb2.xy * r1.xy; ac += cb2.zw * r1.zw;
            ac -= ma.xy * i0.xy; ac -= ma.zw * i0.zw; ac -= mb.xy * i1.xy; ac -= mb.zw * i1.zw;
            yacc[sc2][k] += ac.x + ac.y;
          }
        }
        __builtin_amdgcn_fence(__ATOMIC_ACQ_REL, "workgroup");
        __builtin_amdgcn_wave_barrier();
      }
      if (!isS && ((d == 0 && ch == nch - 1) || (d == 1 && ch == 0))) {
        const int oidx = (((b * 4 + l) * 2 + d) * 16 + g) * 64 + lane;
        P.out[OUT_SRE + oidx] = hs.x; P.out[OUT_SIM + oidx] = hs.y;
      }
    }
    const float sk = P.in[I_S5SKIP][l * 256 + g * 16 + yc];
#pragma unroll
    for (int a = 0; a < 2; ++a)
#pragma unroll
      for (int k = 0; k < 4; ++k) {
        const int t = a * 16 + ytq * 4 + k;
        float y = yacc[a][k] + U[t * 256 + g * 16 + yc] * sk;
        YS[(size_t)(tokbase + t) * 256 + g * 16 + yc] = f2bf(y);
      }
  }
}

__device__ __forceinline__ void s5c_phase(const Params& P, int l, char* lds) {
  const int tid = tidx(), lane = tid & 63, w = tid >> 6;
  const float2* lamb = (const float2*)(P.ws + OFF_LAMB);
  const float2* SE = (const float2*)(P.ws + OFF_SE);
  float2* CAR = (float2*)(P.ws + OFF_CAR);
  float2* TL = (float2*)lds;
  for (int it = bidx(); it < 64; it += gdim()) {
    const int b = it >> 5, gd = it & 31, g = gd >> 1, d = gd & 1;
    const int cbase = 128 + b * 128;
    float2 lam32 = lamb[(d * 16 + g) * 64 + lane];
#pragma unroll
    for (int i = 0; i < 5; ++i) lam32 = cmul(lam32, lam32);
    float2 lam512 = lam32;
#pragma unroll
    for (int i = 0; i < 4; ++i) lam512 = cmul(lam512, lam512);
    float2 ev[16], loc[16];
#pragma unroll
    for (int t = 0; t < 16; ++t) {
      const int jj = w * 16 + t, j = d ? 127 - jj : jj;
      ev[t] = SE[((size_t)(cbase + j) * 32 + gd) * 64 + lane];
    }
    float2 run = make_float2(0.f, 0.f);
#pragma unroll
    for (int t = 0; t < 16; ++t) { loc[t] = run; const float2 t2 = cmul(lam32, run); run = make_float2(t2.x + ev[t].x, t2.y + ev[t].y); }
    __syncthreads();
    TL[w * 64 + lane] = run;
    __syncthreads();
    const int hidx = (((b * 4 + l) * 2 + d) * 16 + g) * 64 + lane;
    float2 st = make_float2(P.in[I_SRE][hidx], P.in[I_SIM][hidx]);
    for (int ww = 0; ww < w; ++ww) { const float2 t2 = cmul(lam512, st); const float2 tt = TL[ww * 64 + lane]; st = make_float2(t2.x + tt.x, t2.y + tt.y); }
#pragma unroll
    for (int t = 0; t < 16; ++t) {
      const int jj = w * 16 + t, j = d ? 127 - jj : jj;
      CAR[((size_t)(cbase + j) * 32 + gd) * 64 + lane] = make_float2(loc[t].x + st.x, loc[t].y + st.y);
      st = cmul(lam32, st);
    }
  }
  const int nb = gdim() > 64 ? gdim() - 64 : gdim(), b0 = gdim() > 64 ? bidx() - 64 : bidx();
  if (b0 >= 0)
  for (int wi = b0 * 8 + w; wi < 16 * 32; wi += nb * 8) {
    const int seq = wi >> 5, gd = wi & 31, g = gd >> 1, d = gd & 1;
    const int cbase = seq * 8;
    float2 lam32 = lamb[(d * 16 + g) * 64 + lane];
#pragma unroll
    for (int i = 0; i < 5; ++i) lam32 = cmul(lam32, lam32);
    float2 hs = make_float2(0.f, 0.f);
#pragma unroll
    for (int jj = 0; jj < 8; ++jj) {
      const int j = d ? 7 - jj : jj;
      const size_t idx = ((size_t)(cbase + j) * 32 + gd) * 64 + lane;
      CAR[idx] = hs;
      float2 e = SE[idx];
      float2 t2 = cmul(lam32, hs);
      hs = make_float2(t2.x + e.x, t2.y + e.y);
    }
  }
}

__device__ __forceinline__ void ya_transpose_items(const Params& P, char* lds) {
  const int tid = tidx();
  const bfu* YAT = (const bfu*)(P.ws + OFF_YAT);
  bfu* YC = (bfu*)(P.ws + OFF_YCAT);
  bfu* tl = (bfu*)lds;
  for (int it = bidx(); it < TT / 64; it += gdim()) {
    const int tok0 = it * 64;
    __syncthreads();
    {
      const int ch = tid >> 1, hf = tid & 1;
      const uint4* src = (const uint4*)(YAT + (size_t)ch * TT + tok0 + hf * 32);
#pragma unroll
      for (int q = 0; q < 4; ++q) {
        const uint4 v = src[q];
        const unsigned ww[4] = {v.x, v.y, v.z, v.w};
#pragma unroll
        for (int j = 0; j < 4; ++j) {
          const int tk = hf * 32 + q * 8 + 2 * j;
          tl[tk * 264 + ch] = (bfu)(ww[j] & 0xffffu);
          tl[(tk + 1) * 264 + ch] = (bfu)(ww[j] >> 16);
        }
      }
    }
    __syncthreads();
    {
      const int tk = tid >> 3, c0 = (tid & 7) * 32;
      const uint4* src = (const uint4*)(tl + tk * 264 + c0);
      uint4* dst = (uint4*)(YC + (size_t)(tok0 + tk) * 1024 + c0);
#pragma unroll
      for (int q = 0; q < 4; ++q) dst[q] = src[q];
    }
  }
  __syncthreads();
}

#define XB_TMO      128
#define XB_XCNT(j)  (256  + 64 * (j))
#define XB_XSUB(j)  (1280 + 64 * (j))
#define XB_XGEN(j)  (2304 + 64 * (j))
#define XB_TOP      3328
#define XB_TOPGEN   3392
#define XCD_BAR_WORDS 3456
#define XB_SPIN_CAP (1u << 18)
#define LAS __attribute__((address_space(3)))

__device__ __forceinline__ unsigned xb_ld(unsigned* p)              { return __hip_atomic_load(p, __ATOMIC_RELAXED, __HIP_MEMORY_SCOPE_AGENT); }
__device__ __forceinline__ unsigned xb_add(unsigned* p, unsigned v) { return __hip_atomic_fetch_add(p, v, __ATOMIC_RELAXED, __HIP_MEMORY_SCOPE_AGENT); }
__device__ __forceinline__ unsigned xb_xcc_id() { return (unsigned)__builtin_amdgcn_s_getreg((3 << 11) | 20) & 0xFu; }
#define XB_SPIN(cond, bar) do { unsigned _sp = 0; while (cond) { __builtin_amdgcn_s_sleep(1); \
    if ((++_sp & 255u) == 0u) { if (xb_ld(&(bar)[XB_TMO])) break; if (_sp > XB_SPIN_CAP) { atomicAdd(&(bar)[XB_TMO], 1u); break; } } } } while (0)

struct XcdBarrier {
    unsigned* bar; unsigned x;
    volatile LAS unsigned* st;
};

__device__ __forceinline__ XcdBarrier xcd_barrier_post(unsigned* bar, volatile LAS unsigned* st) {
    XcdBarrier b; b.bar = bar; b.x = xb_xcc_id(); b.st = st;
    if (tidx() == 0) (void)xb_add(&bar[XB_XCNT(b.x)], 1u);
    return b;
}
__device__ __forceinline__ void xcd_barrier_complete(unsigned* bar, unsigned x, unsigned& nloc, unsigned& nx) {
    const unsigned G = gdim() * gridDim.y * gridDim.z;
    unsigned sum, cnt, mine, sp = 0u;
    for (;;) {
        sum = 0u; cnt = 0u; mine = 0u;
#pragma unroll
        for (unsigned j = 0; j < 16; ++j) { const unsigned c = xb_ld(&bar[XB_XCNT(j)]); sum += c; cnt += (c > 0u) ? 1u : 0u; mine = (j == x) ? c : mine; }
        if (sum == G) break;
        __builtin_amdgcn_s_sleep(1);
        if ((++sp & 255u) == 0u) { if (xb_ld(&bar[XB_TMO])) break; if (sp > XB_SPIN_CAP) { atomicAdd(&bar[XB_TMO], 1u); break; } }
    }
    nloc = mine > 0u ? mine : 1u; nx = cnt > 0u ? cnt : 1u;
}

__device__ __forceinline__ void xcd_barrier(const XcdBarrier& b) {
    asm volatile("s_waitcnt vmcnt(0)" ::: "memory");
    __syncthreads();
    if (tidx() == 0) {
        unsigned* bar = b.bar;
        __builtin_amdgcn_s_waitcnt(0);
        unsigned nloc = b.st[0], nx = b.st[1];
        if (nloc == 0u) { xcd_barrier_complete(bar, b.x, nloc, nx); b.st[0] = nloc; b.st[1] = nx; }
        const unsigned old = xb_add(&bar[XB_XSUB(b.x)], 1u);
        const unsigned gen = old / nloc;
        if (old + 1u == (gen + 1u) * nloc) {
            __builtin_amdgcn_fence(__ATOMIC_RELEASE, "agent");
            asm volatile("s_waitcnt vmcnt(0)" ::: "memory");
            const unsigned og = xb_add(&bar[XB_TOP], 1u);
            const unsigned tg = og / nx;
            if (og + 1u == (tg + 1u) * nx) xb_add(&bar[XB_TOPGEN], 1u);
            else XB_SPIN(xb_ld(&bar[XB_TOPGEN]) == tg, bar);
            __builtin_amdgcn_fence(__ATOMIC_ACQUIRE, "agent");
            xb_add(&bar[XB_XGEN(b.x)], 1u);
            asm volatile("s_waitcnt vmcnt(0)" ::: "memory");
        } else {
            XB_SPIN(xb_ld(&bar[XB_XGEN(b.x)]) == gen, bar);
            __builtin_amdgcn_fence(__ATOMIC_ACQUIRE, "agent");
            asm volatile("s_waitcnt vmcnt(0)" ::: "memory");
        }
    }
    __syncthreads();
}


constexpr int NSP = 11;
#ifdef REP_SP
constexpr int NSPX = NSP + REP_N;
#else
constexpr int NSPX = NSP;
#endif
constexpr int N_PHASES = 1 + 4 * NSPX + 1;

__device__ __forceinline__ void prep_items(const Params& P, int l, int extra_first, char* lds) {
  const int nf = 136;
  if (bidx() == gdim() - 1) s5pre_item(P, l);
  if ((int)gdim() >= nf + 64) {
    if ((int)bidx() < nf) filt_item(P, l, bidx(), lds);
    else conv_stream(P, l, bidx() - nf, gdim() - nf, lds);
  } else {
    for (int it = bidx(); it < nf; it += gdim()) filt_item(P, l, it, lds);
    conv_stream(P, l, bidx(), gdim(), lds);
  }
}

__device__ __forceinline__ void mix1_phase(const Params& P, int l, char* lds) {
  const int total = 256 + 384 + 128;
  for (int it = bidx(); it < total; it += gdim()) {
    int i = it;
    if (i < 256) { hyena_sample_item(P, l, i, lds); continue; }
    i -= 256;
    if (i < 384) { s5a_item(P, l, i, lds); continue; }
    i -= 384;
    attn_item(P, l, i >> 3, (i >> 2) & 1, i & 3, lds);
  }
}
__device__ __forceinline__ void mix2_phase(const Params& P, int l, char* lds) {
  s5c_phase(P, l, lds);
  for (int i = bidx(); i < 256; i += gdim()) attn_item(P, l, 16 + (i >> 7), (i >> 6) & 1, i & 63, lds);
}
__device__ __forceinline__ void mix3_phase(const Params& P, int l, char* lds) {
  const int total = 768 + 256;
  for (int it = bidx(); it < total; it += gdim()) {
    if (it < 768) s5b_item(P, l, it, lds);
    else hyena_prompt_item(P, l, it - 768, lds);
  }
}

__device__ __forceinline__ void run_phase(const Params& P, int ph, char* lds) {
  if (ph == N_PHASES - 1) { final_phase(P); return; }
  if (ph == 0) {
    for (int it = bidx(); it < 385; it += gdim()) { if (it < 384) ada_item(P, it, lds); else tables_item(P); }
    __syncthreads();
  }
  const int l = ph == 0 ? 0 : (ph - 1) / NSPX;
  int sp = ph == 0 ? -1 : (ph - 1) % NSPX;
#ifdef REP_SP
  if (sp > REP_SP) sp = (sp <= REP_SP + REP_N) ? REP_SP : sp - REP_N;
#endif
  if (ph == 0 || (sp == 0 && l > 0)) prep_items(P, l, 0, lds);
  int gmode = -1;
  switch (sp) {
    case 0: norm_phase(P, l, 0); break;
    case 1: gmode = 0; break;
    case 2: mix1_phase(P, l, lds); break;
    case 3: mix2_phase(P, l, lds); break;
    case 4: mix3_phase(P, l, lds); break;
    case 5: glu_phase(P, l, lds); ya_transpose_items(P, lds); break;
    case 6: proj_phase(P, l, lds); break;
    case 7: gmode = 2; break;
    case 8: norm_phase(P, l, 1); break;
    case 9: gmode = 1; break;
    case 10: gmode = 3; break;
    default: break;
  }
  if (gmode >= 0) big_gemm_phase(P, l, gmode, lds);
}

__global__ void __launch_bounds__(NTHR) mk(Params P, int lo, int hi) {
  extern __shared__ __attribute__((aligned(16))) char lds[];
  __shared__ uint4 xb_words;
  cg::grid_group grid = cg::this_grid();
  if (tidx() == 0) xb_words = make_uint4(0u, 0u, 0u, 0u);
  __syncthreads();
  XcdBarrier xb = xcd_barrier_post((unsigned*)(P.ws + OFF_BAR), (volatile LAS unsigned*)&xb_words);
  for (int ph = lo; ph < hi; ++ph) {
    run_phase(P, ph, lds);
    if (ph + 1 < hi) {
      if (P.ws == nullptr) grid.sync();
      xcd_barrier(xb);
    }
  }
}

extern "C" void kernel_launch(void* const* d_in, const int* in_sizes, int n_in, void* d_out, int out_size, void* d_ws, size_t ws_size,
                              hipStream_t stream) {
  static int grid_blocks = 0;
  if (!grid_blocks) {
    int dev = 0, cus = 0, per_cu = 0;
    hipGetDevice(&dev);
    hipDeviceGetAttribute(&cus, hipDeviceAttributeMultiprocessorCount, dev);
    hipFuncSetAttribute((const void*)mk, hipFuncAttributeMaxDynamicSharedMemorySize, LDS_BYTES);
    hipOccupancyMaxActiveBlocksPerMultiprocessor(&per_cu, (const void*)mk, NTHR, LDS_BYTES);
    if (per_cu < 1) per_cu = 1;
    grid_blocks = cus * per_cu;
    if (ws_size < WS_END) fprintf(stderr, "kernel_launch: workspace too small: %zu < %zu\n", ws_size, (size_t)WS_END);
  }
  Params p{};
  for (int i = 0; i < 42; ++i) p.in[i] = (const float*)d_in[i];
  p.out = (float*)d_out; p.ws = (char*)d_ws;
  (void)hipMemsetAsync((char*)d_ws + OFF_BAR, 0, 16384, stream);
#if MULTI_LAUNCH
  for (int ph = 0; ph < N_PHASES; ++ph) {
    int lo = ph, hi = ph + 1;
    hipLaunchKernelGGL(mk, dim3(grid_blocks), dim3(NTHR), LDS_BYTES, stream, p, lo, hi);
  }
#else
  int lo = 0, hi = N_PHASES;
  void* args[] = {&p, &lo, &hi};
  hipError_t e = hipLaunchCooperativeKernel((const void*)mk, dim3(grid_blocks), dim3(NTHR), args, LDS_BYTES, stream);
  if (e != hipSuccess) fprintf(stderr, "cooperative launch failed: %s (grid %d)\n", hipGetErrorString(e), grid_blocks);
#endif
}
```

```cpp
#include <hip/hip_runtime.h>
#include <hip/hip_cooperative_groups.h>
#include <cstdio>
namespace cg = cooperative_groups;

#ifndef MULTI_LAUNCH
#define MULTI_LAUNCH 0
#endif

typedef __attribute__((ext_vector_type(8))) short bf16x8;
typedef __attribute__((ext_vector_type(16))) float f32x16;
typedef unsigned short bfu;
typedef float v2f __attribute__((ext_vector_type(2)));
typedef float v4f __attribute__((ext_vector_type(4)));
typedef __attribute__((ext_vector_type(4))) unsigned u32x4;

constexpr int NTHR = 512;
constexpr int TT = 12288;
constexpr int LDS_BYTES = 131072;

enum { I_XP = 0, I_XS, I_CK, I_CV, I_SRE, I_SIM, I_C, I_CCTX, I_ADAW, I_ADAB, I_N1G, I_WIN, I_HCW, I_HCB, I_HW1, I_HB1, I_HW2, I_HB2,
       I_HW3, I_HFREQ, I_HDEC, I_HSKIP, I_LRE, I_LIM, I_LSTEP, I_BRE, I_BIM, I_CRE, I_CIM, I_S5SKIP, I_GLUW, I_GLUB, I_SINK,
       I_PA, I_PB, I_PC, I_WOUT, I_N2G, I_FG, I_FU, I_FD, I_FNG };

constexpr size_t OUT_YP = 0, OUT_YS = 4194304, OUT_K = 12582912, OUT_V = 14680064, OUT_SRE = 16777216, OUT_SIM = 16908288;

constexpr size_t OFF_WIN  = 0;
constexpr size_t OFF_WP   = OFF_WIN + (size_t)4864 * 1024 * 2;
constexpr size_t OFF_WO   = OFF_WP + (size_t)1024 * 1024 * 2;
constexpr size_t OFF_WGU  = OFF_WO + (size_t)1024 * 1024 * 2;
constexpr size_t OFF_WDN  = OFF_WGU + (size_t)5632 * 1024 * 2;
constexpr size_t OFF_WGLU = OFF_WDN + (size_t)1024 * 2816 * 2;
constexpr size_t OFF_X    = OFF_WGLU + (size_t)512 * 256 * 2;
constexpr size_t OFF_AB   = OFF_X + (size_t)TT * 1024 * 4;
constexpr size_t OFF_ZAT  = OFF_AB + (size_t)TT * 1024 * 2;
constexpr size_t OFF_ZB   = OFF_ZAT + (size_t)768 * TT * 4;
constexpr size_t OFF_Q    = OFF_ZB + (size_t)TT * 256 * 4;
constexpr size_t OFF_KS   = OFF_Q + (size_t)TT * 512 * 4;
constexpr size_t OFF_VS   = OFF_KS + (size_t)8192 * 128 * 4;
constexpr size_t OFF_G    = OFF_VS + (size_t)8192 * 128 * 4;
constexpr size_t OFF_YCAT = OFF_G + (size_t)TT * 3072 * 2;
constexpr size_t OFF_YS5  = OFF_YCAT + (size_t)TT * 1024 * 2;
constexpr size_t OFF_FS   = OFF_YS5 + (size_t)TT * 256 * 2;
constexpr size_t OFF_FP   = OFF_FS + (size_t)1024 * 4096 * 4;
constexpr size_t OFF_MOD  = OFF_FP + (size_t)1024 * 256 * 4;
constexpr size_t OFF_TW   = OFF_MOD + (size_t)4 * 3 * 6144 * 4;
constexpr size_t OFF_RT   = OFF_TW + (size_t)4096 * 8;
constexpr size_t OFF_LAMB = OFF_RT + (size_t)64 * 16 * 8;
constexpr size_t OFF_BBAR = OFF_LAMB + (size_t)2048 * 8;
constexpr size_t OFF_SE   = OFF_BBAR + (size_t)2048 * 16 * 8;
constexpr size_t OFF_CAR  = OFF_SE + (size_t)384 * 32 * 64 * 8;
constexpr size_t OFF_XB   = OFF_CAR + (size_t)384 * 32 * 64 * 8;
constexpr size_t OFF_BAR  = OFF_XB + (size_t)TT * 1024 * 4;
constexpr size_t OFF_YAT  = OFF_BAR + 16384;
constexpr size_t WS_END   = OFF_YAT + (size_t)256 * TT * 2;

struct Params { const float* in[42]; float* out; char* ws; };

__device__ __forceinline__ int bidx() { int b = blockIdx.x; asm volatile("" : "+s"(b)); return b; }
__device__ __forceinline__ int gdim() { int g = gridDim.x; asm volatile("" : "+s"(g)); return g; }
__device__ __forceinline__ int tidx() { int t = threadIdx.x; asm volatile("" : "+v"(t)); return t; }
typedef __bf16 bf16v2 __attribute__((ext_vector_type(2)));
__device__ __forceinline__ unsigned pack2(float a, float b) {
  v2f v = {a, b};
  bf16v2 r = __builtin_convertvector(v, bf16v2);
  return __builtin_bit_cast(unsigned, r);
}
__device__ __forceinline__ bfu f2bf(float f) { return (bfu)(pack2(f, 0.f) & 0xffffu); }
__device__ __forceinline__ float bf2f(bfu v) { return __uint_as_float(((unsigned)v) << 16); }
__device__ __forceinline__ float sigm(float x) { return __builtin_amdgcn_rcpf(1.f + __builtin_amdgcn_exp2f(-1.44269504089f * x)); }
__device__ __forceinline__ float2 cmul(float2 a, float2 b) { return make_float2(a.x * b.x - a.y * b.y, a.x * b.y + a.y * b.x); }
__device__ __forceinline__ int cond_of(int row) { return row < 4096 ? 0 : 1 + ((row - 4096) >> 12); }
__device__ __forceinline__ const float* xrow(const Params& P, int l, int row) {
  if (l > 0) return (const float*)(P.ws + OFF_X) + (size_t)row * 1024;
  return row < 4096 ? P.in[I_XP] + (size_t)row * 1024 : P.in[I_XS] + (size_t)(row - 4096) * 1024;
}

template <int N>
__device__ __forceinline__ void g_load(u32x4 (&rg)[N], const bfu* __restrict__ p, int ld) {
#pragma unroll
  for (int i = 0; i < N; ++i) rg[i] = *(const u32x4*)(p + (size_t)(64 * i) * ld);
}
template <int N>
__device__ __forceinline__ void l_store(const u32x4 (&rg)[N], char* base, int lrow, int lc) {
#pragma unroll
  for (int i = 0; i < N; ++i) { int row = lrow + 64 * i; *(u32x4*)(base + row * 128 + ((lc ^ ((row >> 1) & 7)) << 4)) = rg[i]; }
}
template <int MI>
__device__ __forceinline__ void g_compute(const char* sa, const char* sb, f32x16 (&acc)[MI][2], int wm, int wn, int r, int h) {
#pragma unroll
  for (int s = 0; s < 4; ++s) {
    bf16x8 af[MI], bfr[2];
#pragma unroll
    for (int mi = 0; mi < MI; ++mi) { int row = wm * 32 * MI + mi * 32 + r; af[mi] = *(const bf16x8*)(sa + row * 128 + (((2 * s + h) ^ ((row >> 1) & 7)) << 4)); }
#pragma unroll
    for (int ni = 0; ni < 2; ++ni) { int row = wn * 64 + ni * 32 + r; bfr[ni] = *(const bf16x8*)(sb + row * 128 + (((2 * s + h) ^ ((row >> 1) & 7)) << 4)); }
#pragma unroll
    for (int mi = 0; mi < MI; ++mi)
#pragma unroll
      for (int ni = 0; ni < 2; ++ni) acc[mi][ni] = __builtin_amdgcn_mfma_f32_32x32x16_bf16(af[mi], bfr[ni], acc[mi][ni], 0, 0, 0);
  }
}

template <int MI>
__device__ __forceinline__ void gemm_core(const bfu* __restrict__ A, int lda, const bfu* __restrict__ B, int ldb, int K,
                                          f32x16 (&acc)[MI][2], char* lds) {
  constexpr int BM = 128 * MI;
  constexpr int A_BYTES = BM * 128, B_BYTES = 128 * 128, STAGE = A_BYTES + B_BYTES;
  const int tid = tidx(), lane = tid & 63, w = tid >> 6;
  const int wm = w & 3, wn = w >> 2, r = lane & 31, h = lane >> 5;
  const int lrow = tid >> 3, lc = tid & 7;
  u32x4 a0[2 * MI], b0[2], a1[2 * MI], b1[2];
  const int nk = K >> 6;
  const bfu* Ap = A + (size_t)lrow * lda + lc * 8;
  const bfu* Bp = B + (size_t)lrow * ldb + lc * 8;
  g_load(a0, Ap, lda); g_load(b0, Bp, ldb);
  g_load(a1, Ap + 64, lda); g_load(b1, Bp + 64, ldb);
  l_store(a0, lds, lrow, lc); l_store(b0, lds + A_BYTES, lrow, lc);
  if (nk > 2) { g_load(a0, Ap + 128, lda); g_load(b0, Bp + 128, ldb); }
  __syncthreads();
  for (int kt = 0; kt < nk; kt += 2) {
    g_compute<MI>(lds, lds + A_BYTES, acc, wm, wn, r, h);
    l_store(a1, lds + STAGE, lrow, lc); l_store(b1, lds + STAGE + A_BYTES, lrow, lc);
    if (kt + 3 < nk) { g_load(a1, Ap + (kt + 3) * 64, lda); g_load(b1, Bp + (kt + 3) * 64, ldb); }
    __syncthreads();
    g_compute<MI>(lds + STAGE, lds + STAGE + A_BYTES, acc, wm, wn, r, h);
    if (kt + 2 < nk) { l_store(a0, lds, lrow, lc); l_store(b0, lds + A_BYTES, lrow, lc); }
    if (kt + 4 < nk) { g_load(a0, Ap + (kt + 4) * 64, lda); g_load(b0, Bp + (kt + 4) * 64, ldb); }
    __syncthreads();
  }
}

template <int MI>
__device__ __forceinline__ void zero_acc(f32x16 (&acc)[MI][2]) {
#pragma unroll
  for (int mi = 0; mi < MI; ++mi)
#pragma unroll
    for (int ni = 0; ni < 2; ++ni)
#pragma unroll
      for (int i = 0; i < 16; ++i) acc[mi][ni][i] = 0.f;
}

__device__ __forceinline__ int rowmap(int mode, int n) {
  if (mode == 0) return n;
  if (mode == 1) return ((n >> 4) << 5) + (n & 15);
  if (mode == 2) return ((n >> 4) << 5) + 16 + (n & 15);
  if (n < 256) return ((n >> 5) << 6) + (n & 31);
  n -= 256; return ((n >> 5) << 6) + 32 + (n & 31);
}
constexpr int CONV_TILES = (1216 + 64 + 64 + 128 + 256 + 704 + 704 + 704 + 32) / 2;
struct ConvD { const float* src; bfu* dst; int N, ldd, koff, mode, kt, ntp; };
__device__ __forceinline__ ConvD conv_desc(const Params& P, int l, int t) {
  char* ws = P.ws;
  if (t < 608) return ConvD{P.in[I_WIN] + (size_t)l * 1024 * 4864, (bfu*)(ws + OFF_WIN), 4864, 1024, 0, 0, t / 38, t % 38};
  t -= 608;
  if (t < 32) return ConvD{P.in[I_PA] + (size_t)l * 256 * 1024, (bfu*)(ws + OFF_WP), 1024, 1024, 0, 0, t / 8, t % 8};
  t -= 32;
  if (t < 32) return ConvD{P.in[I_PB] + (size_t)l * 256 * 1024, (bfu*)(ws + OFF_WP), 1024, 1024, 256, 0, t / 8, t % 8};
  t -= 32;
  if (t < 64) return ConvD{P.in[I_PC] + (size_t)l * 512 * 1024, (bfu*)(ws + OFF_WP), 1024, 1024, 512, 0, t / 8, t % 8};
  t -= 64;
  if (t < 128) return ConvD{P.in[I_WOUT] + (size_t)l * 1024 * 1024, (bfu*)(ws + OFF_WO), 1024, 1024, 0, 0, t / 8, t % 8};
  t -= 128;
  if (t < 352) return ConvD{P.in[I_FG] + (size_t)l * 1024 * 2816, (bfu*)(ws + OFF_WGU), 2816, 1024, 0, 1, t / 22, t % 22};
  t -= 352;
  if (t < 352) return ConvD{P.in[I_FU] + (size_t)l * 1024 * 2816, (bfu*)(ws + OFF_WGU), 2816, 1024, 0, 2, t / 22, t % 22};
  t -= 352;
  if (t < 352) return ConvD{P.in[I_FD] + (size_t)l * 2816 * 1024, (bfu*)(ws + OFF_WDN), 1024, 2816, 0, 0, t / 8, t % 8};
  t -= 352;
  return ConvD{P.in[I_GLUW] + (size_t)l * 256 * 512, (bfu*)(ws + OFF_WGLU), 512, 256, 0, 3, t / 4, t % 4};
}
__device__ __forceinline__ void conv_ld(const ConvD& d, int tid, v4f (&r)[4]) {
  const int rr = tid >> 3, c0 = (tid & 7) * 8;
  const float* s0 = d.src + (size_t)(d.kt * 64 + rr) * d.N + d.ntp * 128 + c0;
  r[0] = *(const v4f*)s0; r[1] = *(const v4f*)(s0 + 4); r[2] = *(const v4f*)(s0 + 64); r[3] = *(const v4f*)(s0 + 68);
}
__device__ __forceinline__ void conv_lds_put(int tid, const v4f (&r)[4], float* tl) {
  const int rr = tid >> 3, c0 = (tid & 7) * 8;
  float* t0 = tl + c0 * 65 + rr;
  t0[0] = r[0].x; t0[65] = r[0].y; t0[130] = r[0].z; t0[195] = r[0].w; t0[260] = r[1].x; t0[325] = r[1].y; t0[390] = r[1].z; t0[455] = r[1].w;
  float* t1 = t0 + 64 * 65;
  t1[0] = r[2].x; t1[65] = r[2].y; t1[130] = r[2].z; t1[195] = r[2].w; t1[260] = r[3].x; t1[325] = r[3].y; t1[390] = r[3].z; t1[455] = r[3].w;
}
__device__ __forceinline__ void conv_out(const ConvD& d, int tid, const float* tl) {
#pragma unroll
  for (int hh = 0; hh < 2; ++hh) {
    int n = (tid >> 3) + hh * 64, k0 = (tid & 7) * 8;
    int drow = rowmap(d.mode, d.ntp * 128 + n);
    const float* t = tl + n * 65 + k0;
    uint4 o; o.x = pack2(t[0], t[1]); o.y = pack2(t[2], t[3]); o.z = pack2(t[4], t[5]); o.w = pack2(t[6], t[7]);
    *(uint4*)(d.dst + (size_t)drow * d.ldd + d.koff + d.kt * 64 + k0) = o;
  }
}
__device__ __forceinline__ void conv_stream(const Params& P, int l, int first, int stride, char* lds) {
  float* tl = (float*)lds;
  const int tid = tidx();
  asm volatile("" : "+s"(first), "+s"(stride));
  int it = first;
  v4f r[4];
  ConvD d = conv_desc(P, l, it < CONV_TILES ? it : 0);
  if (it < CONV_TILES) conv_ld(d, tid, r);
  while (it < CONV_TILES) {
    conv_lds_put(tid, r, tl);
    __syncthreads();
    const int nit = it + stride;
    const ConvD nd = conv_desc(P, l, nit < CONV_TILES ? nit : 0);
    if (nit < CONV_TILES) conv_ld(nd, tid, r);
    conv_out(d, tid, tl);
    __syncthreads();
    d = nd; it = nit;
  }
}

__device__ __forceinline__ void ada_item(const Params& P, int item, char* lds) {
  const int l = item / 96, cc = item % 96;
  float* sc = (float*)lds;
  float* red = sc + 3072;
  const int tid = tidx(), lane = tid & 63, w = tid >> 6;
  for (int i = tid; i < 3072; i += NTHR) {
    int cnd = i >> 10, k = i & 1023;
    float v = cnd == 0 ? P.in[I_CCTX][k] : P.in[I_C][(cnd - 1) * 1024 + k];
    sc[i] = v * sigm(v);
  }
  __syncthreads();
  const float* wp = P.in[I_ADAW] + (size_t)l * 1024 * 6144 + cc * 64 + lane;
  float a0 = 0.f, a1 = 0.f, a2 = 0.f;
#pragma unroll 1
  for (int k0 = w * 128; k0 < w * 128 + 128; k0 += 32) {
    float wv[32];
#pragma unroll
    for (int j = 0; j < 32; ++j) wv[j] = __builtin_nontemporal_load(wp + (size_t)(k0 + j) * 6144);
#pragma unroll
    for (int j = 0; j < 32; ++j) { a0 += sc[k0 + j] * wv[j]; a1 += sc[1024 + k0 + j] * wv[j]; a2 += sc[2048 + k0 + j] * wv[j]; }
  }
  red[(w * 3 + 0) * 64 + lane] = a0; red[(w * 3 + 1) * 64 + lane] = a1; red[(w * 3 + 2) * 64 + lane] = a2;
  __syncthreads();
  if (tid < 192) {
    int cnd = tid >> 6, c = tid & 63;
    float s = P.in[I_ADAB][l * 6144 + cc * 64 + c];
#pragma unroll
    for (int ww = 0; ww < 8; ++ww) s += red[(ww * 3 + cnd) * 64 + c];
    ((float*)(P.ws + OFF_MOD))[(l * 3 + cnd) * 6144 + cc * 64 + c] = s;
  }
  __syncthreads();
}

__device__ __forceinline__ void tables_item(const Params& P) {
  float2* tw = (float2*)(P.ws + OFF_TW);
  float2* rt = (float2*)(P.ws + OFF_RT);
  for (int k = tidx(); k < 4096; k += NTHR) { float s, c; sincospif((float)k / 4096.f, &s, &c); tw[k] = make_float2(c, -s); }
  for (int i = tidx(); i < 1024; i += NTHR) {
    int pos = i >> 4, f = i & 15;
    float inv = powf(10000.f, -(float)f / 16.f);
    float ang = (float)pos * inv;
    rt[i] = make_float2(cosf(ang), sinf(ang));
  }
}

__device__ __forceinline__ void filt_item(const Params& P, int l, int item2, char* lds) {
  const int item = item2 >> 1, chalf = item2 & 1;
  const bool isS = item >= 4;
  const int L = isS ? 4096 : 256;
  const int pb = isS ? item - 4 : item;
  float* F = (float*)(P.ws + (isS ? OFF_FS : OFF_FP));
  float* feat = (float*)lds;
  float* h1 = feat + 64 * 33;
  float* h2 = h1 + 64 * 65;
  const int tid = tidx();
  const int pos0 = pb * 64;
  const float tstep = 1.f / (float)(L - 1);
  for (int idx = tid; idx < 64 * 33; idx += NTHR) {
    int p = idx / 33, f = idx % 33;
    int pos = pos0 + p;
    float val;
    if (f == 0) val = (float)pos * tstep;
    else {
      int bi = (f - 1) & 15;
      float fr = (float)bi / 15.f;
      float band = 1e-4f * (1.f - fr) + 15.f * fr;
      float wv = 2.f * 3.14159265358979323846f * (float)pos / (float)L;
      float ang = wv * band;
      val = (f <= 16) ? cosf(ang) : -sinf(ang);
    }
    feat[idx] = val;
  }
  __syncthreads();
  const float* w1 = P.in[I_HW1] + (size_t)l * 33 * 64;
  const float* b1 = P.in[I_HB1] + l * 64;
  const float* w2 = P.in[I_HW2] + (size_t)l * 64 * 64;
  const float* b2 = P.in[I_HB2] + l * 64;
  const float* fq = P.in[I_HFREQ] + l * 64;
  for (int idx = tid; idx < 4096; idx += NTHR) {
    int p = idx >> 6, u = idx & 63;
    float s = b1[u];
    for (int f = 0; f < 33; ++f) s += feat[p * 33 + f] * w1[f * 64 + u];
    h1[p * 65 + u] = sinf(fq[u] * s);
  }
  __syncthreads();
  for (int idx = tid; idx < 4096; idx += NTHR) {
    int p = idx >> 6, u = idx & 63;
    float s = b2[u];
    for (int k = 0; k < 64; ++k) s += h1[p * 65 + k] * w2[k * 64 + u];
    h2[p * 65 + u] = sinf(fq[u] * s);
  }
  __syncthreads();
  const int lane = tid & 63, w = tid >> 6;
  float hr[64];
#pragma unroll
  for (int k = 0; k < 64; ++k) hr[k] = h2[lane * 65 + k];
  const float* w3 = P.in[I_HW3] + (size_t)l * 64 * 1024;
  const float* dec = P.in[I_HDEC] + l * 1024;
  const float tpos = (float)(pos0 + lane) * tstep;
  float* Wl = h2 + 64 * 65;
#pragma unroll 1
  for (int chunk = chalf * 4; chunk < chalf * 4 + 4; ++chunk) {
    __syncthreads();
    for (int i = tid; i < 2048; i += NTHR) {
      int k = i >> 5, c4 = i & 31;
      *(float4*)(Wl + k * 128 + c4 * 4) = *(const float4*)(w3 + k * 1024 + chunk * 128 + c4 * 4);
    }
    __syncthreads();
#pragma unroll 1
    for (int cgp = 0; cgp < 4; ++cgp) {
      const int cl = w * 16 + cgp * 4;
      float a0 = 0.f, a1 = 0.f, a2 = 0.f, a3 = 0.f;
#pragma unroll
      for (int k = 0; k < 64; ++k) {
        float4 wv = *(const float4*)(Wl + k * 128 + cl);
        a0 += hr[k] * wv.x; a1 += hr[k] * wv.y; a2 += hr[k] * wv.z; a3 += hr[k] * wv.w;
      }
      const int col = chunk * 128 + cl;
      F[(size_t)(col + 0) * L + pos0 + lane] = a0 * __expf(-tpos * fabsf(dec[col + 0]));
      F[(size_t)(col + 1) * L + pos0 + lane] = a1 * __expf(-tpos * fabsf(dec[col + 1]));
      F[(size_t)(col + 2) * L + pos0 + lane] = a2 * __expf(-tpos * fabsf(dec[col + 2]));
      F[(size_t)(col + 3) * L + pos0 + lane] = a3 * __expf(-tpos * fabsf(dec[col + 3]));
    }
  }
  __syncthreads();
}

__device__ __forceinline__ void s5pre_item(const Params& P, int l) {
  float2* lamb = (float2*)(P.ws + OFF_LAMB);
  float2* bbar = (float2*)(P.ws + OFF_BBAR);
  for (int idx = tidx(); idx < 2048; idx += NTHR) {
    float lre = P.in[I_LRE][l * 2048 + idx], lim = P.in[I_LIM][l * 2048 + idx];
    float step = expf(P.in[I_LSTEP][l * 32 + (idx >> 6)]);
    float er = expf(lre * step), sn, cs; sincosf(lim * step, &sn, &cs);
    float2 lb = make_float2(er * cs, er * sn);
    lamb[idx] = lb;
    float2 num = make_float2(lb.x - 1.f, lb.y);
    float den = lre * lre + lim * lim;
    float2 coef = make_float2((num.x * lre + num.y * lim) / den, (num.y * lre - num.x * lim) / den);
    const float* br = P.in[I_BRE] + ((size_t)l * 2048 + idx) * 16;
    const float* bi = P.in[I_BIM] + ((size_t)l * 2048 + idx) * 16;
    for (int c = 0; c < 16; ++c) bbar[idx * 16 + c] = cmul(coef, make_float2(br[c], bi[c]));
  }
}

__device__ __forceinline__ void norm_phase(const Params& P, int l, int which) {
  const int lane = tidx() & 63, w = tidx() >> 6;
  const float* gam = P.in[which ? I_N2G : I_N1G] + l * 1024;
  bfu* AB = (bfu*)(P.ws + OFF_AB);
  for (int row = bidx() * 8 + w; row < TT; row += gdim() * 8) {
    const float* x = which ? (const float*)(P.ws + OFF_XB) + (size_t)row * 1024 : xrow(P, l, row);
    const float* md = (const float*)(P.ws + OFF_MOD) + (l * 3 + cond_of(row)) * 6144 + which * 3072;
    float4 v[4]; float ss = 0.f;
#pragma unroll
    for (int i = 0; i < 4; ++i) { v[i] = *(const float4*)(x + i * 256 + lane * 4); ss += v[i].x * v[i].x + v[i].y * v[i].y + v[i].z * v[i].z + v[i].w * v[i].w; }
#pragma unroll
    for (int o = 32; o > 0; o >>= 1) ss += __shfl_xor(ss, o);
    float rs = rsqrtf(ss * (1.f / 1024.f) + 1e-6f);
#pragma unroll
    for (int i = 0; i < 4; ++i) {
      int c = i * 256 + lane * 4;
      float4 g = *(const float4*)(gam + c), sh = *(const float4*)(md + c), sc = *(const float4*)(md + 1024 + c);
      float o0 = v[i].x * rs * g.x * (1.f + sc.x) + sh.x, o1 = v[i].y * rs * g.y * (1.f + sc.y) + sh.y;
      float o2 = v[i].z * rs * g.z * (1.f + sc.z) + sh.z, o3 = v[i].w * rs * g.w * (1.f + sc.w) + sh.w;
      uint2 o; o.x = pack2(o0, o1); o.y = pack2(o2, o3);
      *(uint2*)(AB + (size_t)row * 1024 + c) = o;
    }
  }
}
__device__ __forceinline__ void final_phase(const Params& P) {
  const int lane = tidx() & 63, w = tidx() >> 6;
  const float* gam = P.in[I_FNG];
  for (int row = bidx() * 8 + w; row < TT; row += gdim() * 8) {
    const float* x = (const float*)(P.ws + OFF_X) + (size_t)row * 1024;
    float* y = P.out + (size_t)row * 1024;
    float4 v[4]; float ss = 0.f;
#pragma unroll
    for (int i = 0; i < 4; ++i) { v[i] = *(const float4*)(x + i * 256 + lane * 4); ss += v[i].x * v[i].x + v[i].y * v[i].y + v[i].z * v[i].z + v[i].w * v[i].w; }
#pragma unroll
    for (int o = 32; o > 0; o >>= 1) ss += __shfl_xor(ss, o);
    float rs = rsqrtf(ss * (1.f / 1024.f) + 1e-6f);
#pragma unroll
    for (int i = 0; i < 4; ++i) {
      int c = i * 256 + lane * 4;
      float4 g = *(const float4*)(gam + c);
      *(float4*)(y + c) = make_float4(v[i].x * rs * g.x, v[i].y * rs * g.y, v[i].z * rs * g.z, v[i].w * rs * g.w);
    }
  }
}

namespace pg8 {
#define PG8_LAS __attribute__((address_space(3)))
typedef unsigned short bf16_t;
typedef short bf16x8 __attribute__((ext_vector_type(8)));
typedef float f32x4 __attribute__((ext_vector_type(4)));
typedef unsigned u32x4 __attribute__((ext_vector_type(4)));
constexpr int BM = 256, BK = 64, HALF = 128, HTB = HALF * BK * 2  , STAGE_BYTES = 8 * HTB, NXCD = 8, WGM = 8;

__host__ __device__ __forceinline__ int lds_byte(int r, int c) { const int st = (r >> 4) * 2 + (c >> 5), rr = r & 15, cc = c & 31, ob = rr * 64 + cc * 2; return st * 1024 + (ob ^ (((ob >> 9) & 1) << 5)); }
__host__ __device__ __forceinline__ void stage_rc(int b, int& R, int& C) { const int st = b / 1024, sb = b % 1024, swz = sb ^ (((sb >> 9) & 1) << 5); R = (st >> 1) * 16 + swz / 64; C = (st & 1) * 32 + (swz % 64) / 2; }
__host__ __device__ __forceinline__ int perm32(int rho) { const int n = rho >> 4, i = rho & 15; return 8 * (i >> 2) + 4 * n + (i & 3); }

struct Unit { int pm, pn; };
struct Gemm { const bf16_t* A; const bf16_t* Bt; int M, N, K; };

struct StaticOrder {
    int nM, nN, nwg, G, c;
    __host__ __device__ void init(int M, int N, int G_, int c_) { nM = M / BM; nN = N / BM; nwg = nM * nN; G = G_; c = c_; }
    __host__ __device__ bool next(int i, Unit& u) const {
        const long L = (long)i * G + c; if (L >= nwg) return false;
        int wgid = (int)L; { const int q = nwg / NXCD, r = nwg % NXCD, xcd = wgid % NXCD, off = wgid / NXCD; wgid = (xcd < r ? xcd * (q + 1) : r * (q + 1) + (xcd - r) * q) + off; }
        const int nig = WGM * nN, gid = wgid / nig, fm = gid * WGM, gsz = (nM - fm) < WGM ? (nM - fm) : WGM;
        u.pm = fm + ((wgid % nig) % gsz); u.pn = (wgid % nig) / gsz; return true;
    }
    __device__ __forceinline__ void a_ready(const Unit&) const {}
    __device__ __forceinline__ void done(const Unit&) const {}
};
__device__ __forceinline__ unsigned cvt_pk_bf16(float lo, float hi) { unsigned r; asm volatile("v_cvt_pk_bf16_f32 %0, %1, %2" : "=v"(r) : "v"(lo), "v"(hi)); return r; }
template <class Epi, class Sched, bool STAMP = false>
__device__ __forceinline__ void gemm_phase(PG8_LAS unsigned char* lds, const Gemm g, const Sched& S, const Epi& E, unsigned long long* stamps) {
    const int tid = tidx(), wid = __builtin_amdgcn_readfirstlane(tid >> 6), lane = tid & 63, wr = wid >> 2, wc = wid & 3, fr = lane & 15, fq = lane >> 4;
    const int K = g.K, nt = K / BK;
    int ts_lo = 0, ts_hi = 0, nts = 0; const unsigned long long rt_entry = STAMP ? (unsigned long long)wall_clock64() : 0ull;
#define PG8_STAMP() do { if (STAMP && wid == 0 && nts < 64) { const unsigned long long _c = (unsigned long long)clock64(); \
        ts_lo = (lane == nts) ? (int)(unsigned)_c : ts_lo; ts_hi = (lane == nts) ? (int)(unsigned)(_c >> 32) : ts_hi; ++nts; } } while (0)
    PG8_STAMP();
    unsigned voffA[2], voffB[2];
#pragma unroll
    for (int i = 0; i < 2; ++i) { int R, C; stage_rc(tid * 16 + i * 8192, R, C); const int Rb = Epi::PERM ? ((R & ~31) + perm32(R & 31)) : R;
        voffA[i] = (unsigned)(R * K + C) * 2u; voffB[i] = (unsigned)(Rb * K + C) * 2u; }
    const size_t kstep = (size_t)(BK * 2);
    const size_t hstep = (size_t)HALF * K * 2;
    const size_t tstep = 2 * hstep;
    const unsigned ldsw = (unsigned)wid * 1024u;
    const int aoff = lds_byte(wr * 64 + fr, fq * 8), boff = lds_byte(wc * 32 + fr, fq * 8);
#define PG8_SA(b, h) (((b) * 2 + (h)) * HTB)
#define PG8_SB(b, h) ((4 + (b) * 2 + (h)) * HTB)
#define PG8_STAGE(bufoff, gbase, voff) do { _Pragma("unroll") for (int _i = 0; _i < 2; ++_i) \
        __builtin_amdgcn_global_load_lds((const unsigned*)((const char*)(gbase) + (voff)[_i]), (PG8_LAS unsigned*)(lds + (bufoff) + ldsw + _i * 8192), 16, 0, 0); } while (0)
#define PG8_LDA(dst, b, h) do { _Pragma("unroll") for (int m = 0; m < 4; ++m) _Pragma("unroll") for (int k = 0; k < 2; ++k) dst[m][k] = *(const PG8_LAS bf16x8*)(lds + PG8_SA(b, h) + aoff + m * 2048 + k * 1024); } while (0)
#define PG8_LDB(dst, b, h) do { _Pragma("unroll") for (int n = 0; n < 2; ++n) _Pragma("unroll") for (int k = 0; k < 2; ++k) dst[n][k] = *(const PG8_LAS bf16x8*)(lds + PG8_SB(b, h) + boff + n * 2048 + k * 1024); } while (0)
#define PG8_MMA(ai, bj, At, Bt) do { __builtin_amdgcn_s_setprio(1); _Pragma("unroll") for (int m = 0; m < 4; ++m) _Pragma("unroll") for (int n = 0; n < 2; ++n) _Pragma("unroll") for (int k = 0; k < 2; ++k) \
        acc[ai][bj][m][n] = __builtin_amdgcn_mfma_f32_16x16x32_bf16(Bt[n][k], At[m][k], acc[ai][bj][m][n], 0, 0, 0); __builtin_amdgcn_s_setprio(0); } while (0)
#define PG8_WAIT_V(n) asm volatile("s_waitcnt vmcnt(" #n ")" ::: "memory")
#define PG8_WAIT_L(n) asm volatile("s_waitcnt lgkmcnt(" #n ")" ::: "memory")
#define PG8_BAR __builtin_amdgcn_s_barrier()
#define PG8_SCHED __builtin_amdgcn_sched_barrier(0)
    Unit cur, nxt; int ui = 0;
    if (!S.next(0, cur)) return;
    f32x4 acc[2][2][4][2];
#pragma unroll
    for (int a = 0; a < 2; ++a)
#pragma unroll
        for (int b = 0; b < 2; ++b)
#pragma unroll
            for (int m = 0; m < 4; ++m)
#pragma unroll
                for (int n = 0; n < 2; ++n) acc[a][b][m][n] = (f32x4){0.f, 0.f, 0.f, 0.f};
    bf16x8 At[4][2], B0[2][2], B1[2][2];
    const char* cA = (const char*)g.A + (size_t)cur.pm * tstep; const char* cB = (const char*)g.Bt + (size_t)cur.pn * tstep;
    S.a_ready(cur);
    PG8_STAGE(PG8_SB(0, 0), cB, voffB); PG8_STAGE(PG8_SA(0, 0), cA, voffA); PG8_STAGE(PG8_SB(0, 1), cB + hstep, voffB); PG8_STAGE(PG8_SA(0, 1), cA + hstep, voffA);
    if (wr == 1) PG8_BAR;
    PG8_WAIT_V(4); PG8_BAR;
    PG8_STAGE(PG8_SB(1, 0), cB + kstep, voffB); PG8_STAGE(PG8_SA(1, 0), cA + kstep, voffA); PG8_STAGE(PG8_SB(1, 1), cB + hstep + kstep, voffB);
    PG8_WAIT_V(6); PG8_BAR;
    PG8_STAMP();
    for (;;) {
        const bool has_next = S.next(ui + 1, nxt);
        const char* nA = has_next ? (const char*)g.A + (size_t)nxt.pm * tstep : cA; const char* nB = has_next ? (const char*)g.Bt + (size_t)nxt.pn * tstep : cB;
        for (int t = 0; t < nt; t += 2) {
            const bool last = (t == nt - 2);
            const char* a1 = cA + (size_t)(t + 1) * kstep;
            const char* a2 = last ? nA : cA + (size_t)(t + 2) * kstep; const char* b2 = last ? nB : cB + (size_t)(t + 2) * kstep;
            const char* a3 = a2 + kstep; const char* b3 = b2 + kstep;
            if (last && has_next) S.a_ready(nxt);
            PG8_LDB(B0, 0, 0); PG8_SCHED; PG8_LDA(At, 0, 0); PG8_STAGE(PG8_SA(1, 1), a1 + hstep, voffA);
            PG8_WAIT_L(8); PG8_BAR; PG8_WAIT_L(0); PG8_MMA(0, 0, At, B0); PG8_BAR; PG8_SCHED;
            PG8_LDB(B1, 0, 1); PG8_STAGE(PG8_SB(0, 0), b2, voffB);
            PG8_BAR; PG8_WAIT_L(0); PG8_MMA(0, 1, At, B1); PG8_BAR;
            PG8_LDA(At, 0, 1); PG8_STAGE(PG8_SA(0, 0), a2, voffA);
            PG8_BAR; PG8_WAIT_L(0); PG8_MMA(1, 0, At, B0); PG8_BAR; PG8_SCHED;
            PG8_STAGE(PG8_SB(0, 1), b2 + hstep, voffB);
            PG8_WAIT_V(6); PG8_BAR; PG8_MMA(1, 1, At, B1); PG8_BAR;
            PG8_LDB(B0, 1, 0); PG8_SCHED; PG8_LDA(At, 1, 0); PG8_STAGE(PG8_SA(0, 1), a2 + hstep, voffA);
            PG8_WAIT_L(8); PG8_BAR; PG8_WAIT_L(0); PG8_MMA(0, 0, At, B0); PG8_BAR; PG8_SCHED;
            PG8_LDB(B1, 1, 1); PG8_STAGE(PG8_SB(1, 0), b3, voffB);
            PG8_BAR; PG8_WAIT_L(0); PG8_MMA(0, 1, At, B1); PG8_BAR;
            PG8_LDA(At, 1, 1); PG8_STAGE(PG8_SA(1, 0), a3, voffA);
            PG8_BAR; PG8_WAIT_L(0); PG8_MMA(1, 0, At, B0); PG8_BAR; PG8_SCHED;
            PG8_STAGE(PG8_SB(1, 1), b3 + hstep, voffB);
            PG8_WAIT_V(6); PG8_BAR; PG8_MMA(1, 1, At, B1); PG8_BAR;
        }
        PG8_STAMP();
        if constexpr (!Epi::AFTER_DRAIN) { E(acc, cur, wr, wc, fr, fq); S.done(cur); }
        PG8_STAMP();
        if (!has_next) break;
#pragma unroll
        for (int a = 0; a < 2; ++a)
#pragma unroll
            for (int b = 0; b < 2; ++b)
#pragma unroll
                for (int m = 0; m < 4; ++m)
#pragma unroll
                    for (int n = 0; n < 2; ++n) acc[a][b][m][n] = (f32x4){0.f, 0.f, 0.f, 0.f};
        cur = nxt; cA = nA; cB = nB; ++ui;
    }
    PG8_WAIT_V(0);
    if (wr == 0) PG8_BAR;
    PG8_BAR;
    if constexpr (Epi::AFTER_DRAIN) { E.fused(acc, cur, wr, wc, fr, fq, lds, wid, lane); S.done(cur); }
    PG8_STAMP();
    if (STAMP && wid == 0) { stamps[lane] = lane < nts ? (((unsigned long long)(unsigned)ts_hi << 32) | (unsigned)ts_lo) : 0ull;
        if (lane == 62) stamps[62] = rt_entry; if (lane == 63) stamps[63] = (unsigned long long)wall_clock64(); }
#undef PG8_STAMP
#undef PG8_SA
#undef PG8_SB
#undef PG8_STAGE
#undef PG8_LDA
#undef PG8_LDB
#undef PG8_MMA
#undef PG8_WAIT_V
#undef PG8_WAIT_L
#undef PG8_BAR
#undef PG8_SCHED
}
}

struct EpiIn {
  static constexpr bool PERM = false, AFTER_DRAIN = false;
  const Params* Pp; int l;
  __device__ __forceinline__ void operator()(const pg8::f32x4 (&acc)[2][2][4][2], const pg8::Unit& u, int wr, int wc, int fr, int fq) const {
    const Params& P = *Pp;
    const int row0 = u.pm * 256 + wr * 64 + fr;
#pragma unroll
    for (int bj = 0; bj < 2; ++bj) {
      const int colb = u.pn * 256 + bj * 128;
#pragma unroll
      for (int ai = 0; ai < 2; ++ai)
#pragma unroll
        for (int m = 0; m < 4; ++m) {
          const int row = row0 + ai * 128 + m * 16;
#pragma unroll
          for (int n = 0; n < 2; ++n) {
            const int c = colb + wc * 32 + n * 16 + 4 * fq;
            const pg8::f32x4 v = acc[ai][bj][m][n];
            if (colb < 768) {
              float* zt = (float*)(P.ws + OFF_ZAT) + (size_t)c * TT + row;
              zt[0] = v[0]; zt[TT] = v[1]; zt[2 * (size_t)TT] = v[2]; zt[3 * (size_t)TT] = v[3];
            } else if (colb < 1024) *(pg8::f32x4*)((float*)(P.ws + OFF_ZB) + (size_t)row * 256 + c - 768) = v;
            else if (colb < 1536) *(pg8::f32x4*)((float*)(P.ws + OFF_Q) + (size_t)row * 512 + c - 1024) = v;
            else if (colb < 1792) {
              const bool isv = colb >= 1664;
              const int cc = c - (isv ? 1664 : 1536);
              float* dst = row < 4096 ? P.out + (isv ? OUT_V : OUT_K) + ((size_t)((row >> 8) * 4 + l) * 256 + (row & 255)) * 128 + cc
                                      : (float*)(P.ws + (isv ? OFF_VS : OFF_KS)) + (size_t)(row - 4096) * 128 + cc;
              *(pg8::f32x4*)dst = v;
            } else {
              uint2 o; o.x = pack2(sigm(v[0]), sigm(v[1])); o.y = pack2(sigm(v[2]), sigm(v[3]));
              *(uint2*)((bfu*)(P.ws + OFF_G) + (size_t)row * 3072 + c - 1792) = o;
            }
          }
        }
    }
  }
};
struct EpiFfnUp {
  static constexpr bool PERM = false, AFTER_DRAIN = false;
  bfu* HID;
  __device__ __forceinline__ void operator()(const pg8::f32x4 (&acc)[2][2][4][2], const pg8::Unit& u, int wr, int wc, int fr, int fq) const {
    const int row0 = u.pm * 256 + wr * 64 + fr;
#pragma unroll
    for (int ai = 0; ai < 2; ++ai)
#pragma unroll
      for (int m = 0; m < 4; ++m) {
        const int row = row0 + ai * 128 + m * 16;
#pragma unroll
        for (int bj = 0; bj < 2; ++bj) {
          const int hc = u.pn * 128 + bj * 64 + wc * 16 + 4 * fq;
          const pg8::f32x4 g = acc[ai][bj][m][0], up = acc[ai][bj][m][1];
          uint2 o; o.x = pack2(g[0] * sigm(g[0]) * up[0], g[1] * sigm(g[1]) * up[1]); o.y = pack2(g[2] * sigm(g[2]) * up[2], g[3] * sigm(g[3]) * up[3]);
          *(uint2*)(HID + (size_t)row * 2816 + hc) = o;
        }
      }
  }
};
struct EpiResid {
  static constexpr bool PERM = false, AFTER_DRAIN = false;
  const Params* Pp; int l; int which;
  __device__ __forceinline__ void operator()(const pg8::f32x4 (&acc)[2][2][4][2], const pg8::Unit& u, int wr, int wc, int fr, int fq) const {
    const Params& P = *Pp;
    const int row0 = u.pm * 256 + wr * 64 + fr;
    const float* gate = (const float*)(P.ws + OFF_MOD) + (l * 3 + cond_of(u.pm * 256)) * 6144 + (which ? 5120 : 2048);
    float* XA = (float*)(P.ws + OFF_X);
    float* XB = (float*)(P.ws + OFF_XB);
#pragma unroll
    for (int bj = 0; bj < 2; ++bj)
#pragma unroll
      for (int n = 0; n < 2; ++n) {
        const int c = u.pn * 256 + bj * 128 + wc * 32 + n * 16 + 4 * fq;
        const pg8::f32x4 gv = *(const pg8::f32x4*)(gate + c);
#pragma unroll
        for (int ai = 0; ai < 2; ++ai)
#pragma unroll
          for (int m = 0; m < 4; ++m) {
            const int row = row0 + ai * 128 + m * 16;
            const float* xs = which ? XB + (size_t)row * 1024 + c : xrow(P, l, row) + c;
            float* xd = (which ? XA : XB) + (size_t)row * 1024 + c;
            const pg8::f32x4 xin = *(const pg8::f32x4*)xs;
            *(pg8::f32x4*)xd = xin + gv * acc[ai][bj][m][n];
          }
      }
  }
};

struct EpiAll {
  static constexpr bool PERM = false, AFTER_DRAIN = false;
  const Params* Pp; int l; int mode;
  __device__ __forceinline__ void operator()(const pg8::f32x4 (&acc)[2][2][4][2], const pg8::Unit& u, int wr, int wc, int fr, int fq) const {
    if (mode == 0) { EpiIn e{Pp, l}; e(acc, u, wr, wc, fr, fq); }
    else if (mode == 1) { EpiFfnUp e{(bfu*)(Pp->ws + OFF_G)}; e(acc, u, wr, wc, fr, fq); }
    else { EpiResid e{Pp, l, mode - 2}; e(acc, u, wr, wc, fr, fq); }
  }
};
__device__ __forceinline__ void big_gemm_phase(const Params& P, int l, int mode, char* lds) {
  const bfu* A = (const bfu*)(P.ws + (mode == 3 ? OFF_G : OFF_AB));
  const bfu* B = (const bfu*)(P.ws + (mode == 0 ? OFF_WIN : mode == 1 ? OFF_WGU : mode == 2 ? OFF_WO : OFF_WDN));
  const int N = mode == 0 ? 4864 : mode == 1 ? 5632 : 1024;
  const int K = mode == 3 ? 2816 : 1024;
  pg8::Gemm g{A, B, TT, N, K};
  pg8::StaticOrder S; S.init(TT, N, gdim(), bidx());
  EpiAll E{&P, l, mode};
  pg8::gemm_phase<EpiAll, pg8::StaticOrder, false>((PG8_LAS unsigned char*)lds, g, S, E, nullptr);
}

__device__ __forceinline__ int tile_slots(int MT, int NT) { return (MT >> 3) * ((NT + 3) >> 2) * 32; }
__device__ __forceinline__ bool tile_map(int it, int MT, int NT, int& mt, int& nt) {
  int T = it;
  if (gdim() == 256) { const int b = it & 255, j = it >> 8; T = ((j * 8 + (b & 7)) << 5) + (b >> 3); }
  const int patch = T >> 5, ip = T & 31, pmc = MT >> 3;
  mt = (patch % pmc) * 8 + (ip & 7); nt = (patch / pmc) * 4 + (ip >> 3);
  return nt < NT && T < tile_slots(MT, NT);
}
#define TILE_LOOP(MT_, NT_) const int nslots_ = (tile_slots(MT_, NT_) + 255) / 256 * 256; \
  for (int it_ = bidx(); it_ < nslots_; it_ += gdim()) { int mt, nt; if (!tile_map(it_, MT_, NT_, mt, nt)) continue;

#define EPI_ROW(MI_, mi, reg) (wm * 32 * MI_ + (mi) * 32 + ((reg) & 3) + 8 * ((reg) >> 2) + 4 * h)

__device__ __forceinline__ void glu_phase(const Params& P, int l, char* lds) {
  const int tid = tidx(), lane = tid & 63, w = tid >> 6, wm = w & 3, wn = w >> 2, r = lane & 31, h = lane >> 5;
  const bfu* A = (const bfu*)(P.ws + OFF_YS5);
  const bfu* B = (const bfu*)(P.ws + OFF_WGLU);
  const float* bias = P.in[I_GLUB] + l * 512;
  bfu* YC = (bfu*)(P.ws + OFF_YCAT);
  TILE_LOOP(96, 4)
    const int m0 = mt * 128;
    f32x16 acc[1][2]; zero_acc<1>(acc);
    gemm_core<1>(A + (size_t)m0 * 256, 256, B + (size_t)(nt * 128) * 256, 256, 256, acc, lds);
    const int cj = nt * 64 + wn * 32 + r;
    const float ba = bias[cj], bg = bias[256 + cj];
#pragma unroll
    for (int reg = 0; reg < 16; ++reg) {
      const int row = m0 + EPI_ROW(1, 0, reg);
      float a = acc[0][0][reg] + ba, g = acc[0][1][reg] + bg;
      YC[(size_t)row * 1024 + 256 + cj] = f2bf(a * sigm(g));
    }
  }
}

__device__ __forceinline__ void proj_phase(const Params& P, int l, char* lds) {
  const int tid = tidx(), lane = tid & 63, w = tid >> 6, wm = w & 3, wn = w >> 2, r = lane & 31, h = lane >> 5;
  const bfu* A = (const bfu*)(P.ws + OFF_YCAT);
  const bfu* B = (const bfu*)(P.ws + OFF_WP);
  const bfu* G = (const bfu*)(P.ws + OFF_G);
  bfu* AB = (bfu*)(P.ws + OFF_AB);
  TILE_LOOP(96, 8)
    const int m0 = mt * 128, n0 = nt * 128;
    f32x16 mg[1][2]; zero_acc<1>(mg);
#pragma unroll 1
    for (int seg = 0; seg < 3; ++seg) {
      const int koff = seg * 256, klen = seg == 2 ? 512 : 256;
      float gq[2][16];
#pragma unroll
      for (int ni = 0; ni < 2; ++ni) {
        const int col = n0 + wn * 64 + ni * 32 + r;
#pragma unroll
        for (int reg = 0; reg < 16; ++reg) gq[ni][reg] = bf2f(G[(size_t)(m0 + EPI_ROW(1, 0, reg)) * 3072 + seg * 1024 + col]);
      }
      f32x16 acc[1][2]; zero_acc<1>(acc);
      gemm_core<1>(A + (size_t)m0 * 1024 + koff, 1024, B + (size_t)n0 * 1024 + koff, 1024, klen, acc, lds);
#pragma unroll
      for (int ni = 0; ni < 2; ++ni)
#pragma unroll
        for (int reg = 0; reg < 16; ++reg) mg[0][ni][reg] += gq[ni][reg] * acc[0][ni][reg];
    }
#pragma unroll
    for (int ni = 0; ni < 2; ++ni) {
      const int col = n0 + wn * 64 + ni * 32 + r;
#pragma unroll
      for (int reg = 0; reg < 16; ++reg) AB[(size_t)(m0 + EPI_ROW(1, 0, reg)) * 1024 + col] = f2bf(mg[0][ni][reg]);
    }
  }
}

__device__ __forceinline__ float short_conv(const float* __restrict__ z, int t, int L, float w0, float w1, float w2, float b) {
  float s = b + w1 * z[t];
  if (t > 0) s += w0 * z[t - 1];
  if (t < L - 1) s += w2 * z[t + 1];
  return s;
}

#define TWD(k) tw[(k) + ((k) >> 6)]
__device__ __forceinline__ float2 cadd(float2 a, float2 b) { return make_float2(a.x + b.x, a.y + b.y); }
__device__ __forceinline__ float2 csub(float2 a, float2 b) { return make_float2(a.x - b.x, a.y - b.y); }
__device__ __forceinline__ void fft_fwd(float2* data, const float2* tw) {
  const int tid = tidx();
#pragma unroll
  for (int it = 0; it < 8; ++it) {
    int i = tid + it * NTHR;
    float2 a = data[i], b = data[i + 4096], wv = TWD(i);
    data[i] = cadd(a, b);
    data[i + 4096] = cmul(csub(a, b), wv);
  }
  __syncthreads();
#pragma unroll
  for (int s = 11; s >= 3; s -= 2) {
    const int q = 1 << (s - 1);
#pragma unroll
    for (int it = 0; it < 4; ++it) {
      int i = tid + it * NTHR;
      int j = i & (q - 1);
      int base = ((i >> (s - 1)) << (s + 1)) | j;
      float2 x0 = data[base], x1 = data[base + q], x2 = data[base + 2 * q], x3 = data[base + 3 * q];
      float2 w1 = TWD(j << (12 - s)), w2 = TWD(j << (13 - s));
      float2 a0 = cadd(x0, x2), a2 = cmul(csub(x0, x2), w1), a1 = cadd(x1, x3);
      float2 t3 = cmul(csub(x1, x3), w1); float2 a3 = make_float2(t3.y, -t3.x);
      data[base] = cadd(a0, a1); data[base + q] = cmul(csub(a0, a1), w2);
      data[base + 2 * q] = cadd(a2, a3); data[base + 3 * q] = cmul(csub(a2, a3), w2);
    }
    __syncthreads();
  }
#pragma unroll
  for (int it = 0; it < 4; ++it) {
    int i = tid + it * NTHR;
    float4 p0 = *(float4*)(data + 4 * i), p1 = *(float4*)(data + 4 * i + 2);
    float2 x0 = make_float2(p0.x, p0.y), x1 = make_float2(p0.z, p0.w), x2 = make_float2(p1.x, p1.y), x3 = make_float2(p1.z, p1.w);
    float2 a0 = cadd(x0, x2), a2 = csub(x0, x2), a1 = cadd(x1, x3);
    float2 t3 = csub(x1, x3); float2 a3 = make_float2(t3.y, -t3.x);
    float2 y0 = cadd(a0, a1), y1 = csub(a0, a1), y2 = cadd(a2, a3), y3 = csub(a2, a3);
    *(float4*)(data + 4 * i) = make_float4(y0.x, y0.y, y1.x, y1.y);
    *(float4*)(data + 4 * i + 2) = make_float4(y2.x, y2.y, y3.x, y3.y);
  }
  __syncthreads();
}
__device__ __forceinline__ void fft_inv(float2* data, const float2* tw) {
  const int tid = tidx();
#pragma unroll
  for (int it = 0; it < 4; ++it) {
    int i = tid + it * NTHR;
    float4 p0 = *(float4*)(data + 4 * i), p1 = *(float4*)(data + 4 * i + 2);
    float2 x0 = make_float2(p0.x, p0.y), x1 = make_float2(p0.z, p0.w), x2 = make_float2(p1.x, p1.y), x3 = make_float2(p1.z, p1.w);
    float2 a0 = cadd(x0, x1), a1 = csub(x0, x1), a2 = cadd(x2, x3), a3 = csub(x2, x3);
    float2 c3 = make_float2(-a3.y, a3.x);
    float2 y0 = cadd(a0, a2), y2 = csub(a0, a2), y1 = cadd(a1, c3), y3 = csub(a1, c3);
    *(float4*)(data + 4 * i) = make_float4(y0.x, y0.y, y1.x, y1.y);
    *(float4*)(data + 4 * i + 2) = make_float4(y2.x, y2.y, y3.x, y3.y);
  }
  __syncthreads();
#pragma unroll
  for (int s = 2; s <= 10; s += 2) {
    const int q = 1 << s;
#pragma unroll
    for (int it = 0; it < 4; ++it) {
      int i = tid + it * NTHR;
      int j = i & (q - 1);
      int base = ((i >> s) << (s + 2)) | j;
      float2 x0 = data[base], x1 = data[base + q], x2 = data[base + 2 * q], x3 = data[base + 3 * q];
      float2 w1 = TWD(j << (12 - s)), w2 = TWD(j << (11 - s));
      w1.y = -w1.y; w2.y = -w2.y;
      float2 b1 = cmul(x1, w1), b3 = cmul(x3, w1);
      float2 a0 = cadd(x0, b1), a1 = csub(x0, b1), a2 = cadd(x2, b3), a3 = csub(x2, b3);
      float2 c2 = cmul(a2, w2), t3 = cmul(a3, w2); float2 c3 = make_float2(-t3.y, t3.x);
      data[base] = cadd(a0, c2); data[base + 2 * q] = csub(a0, c2);
      data[base + q] = cadd(a1, c3); data[base + 3 * q] = csub(a1, c3);
    }
    __syncthreads();
  }
#pragma unroll
  for (int it = 0; it < 8; ++it) {
    int i = tid + it * NTHR;
    float2 wv = TWD(i); wv.y = -wv.y;
    float2 a = data[i], b = cmul(data[i + 4096], wv);
    data[i] = cadd(a, b);
    data[i + 4096] = csub(a, b);
  }
  __syncthreads();
}
__device__ __forceinline__ float block_sum(float v, float* red) {
  const int lane = tidx() & 63, w = tidx() >> 6;
#pragma unroll
  for (int o = 32; o > 0; o >>= 1) v += __shfl_xor(v, o);
  __syncthreads();
  if (lane == 0) red[w] = v;
  __syncthreads();
  float s = 0.f;
#pragma unroll
  for (int i = 0; i < 8; ++i) s += red[i];
  return s;
}

__device__ __forceinline__ void hyena_sample_item(const Params& P, int l, int c, char* lds) {
  float2* data = (float2*)lds;
  float2* tw = data + 8192;
  __shared__ float red[8];
  const int tid = tidx();
  const int L = 4096;
  const float* FS = (const float*)(P.ws + OFF_FS);
  const float* ZAT = (const float*)(P.ws + OFF_ZAT);
  const float* cw = P.in[I_HCW] + l * 3 * 768;
  const float* cb = P.in[I_HCB] + l * 768;
  {
    const float2* twg = (const float2*)(P.ws + OFF_TW);
    for (int i = tid; i < 4096; i += NTHR) tw[i + (i >> 6)] = twg[i];
  }
  float2 vreg[8];
  float2 KfA[16], KfB[16];
  {
    const float* hf0 = FS + (size_t)(0 * 256 + c) * L; const float* hb0 = FS + (size_t)(1 * 256 + c) * L;
    const float* hf1 = FS + (size_t)(2 * 256 + c) * L; const float* hb1 = FS + (size_t)(3 * 256 + c) * L;
    float as0 = 0.f, as1 = 0.f;
#pragma unroll
    for (int m = 0; m < 16; ++m) {
      int n = tid + m * NTHR;
      float v0 = n < L ? hf0[n] : (n == L ? 0.f : hb0[2 * L - n]);
      float v1 = n < L ? hf1[n] : (n == L ? 0.f : hb1[2 * L - n]);
      as0 += fabsf(v0); as1 += fabsf(v1);
      data[n] = make_float2(v0, v1);
    }
    const float nrm0 = block_sum(as0, red);
    const float nrm1 = block_sum(as1, red);
    fft_fwd(data, tw);
    const float k0s = 0.5f / (nrm0 * 8192.f), k1s = 0.5f / (nrm1 * 8192.f);
#pragma unroll
    for (int m = 0; m < 16; ++m) {
      const int r = tid + m * NTHR;
      const unsigned n = __brev((unsigned)r) >> 19;
      const unsigned rp = __brev(((8192u - n) & 8191u)) >> 19;
      const float2 A = data[r], Bz = data[rp];
      KfA[m] = make_float2((A.x + Bz.x) * k0s, (A.y - Bz.y) * k0s);
      KfB[m] = make_float2((A.y + Bz.y) * k1s, (Bz.x - A.x) * k1s);
    }
    __syncthreads();
  }
#pragma unroll
  for (int o = 0; o < 2; ++o) {
    float2 Kf[16];
#pragma unroll
    for (int m = 0; m < 16; ++m) Kf[m] = o == 0 ? KfA[m] : KfB[m];
    if (o == 0) {
      const float w0 = cw[c], w1 = cw[768 + c], w2 = cw[1536 + c], b = cb[c];
      const float* z0 = ZAT + (size_t)c * TT + 4096;
#pragma unroll
      for (int m = 0; m < 8; ++m) {
        int t = tid + m * NTHR;
        vreg[m] = make_float2(short_conv(z0, t, L, w0, w1, w2, b), short_conv(z0 + 4096, t, L, w0, w1, w2, b));
      }
    }
#pragma unroll
    for (int m = 0; m < 8; ++m) { int t = tid + m * NTHR; data[t] = vreg[m]; data[t + L] = make_float2(0.f, 0.f); }
    __syncthreads();
    fft_fwd(data, tw);
#pragma unroll
    for (int m = 0; m < 16; ++m) { int n = tid + m * NTHR; data[n] = cmul(data[n], Kf[m]); }
    __syncthreads();
    fft_inv(data, tw);
    {
      const int gc = (o + 1) * 256 + c;
      const float w0 = cw[gc], w1 = cw[768 + gc], w2 = cw[1536 + gc], b = cb[gc];
      const float* zg = ZAT + (size_t)gc * TT + 4096;
      const float sk = P.in[I_HSKIP][(l * 2 + o) * 256 + c];
#pragma unroll
      for (int m = 0; m < 8; ++m) {
        int t = tid + m * NTHR;
        float2 y = data[t];
        float g0 = short_conv(zg, t, L, w0, w1, w2, b), g1 = short_conv(zg + 4096, t, L, w0, w1, w2, b);
        vreg[m] = make_float2(g0 * (y.x + sk * vreg[m].x), g1 * (y.y + sk * vreg[m].y));
      }
    }
    __syncthreads();
  }
  bfu* YAT = (bfu*)(P.ws + OFF_YAT);
#pragma unroll
  for (int m = 0; m < 8; ++m) {
    int t = tid + m * NTHR;
    YAT[(size_t)c * TT + 4096 + t] = f2bf(vreg[m].x);
    YAT[(size_t)c * TT + 8192 + t] = f2bf(vreg[m].y);
  }
}

typedef __attribute__((ext_vector_type(4))) float f32x4_t;
__device__ __forceinline__ void hyena_prompt_item(const Params& P, int l, int c, char* lds) {
  float* V = (float*)lds;
  float* KF = V + 4096;
  bfu* Ub = (bfu*)(KF + 1024);
  bfu* Rc = Ub + 16 * 264;
  __shared__ float red[8];
  const int tid = tidx(), lane = tid & 63, w = tid >> 6;
  const int L = 256;
  const float* FP = (const float*)(P.ws + OFF_FP);
  const float* ZAT = (const float*)(P.ws + OFF_ZAT);
  const float* cw = P.in[I_HCW] + l * 3 * 768;
  const float* cb = P.in[I_HCB] + l * 768;
#pragma unroll
  for (int o = 0; o < 2; ++o) {
    const float* hf = FP + (size_t)((o * 2 + 0) * 256 + c) * L;
    const float* hb = FP + (size_t)((o * 2 + 1) * 256 + c) * L;
    int d = tid - 255;
    float v = (tid == 511) ? 0.f : (d >= 0 ? hf[d] : hb[-d]);
    float nrm = block_sum(fabsf(v), red);
    KF[o * 512 + tid] = v / nrm;
  }
  const int seq = tid >> 5, t0 = (tid & 31) * 8;
  {
    const float w0 = cw[c], w1 = cw[768 + c], w2 = cw[1536 + c], b = cb[c];
    const float* z0 = ZAT + (size_t)c * TT + seq * 256;
    float vr[8];
#pragma unroll
    for (int i = 0; i < 8; ++i) { vr[i] = short_conv(z0, t0 + i, L, w0, w1, w2, b); V[seq * 256 + t0 + i] = vr[i]; }
    uint4 o4; o4.x = pack2(vr[0], vr[1]); o4.y = pack2(vr[2], vr[3]); o4.z = pack2(vr[4], vr[5]); o4.w = pack2(vr[6], vr[7]);
    *(uint4*)(Ub + seq * 264 + t0) = o4;
  }
  __syncthreads();
  for (int i = tid; i < 2 * 8 * 528; i += NTHR) {
    const int o = i / (8 * 528), rem = i % (8 * 528), cc = rem / 528, x = rem % 528;
    const int y = 510 - x - cc;
    Rc[i] = (y >= 0 && y <= 510) ? f2bf(KF[o * 512 + y]) : (bfu)0;
  }
  __syncthreads();
  const int r = lane & 15, hq = lane >> 4;
  const int cc = 7 - (r & 7);
  bfu* YC = (bfu*)(P.ws + OFF_YCAT);
#pragma unroll
  for (int o = 0; o < 2; ++o) {
    f32x4_t acc[2];
#pragma unroll
    for (int i = 0; i < 2; ++i) {
      const int tb = w * 2 + i;
      acc[i] = (f32x4_t){0.f, 0.f, 0.f, 0.f};
      const int t = tb * 16 + r;
#pragma unroll
      for (int sb = 0; sb < 8; ++sb) {
        const int sbase = sb * 32 + 8 * hq;
        const int q = 255 - t + sbase;
        const bf16x8 af = *(const bf16x8*)(Rc + (o * 8 + cc) * 528 + (q - cc));
        const bf16x8 bf = *(const bf16x8*)(Ub + r * 264 + sbase);
        acc[i] = __builtin_amdgcn_mfma_f32_16x16x32_bf16(af, bf, acc[i], 0, 0, 0);
      }
    }
    const int gc = (o + 1) * 256 + c;
    const float w0 = cw[gc], w1 = cw[768 + gc], w2 = cw[1536 + gc], b = cb[gc];
    const float* zg = ZAT + (size_t)gc * TT + r * 256;
    const float sk = P.in[I_HSKIP][(l * 2 + o) * 256 + c];
    float zn[2][4];
#pragma unroll
    for (int i = 0; i < 2; ++i) {
      const int tq = (w * 2 + i) * 16 + 4 * hq;
#pragma unroll
      for (int e = 0; e < 4; ++e) {
        const float g = short_conv(zg, tq + e, L, w0, w1, w2, b);
        zn[i][e] = g * (acc[i][e] + sk * V[r * 256 + tq + e]);
      }
    }
    __syncthreads();
    if (o == 0) {
#pragma unroll
      for (int i = 0; i < 2; ++i) {
        const int tq = (w * 2 + i) * 16 + 4 * hq;
        *(float4*)(V + r * 256 + tq) = make_float4(zn[i][0], zn[i][1], zn[i][2], zn[i][3]);
        uint2 o2; o2.x = pack2(zn[i][0], zn[i][1]); o2.y = pack2(zn[i][2], zn[i][3]);
        *(uint2*)(Ub + r * 264 + tq) = o2;
      }
      __syncthreads();
    } else {
#pragma unroll
      for (int i = 0; i < 2; ++i) {
        const int tq = (w * 2 + i) * 16 + 4 * hq;
        { uint2 o2; o2.x = pack2(zn[i][0], zn[i][1]); o2.y = pack2(zn[i][2], zn[i][3]); *(uint2*)((bfu*)(P.ws + OFF_YAT) + (size_t)c * TT + r * 256 + tq) = o2; }
      }
    }
  }
}

__device__ __forceinline__ void attn_item(const Params& P, int l, int seq, int g, int qb, char* lds) {
  char* Kl = lds;
  char* Vt = lds + 8192;
  const int tid = tidx(), lane = tid & 63, w = tid >> 6;
  const bool isS = seq >= 16;
  const int b = isS ? seq - 16 : seq;
  const int L = isS ? 4096 : 256;
  const int tok0 = isS ? 4096 + b * 4096 : b * 256;
  const int q0 = qb * 64;
  const int rr = w >> 1, qs = w & 1, ql = lane & 31, h = lane >> 5;
  const int tq = q0 + qs * 32 + ql;
  const int head = g * 4 + rr;
  const float2* RT = (const float2*)(P.ws + OFF_RT);
  bf16x8 qf[4];
  {
    const float* qp = (const float*)(P.ws + OFF_Q) + (size_t)(tok0 + tq) * 512 + head * 64 + 8 * h;
    float qv[4][8];
#pragma unroll
    for (int s = 0; s < 4; ++s) {
      float4 a = *(const float4*)(qp + 16 * s), bq = *(const float4*)(qp + 16 * s + 4);
      qv[s][0] = a.x; qv[s][1] = a.y; qv[s][2] = a.z; qv[s][3] = a.w; qv[s][4] = bq.x; qv[s][5] = bq.y; qv[s][6] = bq.z; qv[s][7] = bq.w;
    }
    if (isS) {
#pragma unroll
      for (int hp = 0; hp < 2; ++hp) {
        const int pos = hp == 0 ? (tq >> 6) : (tq & 63);
#pragma unroll
        for (int j = 0; j < 8; ++j) {
          float2 cs = RT[pos * 16 + 8 * h + j];
          float x1 = qv[2 * hp][j], x2 = qv[2 * hp + 1][j];
          qv[2 * hp][j] = x1 * cs.x - x2 * cs.y;
          qv[2 * hp + 1][j] = x1 * cs.y + x2 * cs.x;
        }
      }
    }
#pragma unroll
    for (int s = 0; s < 4; ++s) {
      union { bf16x8 v; unsigned u[4]; } cv;
#pragma unroll
      for (int j = 0; j < 4; ++j) cv.u[j] = pack2(qv[s][2 * j] * 0.125f, qv[s][2 * j + 1] * 0.125f);
      qf[s] = cv.v;
    }
  }
  float mrun = P.in[I_SINK][l * 8 + head];
  float lsum = h == 0 ? 1.f : 0.f;
  f32x16 oacc[2];
#pragma unroll
  for (int dt = 0; dt < 2; ++dt)
#pragma unroll
    for (int i = 0; i < 16; ++i) oacc[dt][i] = 0.f;

  const int ntile = isS ? 13 : 4;
  const int lk = tid >> 3, lc = tid & 7;
  for (int ti = 0; ti < ntile; ++ti) {
    int kstart = 0; bool win = false;
    const float* kbase; const float* vbase;
    if (!isS) {
      kstart = ti * 64;
      kbase = P.out + OUT_K + ((size_t)(b * 4 + l) * 256 + kstart) * 128 + g * 64;
      vbase = P.out + OUT_V + ((size_t)(b * 4 + l) * 256 + kstart) * 128 + g * 64;
    } else if (ti < 8) {
      kstart = ti * 64;
      kbase = P.in[I_CK] + ((size_t)(b * 4 + l) * 512 + kstart) * 128 + g * 64;
      vbase = P.in[I_CV] + ((size_t)(b * 4 + l) * 512 + kstart) * 128 + g * 64;
    } else {
      kstart = q0 - 128 + (ti - 8) * 64; win = true;
      if (kstart < 0 || kstart >= L) continue;
      kbase = (const float*)(P.ws + OFF_KS) + ((size_t)b * 4096 + kstart) * 128 + g * 64;
      vbase = (const float*)(P.ws + OFF_VS) + ((size_t)b * 4096 + kstart) * 128 + g * 64;
    }
    __syncthreads();
    {
      const float* kp = kbase + (size_t)lk * 128 + lc * 8;
      float4 a = *(const float4*)kp, bq = *(const float4*)(kp + 4);
      float kv[8] = {a.x, a.y, a.z, a.w, bq.x, bq.y, bq.z, bq.w};
      if (win) {
        const float* pp = kbase + (size_t)lk * 128 + (lc ^ 2) * 8;
        float4 pa = *(const float4*)pp, pb = *(const float4*)(pp + 4);
        float pv[8] = {pa.x, pa.y, pa.z, pa.w, pb.x, pb.y, pb.z, pb.w};
        const int kpos = kstart + lk;
        const int pos = lc < 4 ? (kpos >> 6) : (kpos & 63);
#pragma unroll
        for (int j = 0; j < 8; ++j) {
          float2 cs = RT[pos * 16 + (lc & 1) * 8 + j];
          kv[j] = (lc & 2) ? (pv[j] * cs.y + kv[j] * cs.x) : (kv[j] * cs.x - pv[j] * cs.y);
        }
      }
      uint4 o; o.x = pack2(kv[0], kv[1]); o.y = pack2(kv[2], kv[3]); o.z = pack2(kv[4], kv[5]); o.w = pack2(kv[6], kv[7]);
      *(uint4*)(Kl + lk * 128 + ((lc ^ ((lk >> 1) & 7)) << 4)) = o;
      const float* vp = vbase + (size_t)lk * 128 + lc * 8;
      float4 va = *(const float4*)vp, vb = *(const float4*)(vp + 4);
      float vv[8] = {va.x, va.y, va.z, va.w, vb.x, vb.y, vb.z, vb.w};
#pragma unroll
      for (int j = 0; j < 8; ++j) *(bfu*)(Vt + (lc * 8 + j) * 136 + lk * 2) = f2bf(vv[j]);
    }
    __syncthreads();
    f32x16 st[2];
#pragma unroll
    for (int k2 = 0; k2 < 2; ++k2) {
#pragma unroll
      for (int i = 0; i < 16; ++i) st[k2][i] = 0.f;
      const int row = k2 * 32 + ql;
#pragma unroll
      for (int s = 0; s < 4; ++s) {
        bf16x8 a = *(const bf16x8*)(Kl + row * 128 + (((2 * s + h) ^ ((row >> 1) & 7)) << 4));
        st[k2] = __builtin_amdgcn_mfma_f32_32x32x16_bf16(a, qf[s], st[k2], 0, 0, 0);
      }
    }
    if (win) {
#pragma unroll
      for (int k2 = 0; k2 < 2; ++k2)
#pragma unroll
        for (int i = 0; i < 16; ++i) {
          int kpos = kstart + k2 * 32 + (i & 3) + 8 * (i >> 2) + 4 * h;
          int dd = tq - kpos;
          if (dd > 128 || dd < -128) st[k2][i] = -1e30f;
        }
    }
    float mx = -1e30f;
#pragma unroll
    for (int k2 = 0; k2 < 2; ++k2)
#pragma unroll
      for (int i = 0; i < 16; ++i) mx = fmaxf(mx, st[k2][i]);
    mx = fmaxf(mx, __shfl_xor(mx, 32));
    const float mnew = fmaxf(mrun, mx);
    const float alpha = __expf(mrun - mnew);
    mrun = mnew;
    float ps = 0.f;
    bf16x8 pf[2][2];
#pragma unroll
    for (int k2 = 0; k2 < 2; ++k2) {
      float pv[16];
#pragma unroll
      for (int i = 0; i < 16; ++i) { pv[i] = __expf(st[k2][i] - mnew); ps += pv[i]; }
#pragma unroll
      for (int s2 = 0; s2 < 2; ++s2) {
        union { bf16x8 v; unsigned u[4]; } cv;
#pragma unroll
        for (int j = 0; j < 4; ++j) cv.u[j] = pack2(pv[8 * s2 + 2 * j], pv[8 * s2 + 2 * j + 1]);
        pf[k2][s2] = cv.v;
      }
    }
    lsum = lsum * alpha + ps;
#pragma unroll
    for (int dt = 0; dt < 2; ++dt) {
#pragma unroll
      for (int i = 0; i < 16; ++i) oacc[dt][i] *= alpha;
      const char* vrow = Vt + (dt * 32 + ql) * 136;
#pragma unroll
      for (int k2 = 0; k2 < 2; ++k2)
#pragma unroll
        for (int s2 = 0; s2 < 2; ++s2) {
          const int kb = k2 * 32 + 16 * s2 + 4 * h;
          union { bf16x8 v; uint2 u[2]; } av;
          av.u[0] = *(const uint2*)(vrow + kb * 2);
          av.u[1] = *(const uint2*)(vrow + (kb + 8) * 2);
          oacc[dt] = __builtin_amdgcn_mfma_f32_32x32x16_bf16(av.v, pf[k2][s2], oacc[dt], 0, 0, 0);
        }
    }
  }
  const float ltot = lsum + __shfl_xor(lsum, 32);
  const float inv = 1.f / ltot;
  bfu* yo = (bfu*)(P.ws + OFF_YCAT) + (size_t)(tok0 + tq) * 1024 + 512 + head * 64;
#pragma unroll
  for (int dt = 0; dt < 2; ++dt)
#pragma unroll
    for (int q4 = 0; q4 < 4; ++q4) {
      uint2 o; o.x = pack2(oacc[dt][4 * q4] * inv, oacc[dt][4 * q4 + 1] * inv); o.y = pack2(oacc[dt][4 * q4 + 2] * inv, oacc[dt][4 * q4 + 3] * inv);
      *(uint2*)(yo + dt * 32 + 8 * q4 + 4 * h) = o;
    }
  __syncthreads();
}

__device__ __forceinline__ void s5_chunk_info(int ci, bool& isS, int& b, int& ch, int& nch, int& tokbase) {
  isS = ci >= 128;
  if (isS) { b = (ci - 128) >> 7; ch = (ci - 128) & 127; nch = 128; tokbase = 4096 + b * 4096 + ch * 32; }
  else { b = ci >> 3; ch = ci & 7; nch = 8; tokbase = b * 256 + ch * 32; }
}

__device__ __forceinline__ void s5a_item(const Params& P, int l, int ci, char* lds) {
  float* U = (float*)lds;
  bool isS; int b, ch, nch, tokbase; s5_chunk_info(ci, isS, b, ch, nch, tokbase);
  const int tid = tidx(), lane = tid & 63, w = tid >> 6;
  __syncthreads();
  {
    const float4* src = (const float4*)((const float*)(P.ws + OFF_ZB) + (size_t)tokbase * 256);
    for (int i = tid; i < 2048; i += NTHR) ((float4*)U)[i] = src[i];
  }
  __syncthreads();
  const float2* lamb = (const float2*)(P.ws + OFF_LAMB);
  const float2* bbar = (const float2*)(P.ws + OFF_BBAR);
  float2* SE = (float2*)(P.ws + OFF_SE);
#pragma unroll 2
  for (int cb = 0; cb < 4; ++cb) {
    const int g = w * 2 + (cb >> 1), d = cb & 1;
    const int sidx = (d * 16 + g) * 64 + lane;
    float2 Bv[16];
#pragma unroll
    for (int c4 = 0; c4 < 8; ++c4) { float4 t = *(const float4*)(bbar + sidx * 16 + c4 * 2); Bv[2 * c4] = make_float2(t.x, t.y); Bv[2 * c4 + 1] = make_float2(t.z, t.w); }
    const float2 lam = lamb[sidx];
    float2 hs = make_float2(0.f, 0.f);
#pragma unroll 2
    for (int i = 0; i < 32; ++i) {
      const int t = d ? 31 - i : i;
      const float* u = U + t * 256 + g * 16;
      float2 bu = make_float2(0.f, 0.f);
#pragma unroll
      for (int c4 = 0; c4 < 4; ++c4) {
        float4 uv = *(const float4*)(u + 4 * c4);
        bu.x += Bv[4 * c4].x * uv.x + Bv[4 * c4 + 1].x * uv.y + Bv[4 * c4 + 2].x * uv.z + Bv[4 * c4 + 3].x * uv.w;
        bu.y += Bv[4 * c4].y * uv.x + Bv[4 * c4 + 1].y * uv.y + Bv[4 * c4 + 2].y * uv.z + Bv[4 * c4 + 3].y * uv.w;
      }
      float2 t2 = cmul(lam, hs);
      hs = make_float2(t2.x + bu.x, t2.y + bu.y);
    }
    SE[((size_t)ci * 32 + g * 2 + d) * 64 + lane] = hs;
  }
}

__device__ __forceinline__ void s5b_item(const Params& P, int l, int ci2, char* lds) {
  float* U = (float*)lds;
  const int ci = ci2 >> 1, gh = ci2 & 1;
  bool isS; int b, ch, nch, tokbase; s5_chunk_info(ci, isS, b, ch, nch, tokbase);
  const int tid = tidx(), lane = tid & 63, w = tid >> 6;
  float2* Hb = (float2*)(lds + 32768) + w * 1024;
  __syncthreads();
  {
    const float4* src = (const float4*)((const float*)(P.ws + OFF_ZB) + (size_t)tokbase * 256);
    for (int i = tid; i < 1024; i += NTHR) { const int idx = (i >> 5) * 64 + gh * 32 + (i & 31); ((float4*)U)[idx] = src[idx]; }
  }
  __syncthreads();
  const float2* lamb = (const float2*)(P.ws + OFF_LAMB);
  const float2* bbar = (const float2*)(P.ws + OFF_BBAR);
  const float2* SE = (const float2*)(P.ws + OFF_SE);
  const int cbase = ci - ch;
  const int yc = lane & 15, ytq = lane >> 4;
  bfu* YS = (bfu*)(P.ws + OFF_YS5);
#pragma unroll 1
  for (int gi = 0; gi < 1; ++gi) {
    const int g = gh * 8 + w;
    float yacc[2][4];
#pragma unroll
    for (int a = 0; a < 2; ++a)
#pragma unroll
      for (int k = 0; k < 4; ++k) yacc[a][k] = 0.f;
#pragma unroll
    for (int d = 0; d < 2; ++d) {
      const int sidx = (d * 16 + g) * 64 + lane;
      float2 Bv[16];
#pragma unroll
      for (int c4 = 0; c4 < 8; ++c4) { float4 t = *(const float4*)(bbar + sidx * 16 + c4 * 2); Bv[2 * c4] = make_float2(t.x, t.y); Bv[2 * c4 + 1] = make_float2(t.z, t.w); }
      const float2 lam = lamb[sidx];
      float2 hs = ((const float2*)(P.ws + OFF_CAR))[((size_t)ci * 32 + g * 2 + d) * 64 + lane];
      const float* cre = P.in[I_CRE] + ((size_t)((l * 2 + d) * 16 + g) * 16 + yc) * 64;
      const float* cim = P.in[I_CIM] + ((size_t)((l * 2 + d) * 16 + g) * 16 + yc) * 64;
#pragma unroll
      for (int sc = 0; sc < 2; ++sc) {
#pragma unroll 1
        for (int ii = 0; ii < 16; ++ii) {
          const int i = sc * 16 + ii;
          const int t = d ? 31 - i : i;
          const float* u = U + t * 256 + g * 16;
          float2 bu = make_float2(0.f, 0.f);
#pragma unroll
          for (int c4 = 0; c4 < 4; ++c4) {
            float4 uv = *(const float4*)(u + 4 * c4);
            bu.x += Bv[4 * c4].x * uv.x + Bv[4 * c4 + 1].x * uv.y + Bv[4 * c4 + 2].x * uv.z + Bv[4 * c4 + 3].x * uv.w;
            bu.y += Bv[4 * c4].y * uv.x + Bv[4 * c4 + 1].y * uv.y + Bv[4 * c4 + 2].y * uv.z + Bv[4 * c4 + 3].y * uv.w;
          }
          float2 t2 = cmul(lam, hs);
          hs = make_float2(t2.x + bu.x, t2.y + bu.y);
          ((float*)Hb)[ii * 64 + lane] = hs.x; ((float*)Hb)[1024 + ii * 64 + lane] = hs.y;
        }
        __builtin_amdgcn_fence(__ATOMIC_ACQ_REL, "workgroup");
        __builtin_amdgcn_wave_barrier();
        const int sc2 = d ? 1 - sc : sc;
#pragma unroll 4
        for (int pc = 0; pc < 8; ++pc) {
          const v4f ca = *(const v4f*)(cre + pc * 8), cb2 = *(const v4f*)(cre + pc * 8 + 4);
          const v4f ma = *(const v4f*)(cim + pc * 8), mb = *(const v4f*)(cim + pc * 8 + 4);
#pragma unroll
          for (int k = 0; k < 4; ++k) {
            const int tl = ytq * 4 + k;
            const int rowi = d ? 15 - tl : tl;
            const float* hre = (const float*)Hb + rowi * 64 + pc * 8;
            const v4f r0 = *(const v4f*)hre, r1 = *(const v4f*)(hre + 4), i0 = *(const v4f*)(hre + 1024), i1 = *(const v4f*)(hre + 1028);
            v2f ac = ca.xy * r0.xy;
            ac += ca.zw * r0.zw; ac += cb2.xy * r1.xy; ac += cb2.zw * r1.zw;
            ac -= ma.xy * i0.xy; ac -= ma.zw * i0.zw; ac -= mb.xy * i1.xy; ac -= mb.zw * i1.zw;
            yacc[sc2][k] += ac.x + ac.y;
          }
        }
        __builtin_amdgcn_fence(__ATOMIC_ACQ_REL, "workgroup");
        __builtin_amdgcn_wave_barrier();
      }
      if (!isS && ((d == 0 && ch == nch - 1) || (d == 1 && ch == 0))) {
        const int oidx = (((b * 4 + l) * 2 + d) * 16 + g) * 64 + lane;
        P.out[OUT_SRE + oidx] = hs.x; P.out[OUT_SIM + oidx] = hs.y;
      }
    }
    const float sk = P.in[I_S5SKIP][l * 256 + g * 16 + yc];
#pragma unroll
    for (int a = 0; a < 2; ++a)
#pragma unroll
      for (int k = 0; k < 4; ++k) {
        const int t = a * 16 + ytq * 4 + k;
        float y = yacc[a][k] + U[t * 256 + g * 16 + yc] * sk;
        YS[(size_t)(tokbase + t) * 256 + g * 16 + yc] = f2bf(y);
      }
  }
}

__device__ __forceinline__ void s5c_phase(const Params& P, int l, char* lds) {
  const int tid = tidx(), lane = tid & 63, w = tid >> 6;
  const float2* lamb = (const float2*)(P.ws + OFF_LAMB);
  const float2* SE = (const float2*)(P.ws + OFF_SE);
  float2* CAR = (float2*)(P.ws + OFF_CAR);
  float2* TL = (float2*)lds;
  for (int it = bidx(); it < 64; it += gdim()) {
    const int b = it >> 5, gd = it & 31, g = gd >> 1, d = gd & 1;
    const int cbase = 128 + b * 128;
    float2 lam32 = lamb[(d * 16 + g) * 64 + lane];
#pragma unroll
    for (int i = 0; i < 5; ++i) lam32 = cmul(lam32, lam32);
    float2 lam512 = lam32;
#pragma unroll
    for (int i = 0; i < 4; ++i) lam512 = cmul(lam512, lam512);
    float2 ev[16], loc[16];
#pragma unroll
    for (int t = 0; t < 16; ++t) {
      const int jj = w * 16 + t, j = d ? 127 - jj : jj;
      ev[t] = SE[((size_t)(cbase + j) * 32 + gd) * 64 + lane];
    }
    float2 run = make_float2(0.f, 0.f);
#pragma unroll
    for (int t = 0; t < 16; ++t) { loc[t] = run; const float2 t2 = cmul(lam32, run); run = make_float2(t2.x + ev[t].x, t2.y + ev[t].y); }
    __syncthreads();
    TL[w * 64 + lane] = run;
    __syncthreads();
    const int hidx = (((b * 4 + l) * 2 + d) * 16 + g) * 64 + lane;
    float2 st = make_float2(P.in[I_SRE][hidx], P.in[I_SIM][hidx]);
    for (int ww = 0; ww < w; ++ww) { const float2 t2 = cmul(lam512, st); const float2 tt = TL[ww * 64 + lane]; st = make_float2(t2.x + tt.x, t2.y + tt.y); }
#pragma unroll
    for (int t = 0; t < 16; ++t) {
      const int jj = w * 16 + t, j = d ? 127 - jj : jj;
      CAR[((size_t)(cbase + j) * 32 + gd) * 64 + lane] = make_float2(loc[t].x + st.x, loc[t].y + st.y);
      st = cmul(lam32, st);
    }
  }
  const int nb = gdim() > 64 ? gdim() - 64 : gdim(), b0 = gdim() > 64 ? bidx() - 64 : bidx();
  if (b0 >= 0)
  for (int wi = b0 * 8 + w; wi < 16 * 32; wi += nb * 8) {
    const int seq = wi >> 5, gd = wi & 31, g = gd >> 1, d = gd & 1;
    const int cbase = seq * 8;
    float2 lam32 = lamb[(d * 16 + g) * 64 + lane];
#pragma unroll
    for (int i = 0; i < 5; ++i) lam32 = cmul(lam32, lam32);
    float2 hs = make_float2(0.f, 0.f);
#pragma unroll
    for (int jj = 0; jj < 8; ++jj) {
      const int j = d ? 7 - jj : jj;
      const size_t idx = ((size_t)(cbase + j) * 32 + gd) * 64 + lane;
      CAR[idx] = hs;
      float2 e = SE[idx];
      float2 t2 = cmul(lam32, hs);
      hs = make_float2(t2.x + e.x, t2.y + e.y);
    }
  }
}

__device__ __forceinline__ void ya_transpose_items(const Params& P, char* lds) {
  const int tid = tidx();
  const bfu* YAT = (const bfu*)(P.ws + OFF_YAT);
  bfu* YC = (bfu*)(P.ws + OFF_YCAT);
  bfu* tl = (bfu*)lds;
  for (int it = bidx(); it < TT / 64; it += gdim()) {
    const int tok0 = it * 64;
    __syncthreads();
    {
      const int ch = tid >> 1, hf = tid & 1;
      const uint4* src = (const uint4*)(YAT + (size_t)ch * TT + tok0 + hf * 32);
#pragma unroll
      for (int q = 0; q < 4; ++q) {
        const uint4 v = src[q];
        const unsigned ww[4] = {v.x, v.y, v.z, v.w};
#pragma unroll
        for (int j = 0; j < 4; ++j) {
          const int tk = hf * 32 + q * 8 + 2 * j;
          tl[tk * 264 + ch] = (bfu)(ww[j] & 0xffffu);
          tl[(tk + 1) * 264 + ch] = (bfu)(ww[j] >> 16);
        }
      }
    }
    __syncthreads();
    {
      const int tk = tid >> 3, c0 = (tid & 7) * 32;
      const uint4* src = (const uint4*)(tl + tk * 264 + c0);
      uint4* dst = (uint4*)(YC + (size_t)(tok0 + tk) * 1024 + c0);
#pragma unroll
      for (int q = 0; q < 4; ++q) dst[q] = src[q];
    }
  }
  __syncthreads();
}

#define XB_TMO      128
#define XB_XCNT(j)  (256  + 64 * (j))
#define XB_XSUB(j)  (1280 + 64 * (j))
#define XB_XGEN(j)  (2304 + 64 * (j))
#define XB_TOP      3328
#define XB_TOPGEN   3392
#define XCD_BAR_WORDS 3456
#define XB_SPIN_CAP (1u << 18)
#define LAS __attribute__((address_space(3)))

__device__ __forceinline__ unsigned xb_ld(unsigned* p)              { return __hip_atomic_load(p, __ATOMIC_RELAXED, __HIP_MEMORY_SCOPE_AGENT); }
__device__ __forceinline__ unsigned xb_add(unsigned* p, unsigned v) { return __hip_atomic_fetch_add(p, v, __ATOMIC_RELAXED, __HIP_MEMORY_SCOPE_AGENT); }
__device__ __forceinline__ unsigned xb_xcc_id() { return (unsigned)__builtin_amdgcn_s_getreg((3 << 11) | 20) & 0xFu; }
#define XB_SPIN(cond, bar) do { unsigned _sp = 0; while (cond) { __builtin_amdgcn_s_sleep(1); \
    if ((++_sp & 255u) == 0u) { if (xb_ld(&(bar)[XB_TMO])) break; if (_sp > XB_SPIN_CAP) { atomicAdd(&(bar)[XB_TMO], 1u); break; } } } } while (0)

struct XcdBarrier {
    unsigned* bar; unsigned x;
    volatile LAS unsigned* st;
};

__device__ __forceinline__ XcdBarrier xcd_barrier_post(unsigned* bar, volatile LAS unsigned* st) {
    XcdBarrier b; b.bar = bar; b.x = xb_xcc_id(); b.st = st;
    if (tidx() == 0) (void)xb_add(&bar[XB_XCNT(b.x)], 1u);
    return b;
}
__device__ __forceinline__ void xcd_barrier_complete(unsigned* bar, unsigned x, unsigned& nloc, unsigned& nx) {
    const unsigned G = gdim() * gridDim.y * gridDim.z;
    unsigned sum, cnt, mine, sp = 0u;
    for (;;) {
        sum = 0u; cnt = 0u; mine = 0u;
#pragma unroll
        for (unsigned j = 0; j < 16; ++j) { const unsigned c = xb_ld(&bar[XB_XCNT(j)]); sum += c; cnt += (c > 0u) ? 1u : 0u; mine = (j == x) ? c : mine; }
        if (sum == G) break;
        __builtin_amdgcn_s_sleep(1);
        if ((++sp & 255u) == 0u) { if (xb_ld(&bar[XB_TMO])) break; if (sp > XB_SPIN_CAP) { atomicAdd(&bar[XB_TMO], 1u); break; } }
    }
    nloc = mine > 0u ? mine : 1u; nx = cnt > 0u ? cnt : 1u;
}

__device__ __forceinline__ void xcd_barrier(const XcdBarrier& b) {
    asm volatile("s_waitcnt vmcnt(0)" ::: "memory");
    __syncthreads();
    if (tidx() == 0) {
        unsigned* bar = b.bar;
        __builtin_amdgcn_s_waitcnt(0);
        unsigned nloc = b.st[0], nx = b.st[1];
        if (nloc == 0u) { xcd_barrier_complete(bar, b.x, nloc, nx); b.st[0] = nloc; b.st[1] = nx; }
        const unsigned old = xb_add(&bar[XB_XSUB(b.x)], 1u);
        const unsigned gen = old / nloc;
        if (old + 1u == (gen + 1u) * nloc) {
            __builtin_amdgcn_fence(__ATOMIC_RELEASE, "agent");
            asm volatile("s_waitcnt vmcnt(0)" ::: "memory");
            const unsigned og = xb_add(&bar[XB_TOP], 1u);
            const unsigned tg = og / nx;
            if (og + 1u == (tg + 1u) * nx) xb_add(&bar[XB_TOPGEN], 1u);
            else XB_SPIN(xb_ld(&bar[XB_TOPGEN]) == tg, bar);
            __builtin_amdgcn_fence(__ATOMIC_ACQUIRE, "agent");
            xb_add(&bar[XB_XGEN(b.x)], 1u);
            asm volatile("s_waitcnt vmcnt(0)" ::: "memory");
        } else {
            XB_SPIN(xb_ld(&bar[XB_XGEN(b.x)]) == gen, bar);
            __builtin_amdgcn_fence(__ATOMIC_ACQUIRE, "agent");
            asm volatile("s_waitcnt vmcnt(0)" ::: "memory");
        }
    }
    __syncthreads();
}


constexpr int NSP = 11;
#ifdef REP_SP
constexpr int NSPX = NSP + REP_N;
#else
constexpr int NSPX = NSP;
#endif
constexpr int N_PHASES = 1 + 4 * NSPX + 1;

__device__ __forceinline__ void prep_items(const Params& P, int l, int extra_first, char* lds) {
  const int nf = 136;
  if (bidx() == gdim() - 1) s5pre_item(P, l);
  if ((int)gdim() >= nf + 64) {
    if ((int)bidx() < nf) filt_item(P, l, bidx(), lds);
    else conv_stream(P, l, bidx() - nf, gdim() - nf, lds);
  } else {
    for (int it = bidx(); it < nf; it += gdim()) filt_item(P, l, it, lds);
    conv_stream(P, l, bidx(), gdim(), lds);
  }
}

__device__ __forceinline__ void mix1_phase(const Params& P, int l, char* lds) {
  const int total = 256 + 384 + 128;
  for (int it = bidx(); it < total; it += gdim()) {
    int i = it;
    if (i < 256) { hyena_sample_item(P, l, i, lds); continue; }
    i -= 256;
    if (i < 384) { s5a_item(P, l, i, lds); continue; }
    i -= 384;
    attn_item(P, l, i >> 3, (i >> 2) & 1, i & 3, lds);
  }
}
__device__ __forceinline__ void mix2_phase(const Params& P, int l, char* lds) {
  s5c_phase(P, l, lds);
  for (int i = bidx(); i < 256; i += gdim()) attn_item(P, l, 16 + (i >> 7), (i >> 6) & 1, i & 63, lds);
}
__device__ __forceinline__ void mix3_phase(const Params& P, int l, char* lds) {
  const int total = 768 + 256;
  for (int it = bidx(); it < total; it += gdim()) {
    if (it < 768) s5b_item(P, l, it, lds);
    else hyena_prompt_item(P, l, it - 768, lds);
  }
}

__device__ __forceinline__ void run_phase(const Params& P, int ph, char* lds) {
  if (ph == N_PHASES - 1) { final_phase(P); return; }
  if (ph == 0) {
    for (int it = bidx(); it < 385; it += gdim()) { if (it < 384) ada_item(P, it, lds); else tables_item(P); }
    __syncthreads();
  }
  const int l = ph == 0 ? 0 : (ph - 1) / NSPX;
  int sp = ph == 0 ? -1 : (ph - 1) % NSPX;
#ifdef REP_SP
  if (sp > REP_SP) sp = (sp <= REP_SP + REP_N) ? REP_SP : sp - REP_N;
#endif
  if (ph == 0 || (sp == 0 && l > 0)) prep_items(P, l, 0, lds);
  int gmode = -1;
  switch (sp) {
    case 0: norm_phase(P, l, 0); break;
    case 1: gmode = 0; break;
    case 2: mix1_phase(P, l, lds); break;
    case 3: mix2_phase(P, l, lds); break;
    case 4: mix3_phase(P, l, lds); break;
    case 5: glu_phase(P, l, lds); ya_transpose_items(P, lds); break;
    case 6: proj_phase(P, l, lds); break;
    case 7: gmode = 2; break;
    case 8: norm_phase(P, l, 1); break;
    case 9: gmode = 1; break;
    case 10: gmode = 3; break;
    default: break;
  }
  if (gmode >= 0) big_gemm_phase(P, l, gmode, lds);
}

__global__ void __launch_bounds__(NTHR) mk(Params P, int lo, int hi) {
  extern __shared__ __attribute__((aligned(16))) char lds[];
  __shared__ uint4 xb_words;
  cg::grid_group grid = cg::this_grid();
  if (tidx() == 0) xb_words = make_uint4(0u, 0u, 0u, 0u);
  __syncthreads();
  XcdBarrier xb = xcd_barrier_post((unsigned*)(P.ws + OFF_BAR), (volatile LAS unsigned*)&xb_words);
  for (int ph = lo; ph < hi; ++ph) {
    run_phase(P, ph, lds);
    if (ph + 1 < hi) {
      if (P.ws == nullptr) grid.sync();
      xcd_barrier(xb);
    }
  }
}

extern "C" void kernel_launch(void* const* d_in, const int* in_sizes, int n_in, void* d_out, int out_size, void* d_ws, size_t ws_size,
                              hipStream_t stream) {
  static int grid_blocks = 0;
  if (!grid_blocks) {
    int dev = 0, cus = 0, per_cu = 0;
    hipGetDevice(&dev);
    hipDeviceGetAttribute(&cus, hipDeviceAttributeMultiprocessorCount, dev);
    hipFuncSetAttribute((const void*)mk, hipFuncAttributeMaxDynamicSharedMemorySize, LDS_BYTES);
    hipOccupancyMaxActiveBlocksPerMultiprocessor(&per_cu, (const void*)mk, NTHR, LDS_BYTES);
    if (per_cu < 1) per_cu = 1;
    grid_blocks = cus * per_cu;
    if (ws_size < WS_END) fprintf(stderr, "kernel_launch: workspace too small: %zu < %zu\n", ws_size, (size_t)WS_END);
  }
  Params p{};
  for (int i = 0; i < 42; ++i) p.in[i] = (const float*)d_in[i];
  p.out = (float*)d_out; p.ws = (char*)d_ws;
  (void)hipMemsetAsync((char*)d_ws + OFF_BAR, 0, 16384, stream);
#if MULTI_LAUNCH
  for (int ph = 0; ph < N_PHASES; ++ph) {
    int lo = ph, hi = ph + 1;
    hipLaunchKernelGGL(mk, dim3(grid_blocks), dim3(NTHR), LDS_BYTES, stream, p, lo, hi);
  }
#else
  int lo = 0, hi = N_PHASES;
  void* args[] = {&p, &lo, &hi};
  hipError_t e = hipLaunchCooperativeKernel((const void*)mk, dim3(grid_blocks), dim3(NTHR), args, LDS_BYTES, stream);
  if (e != hipSuccess) fprintf(stderr, "cooperative launch failed: %s (grid %d)\n", hipGetErrorString(e), grid_blocks);
#endif
}
```

```cpp
#include <hip/hip_runtime.h>
#include <hip/hip_cooperative_groups.h>
#include <cstdio>
namespace cg = cooperative_groups;

#ifndef MULTI_LAUNCH
#define MULTI_LAUNCH 0
#endif

typedef __attribute__((ext_vector_type(8))) short bf16x8;
typedef __attribute__((ext_vector_type(16))) float f32x16;
typedef unsigned short bfu;
typedef float v2f __attribute__((ext_vector_type(2)));
typedef float v4f __attribute__((ext_vector_type(4)));
typedef __attribute__((ext_vector_type(4))) unsigned u32x4;

constexpr int NTHR = 512;
constexpr int TT = 12288;
constexpr int LDS_BYTES = 131072;

enum { I_XP = 0, I_XS, I_CK, I_CV, I_SRE, I_SIM, I_C, I_CCTX, I_ADAW, I_ADAB, I_N1G, I_WIN, I_HCW, I_HCB, I_HW1, I_HB1, I_HW2, I_HB2,
       I_HW3, I_HFREQ, I_HDEC, I_HSKIP, I_LRE, I_LIM, I_LSTEP, I_BRE, I_BIM, I_CRE, I_CIM, I_S5SKIP, I_GLUW, I_GLUB, I_SINK,
       I_PA, I_PB, I_PC, I_WOUT, I_N2G, I_FG, I_FU, I_FD, I_FNG };

constexpr size_t OUT_YP = 0, OUT_YS = 4194304, OUT_K = 12582912, OUT_V = 14680064, OUT_SRE = 16777216, OUT_SIM = 16908288;

constexpr size_t OFF_WIN  = 0;
constexpr size_t OFF_WP   = OFF_WIN + (size_t)4864 * 1024 * 2;
constexpr size_t OFF_WO   = OFF_WP + (size_t)1024 * 1024 * 2;
constexpr size_t OFF_WGU  = OFF_WO + (size_t)1024 * 1024 * 2;
constexpr size_t OFF_WDN  = OFF_WGU + (size_t)5632 * 1024 * 2;
constexpr size_t OFF_WGLU = OFF_WDN + (size_t)1024 * 2816 * 2;
constexpr size_t OFF_X    = OFF_WGLU + (size_t)512 * 256 * 2;
constexpr size_t OFF_AB   = OFF_X + (size_t)TT * 1024 * 4;
constexpr size_t OFF_ZAT  = OFF_AB + (size_t)TT * 1024 * 2;
constexpr size_t OFF_ZB   = OFF_ZAT + (size_t)768 * TT * 4;
constexpr size_t OFF_Q    = OFF_ZB + (size_t)TT * 256 * 4;
constexpr size_t OFF_KS   = OFF_Q + (size_t)TT * 512 * 4;
constexpr size_t OFF_VS   = OFF_KS + (size_t)8192 * 128 * 4;
constexpr size_t OFF_G    = OFF_VS + (size_t)8192 * 128 * 4;
constexpr size_t OFF_YCAT = OFF_G + (size_t)TT * 3072 * 2;
constexpr size_t OFF_YS5  = OFF_YCAT + (size_t)TT * 1024 * 2;
constexpr size_t OFF_FS   = OFF_YS5 + (size_t)TT * 256 * 2;
constexpr size_t OFF_FP   = OFF_FS + (size_t)1024 * 4096 * 4;
constexpr size_t OFF_MOD  = OFF_FP + (size_t)1024 * 256 * 4;
constexpr size_t OFF_TW   = OFF_MOD + (size_t)4 * 3 * 6144 * 4;
constexpr size_t OFF_RT   = OFF_TW + (size_t)4096 * 8;
constexpr size_t OFF_LAMB = OFF_RT + (size_t)64 * 16 * 8;
constexpr size_t OFF_BBAR = OFF_LAMB + (size_t)2048 * 8;
constexpr size_t OFF_SE   = OFF_BBAR + (size_t)2048 * 16 * 8;
constexpr size_t OFF_CAR  = OFF_SE + (size_t)384 * 32 * 64 * 8;
constexpr size_t OFF_XB   = OFF_CAR + (size_t)384 * 32 * 64 * 8;
constexpr size_t OFF_BAR  = OFF_XB + (size_t)TT * 1024 * 4;
constexpr size_t OFF_YAT  = OFF_BAR + 16384;
constexpr size_t WS_END   = OFF_YAT + (size_t)256 * TT * 2;

struct Params { const float* in[42]; float* out; char* ws; };

__device__ __forceinline__ int bidx() { int b = blockIdx.x; asm volatile("" : "+s"(b)); return b; }
__device__ __forceinline__ int gdim() { int g = gridDim.x; asm volatile("" : "+s"(g)); return g; }
__device__ __forceinline__ int tidx() { int t = threadIdx.x; asm volatile("" : "+v"(t)); return t; }
typedef __bf16 bf16v2 __attribute__((ext_vector_type(2)));
__device__ __forceinline__ unsigned pack2(float a, float b) {
  v2f v = {a, b};
  bf16v2 r = __builtin_convertvector(v, bf16v2);
  return __builtin_bit_cast(unsigned, r);
}
__device__ __forceinline__ bfu f2bf(float f) { return (bfu)(pack2(f, 0.f) & 0xffffu); }
__device__ __forceinline__ float bf2f(bfu v) { return __uint_as_float(((unsigned)v) << 16); }
__device__ __forceinline__ float sigm(float x) { return __builtin_amdgcn_rcpf(1.f + __builtin_amdgcn_exp2f(-1.44269504089f * x)); }
__device__ __forceinline__ float2 cmul(float2 a, float2 b) { return make_float2(a.x * b.x - a.y * b.y, a.x * b.y + a.y * b.x); }
__device__ __forceinline__ int cond_of(int row) { return row < 4096 ? 0 : 1 + ((row - 4096) >> 12); }
__device__ __forceinline__ const float* xrow(const Params& P, int l, int row) {
  if (l > 0) return (const float*)(P.ws + OFF_X) + (size_t)row * 1024;
  return row < 4096 ? P.in[I_XP] + (size_t)row * 1024 : P.in[I_XS] + (size_t)(row - 4096) * 1024;
}

template <int N>
__device__ __forceinline__ void g_load(u32x4 (&rg)[N], const bfu* __restrict__ p, int ld) {
#pragma unroll
  for (int i = 0; i < N; ++i) rg[i] = *(const u32x4*)(p + (size_t)(64 * i) * ld);
}
template <int N>
__device__ __forceinline__ void l_store(const u32x4 (&rg)[N], char* base, int lrow, int lc) {
#pragma unroll
  for (int i = 0; i < N; ++i) { int row = lrow + 64 * i; *(u32x4*)(base + row * 128 + ((lc ^ ((row >> 1) & 7)) << 4)) = rg[i]; }
}
template <int MI>
__device__ __forceinline__ void g_compute(const char* sa, const char* sb, f32x16 (&acc)[MI][2], int wm, int wn, int r, int h) {
#pragma unroll
  for (int s = 0; s < 4; ++s) {
    bf16x8 af[MI], bfr[2];
#pragma unroll
    for (int mi = 0; mi < MI; ++mi) { int row = wm * 32 * MI + mi * 32 + r; af[mi] = *(const bf16x8*)(sa + row * 128 + (((2 * s + h) ^ ((row >> 1) & 7)) << 4)); }
#pragma unroll
    for (int ni = 0; ni < 2; ++ni) { int row = wn * 64 + ni * 32 + r; bfr[ni] = *(const bf16x8*)(sb + row * 128 + (((2 * s + h) ^ ((row >> 1) & 7)) << 4)); }
#pragma unroll
    for (int mi = 0; mi < MI; ++mi)
#pragma unroll
      for (int ni = 0; ni < 2; ++ni) acc[mi][ni] = __builtin_amdgcn_mfma_f32_32x32x16_bf16(af[mi], bfr[ni], acc[mi][ni], 0, 0, 0);
  }
}

template <int MI>
__device__ __forceinline__ void gemm_core(const bfu* __restrict__ A, int lda, const bfu* __restrict__ B, int ldb, int K,
                                          f32x16 (&acc)[MI][2], char* lds) {
  constexpr int BM = 128 * MI;
  constexpr int A_BYTES = BM * 128, B_BYTES = 128 * 128, STAGE = A_BYTES + B_BYTES;
  const int tid = tidx(), lane = tid & 63, w = tid >> 6;
  const int wm = w & 3, wn = w >> 2, r = lane & 31, h = lane >> 5;
  const int lrow = tid >> 3, lc = tid & 7;
  u32x4 a0[2 * MI], b0[2], a1[2 * MI], b1[2];
  const int nk = K >> 6;
  const bfu* Ap = A + (size_t)lrow * lda + lc * 8;
  const bfu* Bp = B + (size_t)lrow * ldb + lc * 8;
  g_load(a0, Ap, lda); g_load(b0, Bp, ldb);
  g_load(a1, Ap + 64, lda); g_load(b1, Bp + 64, ldb);
  l_store(a0, lds, lrow, lc); l_store(b0, lds + A_BYTES, lrow, lc);
  if (nk > 2) { g_load(a0, Ap + 128, lda); g_load(b0, Bp + 128, ldb); }
  __syncthreads();
  for (int kt = 0; kt < nk; kt += 2) {
    g_compute<MI>(lds, lds + A_BYTES, acc, wm, wn, r, h);
    l_store(a1, lds + STAGE, lrow, lc); l_store(b1, lds + STAGE + A_BYTES, lrow, lc);
    if (kt + 3 < nk) { g_load(a1, Ap + (kt + 3) * 64, lda); g_load(b1, Bp + (kt + 3) * 64, ldb); }
    __syncthreads();
    g_compute<MI>(lds + STAGE, lds + STAGE + A_BYTES, acc, wm, wn, r, h);
    if (kt + 2 < nk) { l_store(a0, lds, lrow, lc); l_store(b0, lds + A_BYTES, lrow, lc); }
    if (kt + 4 < nk) { g_load(a0, Ap + (kt + 4) * 64, lda); g_load(b0, Bp + (kt + 4) * 64, ldb); }
    __syncthreads();
  }
}

template <int MI>
__device__ __forceinline__ void zero_acc(f32x16 (&acc)[MI][2]) {
#pragma unroll
  for (int mi = 0; mi < MI; ++mi)
#pragma unroll
    for (int ni = 0; ni < 2; ++ni)
#pragma unroll
      for (int i = 0; i < 16; ++i) acc[mi][ni][i] = 0.f;
}

__device__ __forceinline__ int rowmap(int mode, int n) {
  if (mode == 0) return n;
  if (mode == 1) return ((n >> 4) << 5) + (n & 15);
  if (mode == 2) return ((n >> 4) << 5) + 16 + (n & 15);
  if (n < 256) return ((n >> 5) << 6) + (n & 31);
  n -= 256; return ((n >> 5) << 6) + 32 + (n & 31);
}
constexpr int CONV_TILES = (1216 + 64 + 64 + 128 + 256 + 704 + 704 + 704 + 32) / 2;
struct ConvD { const float* src; bfu* dst; int N, ldd, koff, mode, kt, ntp; };
__device__ __forceinline__ ConvD conv_desc(const Params& P, int l, int t) {
  char* ws = P.ws;
  if (t < 608) return ConvD{P.in[I_WIN] + (size_t)l * 1024 * 4864, (bfu*)(ws + OFF_WIN), 4864, 1024, 0, 0, t / 38, t % 38};
  t -= 608;
  if (t < 32) return ConvD{P.in[I_PA] + (size_t)l * 256 * 1024, (bfu*)(ws + OFF_WP), 1024, 1024, 0, 0, t / 8, t % 8};
  t -= 32;
  if (t < 32) return ConvD{P.in[I_PB] + (size_t)l * 256 * 1024, (bfu*)(ws + OFF_WP), 1024, 1024, 256, 0, t / 8, t % 8};
  t -= 32;
  if (t < 64) return ConvD{P.in[I_PC] + (size_t)l * 512 * 1024, (bfu*)(ws + OFF_WP), 1024, 1024, 512, 0, t / 8, t % 8};
  t -= 64;
  if (t < 128) return ConvD{P.in[I_WOUT] + (size_t)l * 1024 * 1024, (bfu*)(ws + OFF_WO), 1024, 1024, 0, 0, t / 8, t % 8};
  t -= 128;
  if (t < 352) return ConvD{P.in[I_FG] + (size_t)l * 1024 * 2816, (bfu*)(ws + OFF_WGU), 2816, 1024, 0, 1, t / 22, t % 22};
  t -= 352;
  if (t < 352) return ConvD{P.in[I_FU] + (size_t)l * 1024 * 2816, (bfu*)(ws + OFF_WGU), 2816, 1024, 0, 2, t / 22, t % 22};
  t -= 352;
  if (t < 352) return ConvD{P.in[I_FD] + (size_t)l * 2816 * 1024, (bfu*)(ws + OFF_WDN), 1024, 2816, 0, 0, t / 8, t % 8};
  t -= 352;
  return ConvD{P.in[I_GLUW] + (size_t)l * 256 * 512, (bfu*)(ws + OFF_WGLU), 512, 256, 0, 3, t / 4, t % 4};
}
__device__ __forceinline__ void conv_ld(const ConvD& d, int tid, v4f (&r)[4]) {
  const int rr = tid >> 3, c0 = (tid & 7) * 8;
  const float* s0 = d.src + (size_t)(d.kt * 64 + rr) * d.N + d.ntp * 128 + c0;
  r[0] = *(const v4f*)s0; r[1] = *(const v4f*)(s0 + 4); r[2] = *(const v4f*)(s0 + 64); r[3] = *(const v4f*)(s0 + 68);
}
__device__ __forceinline__ void conv_lds_put(int tid, const v4f (&r)[4], float* tl) {
  const int rr = tid >> 3, c0 = (tid & 7) * 8;
  float* t0 = tl + c0 * 65 + rr;
  t0[0] = r[0].x; t0[65] = r[0].y; t0[130] = r[0].z; t0[195] = r[0].w; t0[260] = r[1].x; t0[325] = r[1].y; t0[390] = r[1].z; t0[455] = r[1].w;
  float* t1 = t0 + 64 * 65;
  t1[0] = r[2].x; t1[65] = r[2].y; t1[130] = r[2].z; t1[195] = r[2].w; t1[260] = r[3].x; t1[325] = r[3].y; t1[390] = r[3].z; t1[455] = r[3].w;
}
__device__ __forceinline__ void conv_out(const ConvD& d, int tid, const float* tl) {
#pragma unroll
  for (int hh = 0; hh < 2; ++hh) {
    int n = (tid >> 3) + hh * 64, k0 = (tid & 7) * 8;
    int drow = rowmap(d.mode, d.ntp * 128 + n);
    const float* t = tl + n * 65 + k0;
    uint4 o; o.x = pack2(t[0], t[1]); o.y = pack2(t[2], t[3]); o.z = pack2(t[4], t[5]); o.w = pack2(t[6], t[7]);
    *(uint4*)(d.dst + (size_t)drow * d.ldd + d.koff + d.kt * 64 + k0) = o;
  }
}
__device__ __forceinline__ void conv_stream(const Params& P, int l, int first, int stride, char* lds) {
  float* tl = (float*)lds;
  const int tid = tidx();
  asm volatile("" : "+s"(first), "+s"(stride));
  int it = first;
  v4f r[4];
  ConvD d = conv_desc(P, l, it < CONV_TILES ? it : 0);
  if (it < CONV_TILES) conv_ld(d, tid, r);
  while (it < CONV_TILES) {
    conv_lds_put(tid, r, tl);
    __syncthreads();
    const int nit = it + stride;
    const ConvD nd = conv_desc(P, l, nit < CONV_TILES ? nit : 0);
    if (nit < CONV_TILES) conv_ld(nd, tid, r);
    conv_out(d, tid, tl);
    __syncthreads();
    d = nd; it = nit;
  }
}

__device__ __forceinline__ void ada_item(const Params& P, int item, char* lds) {
  const int l = item / 96, cc = item % 96;
  float* sc = (float*)lds;
  float* red = sc + 3072;
  const int tid = tidx(), lane = tid & 63, w = tid >> 6;
  for (int i = tid; i < 3072; i += NTHR) {
    int cnd = i >> 10, k = i & 1023;
    float v = cnd == 0 ? P.in[I_CCTX][k] : P.in[I_C][(cnd - 1) * 1024 + k];
    sc[i] = v * sigm(v);
  }
  __syncthreads();
  const float* wp = P.in[I_ADAW] + (size_t)l * 1024 * 6144 + cc * 64 + lane;
  float a0 = 0.f, a1 = 0.f, a2 = 0.f;
#pragma unroll 1
  for (int k0 = w * 128; k0 < w * 128 + 128; k0 += 32) {
    float wv[32];
#pragma unroll
    for (int j = 0; j < 32; ++j) wv[j] = __builtin_nontemporal_load(wp + (size_t)(k0 + j) * 6144);
#pragma unroll
    for (int j = 0; j < 32; ++j) { a0 += sc[k0 + j] * wv[j]; a1 += sc[1024 + k0 + j] * wv[j]; a2 += sc[2048 + k0 + j] * wv[j]; }
  }
  red[(w * 3 + 0) * 64 + lane] = a0; red[(w * 3 + 1) * 64 + lane] = a1; red[(w * 3 + 2) * 64 + lane] = a2;
  __syncthreads();
  if (tid < 192) {
    int cnd = tid >> 6, c = tid & 63;
    float s = P.in[I_ADAB][l * 6144 + cc * 64 + c];
#pragma unroll
    for (int ww = 0; ww < 8; ++ww) s += red[(ww * 3 + cnd) * 64 + c];
    ((float*)(P.ws + OFF_MOD))[(l * 3 + cnd) * 6144 + cc * 64 + c] = s;
  }
  __syncthreads();
}

__device__ __forceinline__ void tables_item(const Params& P) {
  float2* tw = (float2*)(P.ws + OFF_TW);
  float2* rt = (float2*)(P.ws + OFF_RT);
  for (int k = tidx(); k < 4096; k += NTHR) { float s, c; sincospif((float)k / 4096.f, &s, &c); tw[k] = make_float2(c, -s); }
  for (int i = tidx(); i < 1024; i += NTHR) {
    int pos = i >> 4, f = i & 15;
    float inv = powf(10000.f, -(float)f / 16.f);
    float ang = (float)pos * inv;
    rt[i] = make_float2(cosf(ang), sinf(ang));
  }
}

__device__ __forceinline__ void filt_item(const Params& P, int l, int item2, char* lds) {
  const int item = item2 >> 1, chalf = item2 & 1;
  const bool isS = item >= 4;
  const int L = isS ? 4096 : 256;
  const int pb = isS ? item - 4 : item;
  float* F = (float*)(P.ws + (isS ? OFF_FS : OFF_FP));
  float* feat = (float*)lds;
  float* h1 = feat + 64 * 33;
  float* h2 = h1 + 64 * 65;
  const int tid = tidx();
  const int pos0 = pb * 64;
  const float tstep = 1.f / (float)(L - 1);
  for (int idx = tid; idx < 64 * 33; idx += NTHR) {
    int p = idx / 33, f = idx % 33;
    int pos = pos0 + p;
    float val;
    if (f == 0) val = (float)pos * tstep;
    else {
      int bi = (f - 1) & 15;
      float fr = (float)bi / 15.f;
      float band = 1e-4f * (1.f - fr) + 15.f * fr;
      float wv = 2.f * 3.14159265358979323846f * (float)pos / (float)L;
      float ang = wv * band;
      val = (f <= 16) ? cosf(ang) : -sinf(ang);
    }
    feat[idx] = val;
  }
  __syncthreads();
  const float* w1 = P.in[I_HW1] + (size_t)l * 33 * 64;
  const float* b1 = P.in[I_HB1] + l * 64;
  const float* w2 = P.in[I_HW2] + (size_t)l * 64 * 64;
  const float* b2 = P.in[I_HB2] + l * 64;
  const float* fq = P.in[I_HFREQ] + l * 64;
  for (int idx = tid; idx < 4096; idx += NTHR) {
    int p = idx >> 6, u = idx & 63;
    float s = b1[u];
    for (int f = 0; f < 33; ++f) s += feat[p * 33 + f] * w1[f * 64 + u];
    h1[p * 65 + u] = sinf(fq[u] * s);
  }
  __syncthreads();
  for (int idx = tid; idx < 4096; idx += NTHR) {
    int p = idx >> 6, u = idx & 63;
    float s = b2[u];
    for (int k = 0; k < 64; ++k) s += h1[p * 65 + k] * w2[k * 64 + u];
    h2[p * 65 + u] = sinf(fq[u] * s);
  }
  __syncthreads();
  const int lane = tid & 63, w = tid >> 6;
  float hr[64];
#pragma unroll
  for (int k = 0; k < 64; ++k) hr[k] = h2[lane * 65 + k];
  const float* w3 = P.in[I_HW3] + (size_t)l * 64 * 1024;
  const float* dec = P.in[I_HDEC] + l * 1024;
  const float tpos = (float)(pos0 + lane) * tstep;
  float* Wl = h2 + 64 * 65;
#pragma unroll 1
  for (int chunk = chalf * 4; chunk < chalf * 4 + 4; ++chunk) {
    __syncthreads();
    for (int i = tid; i < 2048; i += NTHR) {
      int k = i >> 5, c4 = i & 31;
      *(float4*)(Wl + k * 128 + c4 * 4) = *(const float4*)(w3 + k * 1024 + chunk * 128 + c4 * 4);
    }
    __syncthreads();
#pragma unroll 1
    for (int cgp = 0; cgp < 4; ++cgp) {
      const int cl = w * 16 + cgp * 4;
      float a0 = 0.f, a1 = 0.f, a2 = 0.f, a3 = 0.f;
#pragma unroll
      for (int k = 0; k < 64; ++k) {
        float4 wv = *(const float4*)(Wl + k * 128 + cl);
        a0 += hr[k] * wv.x; a1 += hr[k] * wv.y; a2 += hr[k] * wv.z; a3 += hr[k] * wv.w;
      }
      const int col = chunk * 128 + cl;
      F[(size_t)(col + 0) * L + pos0 + lane] = a0 * __expf(-tpos * fabsf(dec[col + 0]));
      F[(size_t)(col + 1) * L + pos0 + lane] = a1 * __expf(-tpos * fabsf(dec[col + 1]));
      F[(size_t)(col + 2) * L + pos0 + lane] = a2 * __expf(-tpos * fabsf(dec[col + 2]));
      F[(size_t)(col + 3) * L + pos0 + lane] = a3 * __expf(-tpos * fabsf(dec[col + 3]));
    }
  }
  __syncthreads();
}

__device__ __forceinline__ void s5pre_item(const Params& P, int l) {
  float2* lamb = (float2*)(P.ws + OFF_LAMB);
  float2* bbar = (float2*)(P.ws + OFF_BBAR);
  for (int idx = tidx(); idx < 2048; idx += NTHR) {
    float lre = P.in[I_LRE][l * 2048 + idx], lim = P.in[I_LIM][l * 2048 + idx];
    float step = expf(P.in[I_LSTEP][l * 32 + (idx >> 6)]);
    float er = expf(lre * step), sn, cs; sincosf(lim * step, &sn, &cs);
    float2 lb = make_float2(er * cs, er * sn);
    lamb[idx] = lb;
    float2 num = make_float2(lb.x - 1.f, lb.y);
    float den = lre * lre + lim * lim;
    float2 coef = make_float2((num.x * lre + num.y * lim) / den, (num.y * lre - num.x * lim) / den);
    const float* br = P.in[I_BRE] + ((size_t)l * 2048 + idx) * 16;
    const float* bi = P.in[I_BIM] + ((size_t)l * 2048 + idx) * 16;
    for (int c = 0; c < 16; ++c) bbar[((((idx >> 6) * 8 + (c >> 1)) * 64 + (idx & 63)) << 1) + (c & 1)] = cmul(coef, make_float2(br[c], bi[c]));
  }
}

__device__ __forceinline__ void norm_phase(const Params& P, int l, int which) {
  const int lane = tidx() & 63, w = tidx() >> 6;
  const float* gam = P.in[which ? I_N2G : I_N1G] + l * 1024;
  bfu* AB = (bfu*)(P.ws + OFF_AB);
  for (int row = bidx() * 8 + w; row < TT; row += gdim() * 8) {
    const float* x = which ? (const float*)(P.ws + OFF_XB) + (size_t)row * 1024 : xrow(P, l, row);
    const float* md = (const float*)(P.ws + OFF_MOD) + (l * 3 + cond_of(row)) * 6144 + which * 3072;
    float4 v[4]; float ss = 0.f;
#pragma unroll
    for (int i = 0; i < 4; ++i) { v[i] = *(const float4*)(x + i * 256 + lane * 4); ss += v[i].x * v[i].x + v[i].y * v[i].y + v[i].z * v[i].z + v[i].w * v[i].w; }
#pragma unroll
    for (int o = 32; o > 0; o >>= 1) ss += __shfl_xor(ss, o);
    float rs = rsqrtf(ss * (1.f / 1024.f) + 1e-6f);
#pragma unroll
    for (int i = 0; i < 4; ++i) {
      int c = i * 256 + lane * 4;
      float4 g = *(const float4*)(gam + c), sh = *(const float4*)(md + c), sc = *(const float4*)(md + 1024 + c);
      float o0 = v[i].x * rs * g.x * (1.f + sc.x) + sh.x, o1 = v[i].y * rs * g.y * (1.f + sc.y) + sh.y;
      float o2 = v[i].z * rs * g.z * (1.f + sc.z) + sh.z, o3 = v[i].w * rs * g.w * (1.f + sc.w) + sh.w;
      uint2 o; o.x = pack2(o0, o1); o.y = pack2(o2, o3);
      *(uint2*)(AB + (size_t)row * 1024 + c) = o;
    }
  }
}
__device__ __forceinline__ void final_phase(const Params& P) {
  const int lane = tidx() & 63, w = tidx() >> 6;
  const float* gam = P.in[I_FNG];
  for (int row = bidx() * 8 + w; row < TT; row += gdim() * 8) {
    const float* x = (const float*)(P.ws + OFF_X) + (size_t)row * 1024;
    float* y = P.out + (size_t)row * 1024;
    float4 v[4]; float ss = 0.f;
#pragma unroll
    for (int i = 0; i < 4; ++i) { v[i] = *(const float4*)(x + i * 256 + lane * 4); ss += v[i].x * v[i].x + v[i].y * v[i].y + v[i].z * v[i].z + v[i].w * v[i].w; }
#pragma unroll
    for (int o = 32; o > 0; o >>= 1) ss += __shfl_xor(ss, o);
    float rs = rsqrtf(ss * (1.f / 1024.f) + 1e-6f);
#pragma unroll
    for (int i = 0; i < 4; ++i) {
      int c = i * 256 + lane * 4;
      float4 g = *(const float4*)(gam + c);
      *(float4*)(y + c) = make_float4(v[i].x * rs * g.x, v[i].y * rs * g.y, v[i].z * rs * g.z, v[i].w * rs * g.w);
    }
  }
}

namespace pg8 {
#define PG8_LAS __attribute__((address_space(3)))
typedef unsigned short bf16_t;
typedef short bf16x8 __attribute__((ext_vector_type(8)));
typedef float f32x4 __attribute__((ext_vector_type(4)));
typedef unsigned u32x4 __attribute__((ext_vector_type(4)));
constexpr int BM = 256, BK = 64, HALF = 128, HTB = HALF * BK * 2  , STAGE_BYTES = 8 * HTB, NXCD = 8, WGM = 8;

__host__ __device__ __forceinline__ int lds_byte(int r, int c) { const int st = (r >> 4) * 2 + (c >> 5), rr = r & 15, cc = c & 31, ob = rr * 64 + cc * 2; return st * 1024 + (ob ^ (((ob >> 9) & 1) << 5)); }
__host__ __device__ __forceinline__ void stage_rc(int b, int& R, int& C) { const int st = b / 1024, sb = b % 1024, swz = sb ^ (((sb >> 9) & 1) << 5); R = (st >> 1) * 16 + swz / 64; C = (st & 1) * 32 + (swz % 64) / 2; }
__host__ __device__ __forceinline__ int perm32(int rho) { const int n = rho >> 4, i = rho & 15; return 8 * (i >> 2) + 4 * n + (i & 3); }

struct Unit { int pm, pn; };
struct Gemm { const bf16_t* A; const bf16_t* Bt; int M, N, K; };

struct StaticOrder {
    int nM, nN, nwg, G, c;
    __host__ __device__ void init(int M, int N, int G_, int c_) { nM = M / BM; nN = N / BM; nwg = nM * nN; G = G_; c = c_; }
    __host__ __device__ bool next(int i, Unit& u) const {
        const long L = (long)i * G + c; if (L >= nwg) return false;
        int wgid = (int)L; { const int q = nwg / NXCD, r = nwg % NXCD, xcd = wgid % NXCD, off = wgid / NXCD; wgid = (xcd < r ? xcd * (q + 1) : r * (q + 1) + (xcd - r) * q) + off; }
        const int nig = WGM * nN, gid = wgid / nig, fm = gid * WGM, gsz = (nM - fm) < WGM ? (nM - fm) : WGM;
        u.pm = fm + ((wgid % nig) % gsz); u.pn = (wgid % nig) / gsz; return true;
    }
    __device__ __forceinline__ void a_ready(const Unit&) const {}
    __device__ __forceinline__ void done(const Unit&) const {}
};
__device__ __forceinline__ unsigned cvt_pk_bf16(float lo, float hi) { unsigned r; asm volatile("v_cvt_pk_bf16_f32 %0, %1, %2" : "=v"(r) : "v"(lo), "v"(hi)); return r; }
template <class Epi, class Sched, bool STAMP = false>
__device__ __forceinline__ void gemm_phase(PG8_LAS unsigned char* lds, const Gemm g, const Sched& S, const Epi& E, unsigned long long* stamps) {
    const int tid = tidx(), wid = __builtin_amdgcn_readfirstlane(tid >> 6), lane = tid & 63, wr = wid >> 2, wc = wid & 3, fr = lane & 15, fq = lane >> 4;
    const int K = g.K, nt = K / BK;
    int ts_lo = 0, ts_hi = 0, nts = 0; const unsigned long long rt_entry = STAMP ? (unsigned long long)wall_clock64() : 0ull;
#define PG8_STAMP() do { if (STAMP && wid == 0 && nts < 64) { const unsigned long long _c = (unsigned long long)clock64(); \
        ts_lo = (lane == nts) ? (int)(unsigned)_c : ts_lo; ts_hi = (lane == nts) ? (int)(unsigned)(_c >> 32) : ts_hi; ++nts; } } while (0)
    PG8_STAMP();
    unsigned voffA[2], voffB[2];
#pragma unroll
    for (int i = 0; i < 2; ++i) { int R, C; stage_rc(tid * 16 + i * 8192, R, C); const int Rb = Epi::PERM ? ((R & ~31) + perm32(R & 31)) : R;
        voffA[i] = (unsigned)(R * K + C) * 2u; voffB[i] = (unsigned)(Rb * K + C) * 2u; }
    const size_t kstep = (size_t)(BK * 2);
    const size_t hstep = (size_t)HALF * K * 2;
    const size_t tstep = 2 * hstep;
    const unsigned ldsw = (unsigned)wid * 1024u;
    const int aoff = lds_byte(wr * 64 + fr, fq * 8), boff = lds_byte(wc * 32 + fr, fq * 8);
#define PG8_SA(b, h) (((b) * 2 + (h)) * HTB)
#define PG8_SB(b, h) ((4 + (b) * 2 + (h)) * HTB)
#define PG8_STAGE(bufoff, gbase, voff) do { _Pragma("unroll") for (int _i = 0; _i < 2; ++_i) \
        __builtin_amdgcn_global_load_lds((const unsigned*)((const char*)(gbase) + (voff)[_i]), (PG8_LAS unsigned*)(lds + (bufoff) + ldsw + _i * 8192), 16, 0, 0); } while (0)
#define PG8_LDA(dst, b, h) do { _Pragma("unroll") for (int m = 0; m < 4; ++m) _Pragma("unroll") for (int k = 0; k < 2; ++k) dst[m][k] = *(const PG8_LAS bf16x8*)(lds + PG8_SA(b, h) + aoff + m * 2048 + k * 1024); } while (0)
#define PG8_LDB(dst, b, h) do { _Pragma("unroll") for (int n = 0; n < 2; ++n) _Pragma("unroll") for (int k = 0; k < 2; ++k) dst[n][k] = *(const PG8_LAS bf16x8*)(lds + PG8_SB(b, h) + boff + n * 2048 + k * 1024); } while (0)
#define PG8_MMA(ai, bj, At, Bt) do { __builtin_amdgcn_s_setprio(1); _Pragma("unroll") for (int m = 0; m < 4; ++m) _Pragma("unroll") for (int n = 0; n < 2; ++n) _Pragma("unroll") for (int k = 0; k < 2; ++k) \
        acc[ai][bj][m][n] = __builtin_amdgcn_mfma_f32_16x16x32_bf16(Bt[n][k], At[m][k], acc[ai][bj][m][n], 0, 0, 0); __builtin_amdgcn_s_setprio(0); } while (0)
#define PG8_WAIT_V(n) asm volatile("s_waitcnt vmcnt(" #n ")" ::: "memory")
#define PG8_WAIT_L(n) asm volatile("s_waitcnt lgkmcnt(" #n ")" ::: "memory")
#define PG8_BAR __builtin_amdgcn_s_barrier()
#define PG8_SCHED __builtin_amdgcn_sched_barrier(0)
    Unit cur, nxt; int ui = 0;
    if (!S.next(0, cur)) return;
    f32x4 acc[2][2][4][2];
#pragma unroll
    for (int a = 0; a < 2; ++a)
#pragma unroll
        for (int b = 0; b < 2; ++b)
#pragma unroll
            for (int m = 0; m < 4; ++m)
#pragma unroll
                for (int n = 0; n < 2; ++n) acc[a][b][m][n] = (f32x4){0.f, 0.f, 0.f, 0.f};
    bf16x8 At[4][2], B0[2][2], B1[2][2];
    const char* cA = (const char*)g.A + (size_t)cur.pm * tstep; const char* cB = (const char*)g.Bt + (size_t)cur.pn * tstep;
    S.a_ready(cur);
    PG8_STAGE(PG8_SB(0, 0), cB, voffB); PG8_STAGE(PG8_SA(0, 0), cA, voffA); PG8_STAGE(PG8_SB(0, 1), cB + hstep, voffB); PG8_STAGE(PG8_SA(0, 1), cA + hstep, voffA);
    if (wr == 1) PG8_BAR;
    PG8_WAIT_V(4); PG8_BAR;
    PG8_STAGE(PG8_SB(1, 0), cB + kstep, voffB); PG8_STAGE(PG8_SA(1, 0), cA + kstep, voffA); PG8_STAGE(PG8_SB(1, 1), cB + hstep + kstep, voffB);
    PG8_WAIT_V(6); PG8_BAR;
    PG8_STAMP();
    for (;;) {
        const bool has_next = S.next(ui + 1, nxt);
        const char* nA = has_next ? (const char*)g.A + (size_t)nxt.pm * tstep : cA; const char* nB = has_next ? (const char*)g.Bt + (size_t)nxt.pn * tstep : cB;
        for (int t = 0; t < nt; t += 2) {
            const bool last = (t == nt - 2);
            const char* a1 = cA + (size_t)(t + 1) * kstep;
            const char* a2 = last ? nA : cA + (size_t)(t + 2) * kstep; const char* b2 = last ? nB : cB + (size_t)(t + 2) * kstep;
            const char* a3 = a2 + kstep; const char* b3 = b2 + kstep;
            if (last && has_next) S.a_ready(nxt);
            PG8_LDB(B0, 0, 0); PG8_SCHED; PG8_LDA(At, 0, 0); PG8_STAGE(PG8_SA(1, 1), a1 + hstep, voffA);
            PG8_WAIT_L(8); PG8_BAR; PG8_WAIT_L(0); PG8_MMA(0, 0, At, B0); PG8_BAR; PG8_SCHED;
            PG8_LDB(B1, 0, 1); PG8_STAGE(PG8_SB(0, 0), b2, voffB);
            PG8_BAR; PG8_WAIT_L(0); PG8_MMA(0, 1, At, B1); PG8_BAR;
            PG8_LDA(At, 0, 1); PG8_STAGE(PG8_SA(0, 0), a2, voffA);
            PG8_BAR; PG8_WAIT_L(0); PG8_MMA(1, 0, At, B0); PG8_BAR; PG8_SCHED;
            PG8_STAGE(PG8_SB(0, 1), b2 + hstep, voffB);
            PG8_WAIT_V(6); PG8_BAR; PG8_MMA(1, 1, At, B1); PG8_BAR;
            PG8_LDB(B0, 1, 0); PG8_SCHED; PG8_LDA(At, 1, 0); PG8_STAGE(PG8_SA(0, 1), a2 + hstep, voffA);
            PG8_WAIT_L(8); PG8_BAR; PG8_WAIT_L(0); PG8_MMA(0, 0, At, B0); PG8_BAR; PG8_SCHED;
            PG8_LDB(B1, 1, 1); PG8_STAGE(PG8_SB(1, 0), b3, voffB);
            PG8_BAR; PG8_WAIT_L(0); PG8_MMA(0, 1, At, B1); PG8_BAR;
            PG8_LDA(At, 1, 1); PG8_STAGE(PG8_SA(1, 0), a3, voffA);
            PG8_BAR; PG8_WAIT_L(0); PG8_MMA(1, 0, At, B0); PG8_BAR; PG8_SCHED;
            PG8_STAGE(PG8_SB(1, 1), b3 + hstep, voffB);
            PG8_WAIT_V(6); PG8_BAR; PG8_MMA(1, 1, At, B1); PG8_BAR;
        }
        PG8_STAMP();
        if constexpr (!Epi::AFTER_DRAIN) { E(acc, cur, wr, wc, fr, fq); S.done(cur); }
        PG8_STAMP();
        if (!has_next) break;
#pragma unroll
        for (int a = 0; a < 2; ++a)
#pragma unroll
            for (int b = 0; b < 2; ++b)
#pragma unroll
                for (int m = 0; m < 4; ++m)
#pragma unroll
                    for (int n = 0; n < 2; ++n) acc[a][b][m][n] = (f32x4){0.f, 0.f, 0.f, 0.f};
        cur = nxt; cA = nA; cB = nB; ++ui;
    }
    PG8_WAIT_V(0);
    if (wr == 0) PG8_BAR;
    PG8_BAR;
    if constexpr (Epi::AFTER_DRAIN) { E.fused(acc, cur, wr, wc, fr, fq, lds, wid, lane); S.done(cur); }
    PG8_STAMP();
    if (STAMP && wid == 0) { stamps[lane] = lane < nts ? (((unsigned long long)(unsigned)ts_hi << 32) | (unsigned)ts_lo) : 0ull;
        if (lane == 62) stamps[62] = rt_entry; if (lane == 63) stamps[63] = (unsigned long long)wall_clock64(); }
#undef PG8_STAMP
#undef PG8_SA
#undef PG8_SB
#undef PG8_STAGE
#undef PG8_LDA
#undef PG8_LDB
#undef PG8_MMA
#undef PG8_WAIT_V
#undef PG8_WAIT_L
#undef PG8_BAR
#undef PG8_SCHED
}
}

struct EpiIn {
  static constexpr bool PERM = false, AFTER_DRAIN = false;
  const Params* Pp; int l;
  __device__ __forceinline__ void operator()(const pg8::f32x4 (&acc)[2][2][4][2], const pg8::Unit& u, int wr, int wc, int fr, int fq) const {
    const Params& P = *Pp;
    const int row0 = u.pm * 256 + wr * 64 + fr;
#pragma unroll
    for (int bj = 0; bj < 2; ++bj) {
      const int colb = u.pn * 256 + bj * 128;
#pragma unroll
      for (int ai = 0; ai < 2; ++ai)
#pragma unroll
        for (int m = 0; m < 4; ++m) {
          const int row = row0 + ai * 128 + m * 16;
#pragma unroll
          for (int n = 0; n < 2; ++n) {
            const int c = colb + wc * 32 + n * 16 + 4 * fq;
            const pg8::f32x4 v = acc[ai][bj][m][n];
            if (colb < 768) {
              float* zt = (float*)(P.ws + OFF_ZAT) + (size_t)c * TT + row;
              zt[0] = v[0]; zt[TT] = v[1]; zt[2 * (size_t)TT] = v[2]; zt[3 * (size_t)TT] = v[3];
            } else if (colb < 1024) *(pg8::f32x4*)((float*)(P.ws + OFF_ZB) + (size_t)row * 256 + c - 768) = v;
            else if (colb < 1536) *(pg8::f32x4*)((float*)(P.ws + OFF_Q) + (size_t)row * 512 + c - 1024) = v;
            else if (colb < 1792) {
              const bool isv = colb >= 1664;
              const int cc = c - (isv ? 1664 : 1536);
              float* dst = row < 4096 ? P.out + (isv ? OUT_V : OUT_K) + ((size_t)((row >> 8) * 4 + l) * 256 + (row & 255)) * 128 + cc
                                      : (float*)(P.ws + (isv ? OFF_VS : OFF_KS)) + (size_t)(row - 4096) * 128 + cc;
              *(pg8::f32x4*)dst = v;
            } else {
              uint2 o; o.x = pack2(sigm(v[0]), sigm(v[1])); o.y = pack2(sigm(v[2]), sigm(v[3]));
              *(uint2*)((bfu*)(P.ws + OFF_G) + (size_t)row * 3072 + c - 1792) = o;
            }
          }
        }
    }
  }
};
struct EpiFfnUp {
  static constexpr bool PERM = false, AFTER_DRAIN = false;
  bfu* HID;
  __device__ __forceinline__ void operator()(const pg8::f32x4 (&acc)[2][2][4][2], const pg8::Unit& u, int wr, int wc, int fr, int fq) const {
    const int row0 = u.pm * 256 + wr * 64 + fr;
#pragma unroll
    for (int ai = 0; ai < 2; ++ai)
#pragma unroll
      for (int m = 0; m < 4; ++m) {
        const int row = row0 + ai * 128 + m * 16;
#pragma unroll
        for (int bj = 0; bj < 2; ++bj) {
          const int hc = u.pn * 128 + bj * 64 + wc * 16 + 4 * fq;
          const pg8::f32x4 g = acc[ai][bj][m][0], up = acc[ai][bj][m][1];
          uint2 o; o.x = pack2(g[0] * sigm(g[0]) * up[0], g[1] * sigm(g[1]) * up[1]); o.y = pack2(g[2] * sigm(g[2]) * up[2], g[3] * sigm(g[3]) * up[3]);
          *(uint2*)(HID + (size_t)row * 2816 + hc) = o;
        }
      }
  }
};
struct EpiResid {
  static constexpr bool PERM = false, AFTER_DRAIN = false;
  const Params* Pp; int l; int which;
  __device__ __forceinline__ void operator()(const pg8::f32x4 (&acc)[2][2][4][2], const pg8::Unit& u, int wr, int wc, int fr, int fq) const {
    const Params& P = *Pp;
    const int row0 = u.pm * 256 + wr * 64 + fr;
    const float* gate = (const float*)(P.ws + OFF_MOD) + (l * 3 + cond_of(u.pm * 256)) * 6144 + (which ? 5120 : 2048);
    float* XA = (float*)(P.ws + OFF_X);
    float* XB = (float*)(P.ws + OFF_XB);
#pragma unroll
    for (int bj = 0; bj < 2; ++bj)
#pragma unroll
      for (int n = 0; n < 2; ++n) {
        const int c = u.pn * 256 + bj * 128 + wc * 32 + n * 16 + 4 * fq;
        const pg8::f32x4 gv = *(const pg8::f32x4*)(gate + c);
#pragma unroll
        for (int ai = 0; ai < 2; ++ai)
#pragma unroll
          for (int m = 0; m < 4; ++m) {
            const int row = row0 + ai * 128 + m * 16;
            const float* xs = which ? XB + (size_t)row * 1024 + c : xrow(P, l, row) + c;
            float* xd = (which ? XA : XB) + (size_t)row * 1024 + c;
            const pg8::f32x4 xin = *(const pg8::f32x4*)xs;
            *(pg8::f32x4*)xd = xin + gv * acc[ai][bj][m][n];
          }
      }
  }
};

struct EpiAll {
  static constexpr bool PERM = false, AFTER_DRAIN = false;
  const Params* Pp; int l; int mode;
  __device__ __forceinline__ void operator()(const pg8::f32x4 (&acc)[2][2][4][2], const pg8::Unit& u, int wr, int wc, int fr, int fq) const {
    if (mode == 0) { EpiIn e{Pp, l}; e(acc, u, wr, wc, fr, fq); }
    else if (mode == 1) { EpiFfnUp e{(bfu*)(Pp->ws + OFF_G)}; e(acc, u, wr, wc, fr, fq); }
    else { EpiResid e{Pp, l, mode - 2}; e(acc, u, wr, wc, fr, fq); }
  }
};
__device__ __forceinline__ void big_gemm_phase(const Params& P, int l, int mode, char* lds) {
  const bfu* A = (const bfu*)(P.ws + (mode == 3 ? OFF_G : OFF_AB));
  const bfu* B = (const bfu*)(P.ws + (mode == 0 ? OFF_WIN : mode == 1 ? OFF_WGU : mode == 2 ? OFF_WO : OFF_WDN));
  const int N = mode == 0 ? 4864 : mode == 1 ? 5632 : 1024;
  const int K = mode == 3 ? 2816 : 1024;
  pg8::Gemm g{A, B, TT, N, K};
  pg8::StaticOrder S; S.init(TT, N, gdim(), bidx());
  EpiAll E{&P, l, mode};
  pg8::gemm_phase<EpiAll, pg8::StaticOrder, false>((PG8_LAS unsigned char*)lds, g, S, E, nullptr);
}

__device__ __forceinline__ int tile_slots(int MT, int NT) { return (MT >> 3) * ((NT + 3) >> 2) * 32; }
__device__ __forceinline__ bool tile_map(int it, int MT, int NT, int& mt, int& nt) {
  int T = it;
  if (gdim() == 256) { const int b = it & 255, j = it >> 8; T = ((j * 8 + (b & 7)) << 5) + (b >> 3); }
  const int patch = T >> 5, ip = T & 31, pmc = MT >> 3;
  mt = (patch % pmc) * 8 + (ip & 7); nt = (patch / pmc) * 4 + (ip >> 3);
  return nt < NT && T < tile_slots(MT, NT);
}
#define TILE_LOOP(MT_, NT_) const int nslots_ = (tile_slots(MT_, NT_) + 255) / 256 * 256; \
  for (int it_ = bidx(); it_ < nslots_; it_ += gdim()) { int mt, nt; if (!tile_map(it_, MT_, NT_, mt, nt)) continue;

#define EPI_ROW(MI_, mi, reg) (wm * 32 * MI_ + (mi) * 32 + ((reg) & 3) + 8 * ((reg) >> 2) + 4 * h)

__device__ __forceinline__ void glu_phase(const Params& P, int l, char* lds) {
  const int tid = tidx(), lane = tid & 63, w = tid >> 6, wm = w & 3, wn = w >> 2, r = lane & 31, h = lane >> 5;
  const bfu* A = (const bfu*)(P.ws + OFF_YS5);
  const bfu* B = (const bfu*)(P.ws + OFF_WGLU);
  const float* bias = P.in[I_GLUB] + l * 512;
  bfu* YC = (bfu*)(P.ws + OFF_YCAT);
  TILE_LOOP(96, 4)
    const int m0 = mt * 128;
    f32x16 acc[1][2]; zero_acc<1>(acc);
    gemm_core<1>(A + (size_t)m0 * 256, 256, B + (size_t)(nt * 128) * 256, 256, 256, acc, lds);
    const int cj = nt * 64 + wn * 32 + r;
    const float ba = bias[cj], bg = bias[256 + cj];
#pragma unroll
    for (int reg = 0; reg < 16; ++reg) {
      const int row = m0 + EPI_ROW(1, 0, reg);
      float a = acc[0][0][reg] + ba, g = acc[0][1][reg] + bg;
      YC[(size_t)row * 1024 + 256 + cj] = f2bf(a * sigm(g));
    }
  }
}

__device__ __forceinline__ void proj_phase(const Params& P, int l, char* lds) {
  const int tid = tidx(), lane = tid & 63, w = tid >> 6, wm = w & 3, wn = w >> 2, r = lane & 31, h = lane >> 5;
  const bfu* A = (const bfu*)(P.ws + OFF_YCAT);
  const bfu* B = (const bfu*)(P.ws + OFF_WP);
  const bfu* G = (const bfu*)(P.ws + OFF_G);
  bfu* AB = (bfu*)(P.ws + OFF_AB);
  TILE_LOOP(96, 8)
    const int m0 = mt * 128, n0 = nt * 128;
    f32x16 mg[1][2]; zero_acc<1>(mg);
#pragma unroll 1
    for (int seg = 0; seg < 3; ++seg) {
      const int koff = seg * 256, klen = seg == 2 ? 512 : 256;
      float gq[2][16];
#pragma unroll
      for (int ni = 0; ni < 2; ++ni) {
        const int col = n0 + wn * 64 + ni * 32 + r;
#pragma unroll
        for (int reg = 0; reg < 16; ++reg) gq[ni][reg] = bf2f(G[(size_t)(m0 + EPI_ROW(1, 0, reg)) * 3072 + seg * 1024 + col]);
      }
      f32x16 acc[1][2]; zero_acc<1>(acc);
      gemm_core<1>(A + (size_t)m0 * 1024 + koff, 1024, B + (size_t)n0 * 1024 + koff, 1024, klen, acc, lds);
#pragma unroll
      for (int ni = 0; ni < 2; ++ni)
#pragma unroll
        for (int reg = 0; reg < 16; ++reg) mg[0][ni][reg] += gq[ni][reg] * acc[0][ni][reg];
    }
#pragma unroll
    for (int ni = 0; ni < 2; ++ni) {
      const int col = n0 + wn * 64 + ni * 32 + r;
#pragma unroll
      for (int reg = 0; reg < 16; ++reg) AB[(size_t)(m0 + EPI_ROW(1, 0, reg)) * 1024 + col] = f2bf(mg[0][ni][reg]);
    }
  }
}

__device__ __forceinline__ float short_conv(const float* __restrict__ z, int t, int L, float w0, float w1, float w2, float b) {
  float s = b + w1 * z[t];
  if (t > 0) s += w0 * z[t - 1];
  if (t < L - 1) s += w2 * z[t + 1];
  return s;
}

#define TWD(k) tw[(k) + ((k) >> 6)]
__device__ __forceinline__ float2 cadd(float2 a, float2 b) { return make_float2(a.x + b.x, a.y + b.y); }
__device__ __forceinline__ float2 csub(float2 a, float2 b) { return make_float2(a.x - b.x, a.y - b.y); }
__device__ __forceinline__ void fft_fwd(float2* data, const float2* tw) {
  const int tid = tidx();
#pragma unroll
  for (int it = 0; it < 8; ++it) {
    int i = tid + it * NTHR;
    float2 a = data[i], b = data[i + 4096], wv = TWD(i);
    data[i] = cadd(a, b);
    data[i + 4096] = cmul(csub(a, b), wv);
  }
  __syncthreads();
#pragma unroll
  for (int s = 11; s >= 3; s -= 2) {
    const int q = 1 << (s - 1);
#pragma unroll
    for (int it = 0; it < 4; ++it) {
      int i = tid + it * NTHR;
      int j = i & (q - 1);
      int base = ((i >> (s - 1)) << (s + 1)) | j;
      float2 x0 = data[base], x1 = data[base + q], x2 = data[base + 2 * q], x3 = data[base + 3 * q];
      float2 w1 = TWD(j << (12 - s)), w2 = TWD(j << (13 - s));
      float2 a0 = cadd(x0, x2), a2 = cmul(csub(x0, x2), w1), a1 = cadd(x1, x3);
      float2 t3 = cmul(csub(x1, x3), w1); float2 a3 = make_float2(t3.y, -t3.x);
      data[base] = cadd(a0, a1); data[base + q] = cmul(csub(a0, a1), w2);
      data[base + 2 * q] = cadd(a2, a3); data[base + 3 * q] = cmul(csub(a2, a3), w2);
    }
    __syncthreads();
  }
#pragma unroll
  for (int it = 0; it < 4; ++it) {
    int i = tid + it * NTHR;
    float4 p0 = *(float4*)(data + 4 * i), p1 = *(float4*)(data + 4 * i + 2);
    float2 x0 = make_float2(p0.x, p0.y), x1 = make_float2(p0.z, p0.w), x2 = make_float2(p1.x, p1.y), x3 = make_float2(p1.z, p1.w);
    float2 a0 = cadd(x0, x2), a2 = csub(x0, x2), a1 = cadd(x1, x3);
    float2 t3 = csub(x1, x3); float2 a3 = make_float2(t3.y, -t3.x);
    float2 y0 = cadd(a0, a1), y1 = csub(a0, a1), y2 = cadd(a2, a3), y3 = csub(a2, a3);
    *(float4*)(data + 4 * i) = make_float4(y0.x, y0.y, y1.x, y1.y);
    *(float4*)(data + 4 * i + 2) = make_float4(y2.x, y2.y, y3.x, y3.y);
  }
  __syncthreads();
}
__device__ __forceinline__ void fft_inv(float2* data, const float2* tw) {
  const int tid = tidx();
#pragma unroll
  for (int it = 0; it < 4; ++it) {
    int i = tid + it * NTHR;
    float4 p0 = *(float4*)(data + 4 * i), p1 = *(float4*)(data + 4 * i + 2);
    float2 x0 = make_float2(p0.x, p0.y), x1 = make_float2(p0.z, p0.w), x2 = make_float2(p1.x, p1.y), x3 = make_float2(p1.z, p1.w);
    float2 a0 = cadd(x0, x1), a1 = csub(x0, x1), a2 = cadd(x2, x3), a3 = csub(x2, x3);
    float2 c3 = make_float2(-a3.y, a3.x);
    float2 y0 = cadd(a0, a2), y2 = csub(a0, a2), y1 = cadd(a1, c3), y3 = csub(a1, c3);
    *(float4*)(data + 4 * i) = make_float4(y0.x, y0.y, y1.x, y1.y);
    *(float4*)(data + 4 * i + 2) = make_float4(y2.x, y2.y, y3.x, y3.y);
  }
  __syncthreads();
#pragma unroll
  for (int s = 2; s <= 10; s += 2) {
    const int q = 1 << s;
#pragma unroll
    for (int it = 0; it < 4; ++it) {
      int i = tid + it * NTHR;
      int j = i & (q - 1);
      int base = ((i >> s) << (s + 2)) | j;
      float2 x0 = data[base], x1 = data[base + q], x2 = data[base + 2 * q], x3 = data[base + 3 * q];
      float2 w1 = TWD(j << (12 - s)), w2 = TWD(j << (11 - s));
      w1.y = -w1.y; w2.y = -w2.y;
      float2 b1 = cmul(x1, w1), b3 = cmul(x3, w1);
      float2 a0 = cadd(x0, b1), a1 = csub(x0, b1), a2 = cadd(x2, b3), a3 = csub(x2, b3);
      float2 c2 = cmul(a2, w2), t3 = cmul(a3, w2); float2 c3 = make_float2(-t3.y, t3.x);
      data[base] = cadd(a0, c2); data[base + 2 * q] = csub(a0, c2);
      data[base + q] = cadd(a1, c3); data[base + 3 * q] = csub(a1, c3);
    }
    __syncthreads();
  }
#pragma unroll
  for (int it = 0; it < 8; ++it) {
    int i = tid + it * NTHR;
    float2 wv = TWD(i); wv.y = -wv.y;
    float2 a = data[i], b = cmul(data[i + 4096], wv);
    data[i] = cadd(a, b);
    data[i + 4096] = csub(a, b);
  }
  __syncthreads();
}
__device__ __forceinline__ float block_sum(float v, float* red) {
  const int lane = tidx() & 63, w = tidx() >> 6;
#pragma unroll
  for (int o = 32; o > 0; o >>= 1) v += __shfl_xor(v, o);
  __syncthreads();
  if (lane == 0) red[w] = v;
  __syncthreads();
  float s = 0.f;
#pragma unroll
  for (int i = 0; i < 8; ++i) s += red[i];
  return s;
}

__device__ __forceinline__ void hyena_sample_item(const Params& P, int l, int c, char* lds) {
  float2* data = (float2*)lds;
  float2* tw = data + 8192;
  __shared__ float red[8];
  const int tid = tidx();
  const int L = 4096;
  const float* FS = (const float*)(P.ws + OFF_FS);
  const float* ZAT = (const float*)(P.ws + OFF_ZAT);
  const float* cw = P.in[I_HCW] + l * 3 * 768;
  const float* cb = P.in[I_HCB] + l * 768;
  {
    const float2* twg = (const float2*)(P.ws + OFF_TW);
    for (int i = tid; i < 4096; i += NTHR) tw[i + (i >> 6)] = twg[i];
  }
  float2 vreg[8];
  float2 KfA[16], KfB[16];
  {
    const float* hf0 = FS + (size_t)(0 * 256 + c) * L; const float* hb0 = FS + (size_t)(1 * 256 + c) * L;
    const float* hf1 = FS + (size_t)(2 * 256 + c) * L; const float* hb1 = FS + (size_t)(3 * 256 + c) * L;
    float as0 = 0.f, as1 = 0.f;
#pragma unroll
    for (int m = 0; m < 16; ++m) {
      int n = tid + m * NTHR;
      float v0 = n < L ? hf0[n] : (n == L ? 0.f : hb0[2 * L - n]);
      float v1 = n < L ? hf1[n] : (n == L ? 0.f : hb1[2 * L - n]);
      as0 += fabsf(v0); as1 += fabsf(v1);
      data[n] = make_float2(v0, v1);
    }
    const float nrm0 = block_sum(as0, red);
    const float nrm1 = block_sum(as1, red);
    fft_fwd(data, tw);
    const float k0s = 0.5f / (nrm0 * 8192.f), k1s = 0.5f / (nrm1 * 8192.f);
#pragma unroll
    for (int m = 0; m < 16; ++m) {
      const int r = tid + m * NTHR;
      const unsigned n = __brev((unsigned)r) >> 19;
      const unsigned rp = __brev(((8192u - n) & 8191u)) >> 19;
      const float2 A = data[r], Bz = data[rp];
      KfA[m] = make_float2((A.x + Bz.x) * k0s, (A.y - Bz.y) * k0s);
      KfB[m] = make_float2((A.y + Bz.y) * k1s, (Bz.x - A.x) * k1s);
    }
    __syncthreads();
  }
#pragma unroll
  for (int o = 0; o < 2; ++o) {
    float2 Kf[16];
#pragma unroll
    for (int m = 0; m < 16; ++m) Kf[m] = o == 0 ? KfA[m] : KfB[m];
    if (o == 0) {
      const float w0 = cw[c], w1 = cw[768 + c], w2 = cw[1536 + c], b = cb[c];
      const float* z0 = ZAT + (size_t)c * TT + 4096;
#pragma unroll
      for (int m = 0; m < 8; ++m) {
        int t = tid + m * NTHR;
        vreg[m] = make_float2(short_conv(z0, t, L, w0, w1, w2, b), short_conv(z0 + 4096, t, L, w0, w1, w2, b));
      }
    }
#pragma unroll
    for (int m = 0; m < 8; ++m) { int t = tid + m * NTHR; data[t] = vreg[m]; data[t + L] = make_float2(0.f, 0.f); }
    __syncthreads();
    fft_fwd(data, tw);
#pragma unroll
    for (int m = 0; m < 16; ++m) { int n = tid + m * NTHR; data[n] = cmul(data[n], Kf[m]); }
    __syncthreads();
    fft_inv(data, tw);
    {
      const int gc = (o + 1) * 256 + c;
      const float w0 = cw[gc], w1 = cw[768 + gc], w2 = cw[1536 + gc], b = cb[gc];
      const float* zg = ZAT + (size_t)gc * TT + 4096;
      const float sk = P.in[I_HSKIP][(l * 2 + o) * 256 + c];
#pragma unroll
      for (int m = 0; m < 8; ++m) {
        int t = tid + m * NTHR;
        float2 y = data[t];
        float g0 = short_conv(zg, t, L, w0, w1, w2, b), g1 = short_conv(zg + 4096, t, L, w0, w1, w2, b);
        vreg[m] = make_float2(g0 * (y.x + sk * vreg[m].x), g1 * (y.y + sk * vreg[m].y));
      }
    }
    __syncthreads();
  }
  bfu* YAT = (bfu*)(P.ws + OFF_YAT);
#pragma unroll
  for (int m = 0; m < 8; ++m) {
    int t = tid + m * NTHR;
    YAT[(size_t)c * TT + 4096 + t] = f2bf(vreg[m].x);
    YAT[(size_t)c * TT + 8192 + t] = f2bf(vreg[m].y);
  }
}

typedef __attribute__((ext_vector_type(4))) float f32x4_t;
__device__ __forceinline__ void hyena_prompt_item(const Params& P, int l, int c, char* lds) {
  float* V = (float*)lds;
  float* KF = V + 4096;
  bfu* Ub = (bfu*)(KF + 1024);
  bfu* Rc = Ub + 16 * 264;
  __shared__ float red[8];
  const int tid = tidx(), lane = tid & 63, w = tid >> 6;
  const int L = 256;
  const float* FP = (const float*)(P.ws + OFF_FP);
  const float* ZAT = (const float*)(P.ws + OFF_ZAT);
  const float* cw = P.in[I_HCW] + l * 3 * 768;
  const float* cb = P.in[I_HCB] + l * 768;
#pragma unroll
  for (int o = 0; o < 2; ++o) {
    const float* hf = FP + (size_t)((o * 2 + 0) * 256 + c) * L;
    const float* hb = FP + (size_t)((o * 2 + 1) * 256 + c) * L;
    int d = tid - 255;
    float v = (tid == 511) ? 0.f : (d >= 0 ? hf[d] : hb[-d]);
    float nrm = block_sum(fabsf(v), red);
    KF[o * 512 + tid] = v / nrm;
  }
  const int seq = tid >> 5, t0 = (tid & 31) * 8;
  {
    const float w0 = cw[c], w1 = cw[768 + c], w2 = cw[1536 + c], b = cb[c];
    const float* z0 = ZAT + (size_t)c * TT + seq * 256;
    float vr[8];
#pragma unroll
    for (int i = 0; i < 8; ++i) { vr[i] = short_conv(z0, t0 + i, L, w0, w1, w2, b); V[seq * 256 + t0 + i] = vr[i]; }
    uint4 o4; o4.x = pack2(vr[0], vr[1]); o4.y = pack2(vr[2], vr[3]); o4.z = pack2(vr[4], vr[5]); o4.w = pack2(vr[6], vr[7]);
    *(uint4*)(Ub + seq * 264 + t0) = o4;
  }
  __syncthreads();
  for (int i = tid; i < 2 * 8 * 528; i += NTHR) {
    const int o = i / (8 * 528), rem = i % (8 * 528), cc = rem / 528, x = rem % 528;
    const int y = 510 - x - cc;
    Rc[i] = (y >= 0 && y <= 510) ? f2bf(KF[o * 512 + y]) : (bfu)0;
  }
  __syncthreads();
  const int r = lane & 15, hq = lane >> 4;
  const int cc = 7 - (r & 7);
  bfu* YC = (bfu*)(P.ws + OFF_YCAT);
#pragma unroll
  for (int o = 0; o < 2; ++o) {
    f32x4_t acc[2];
#pragma unroll
    for (int i = 0; i < 2; ++i) {
      const int tb = w * 2 + i;
      acc[i] = (f32x4_t){0.f, 0.f, 0.f, 0.f};
      const int t = tb * 16 + r;
#pragma unroll
      for (int sb = 0; sb < 8; ++sb) {
        const int sbase = sb * 32 + 8 * hq;
        const int q = 255 - t + sbase;
        const bf16x8 af = *(const bf16x8*)(Rc + (o * 8 + cc) * 528 + (q - cc));
        const bf16x8 bf = *(const bf16x8*)(Ub + r * 264 + sbase);
        acc[i] = __builtin_amdgcn_mfma_f32_16x16x32_bf16(af, bf, acc[i], 0, 0, 0);
      }
    }
    const int gc = (o + 1) * 256 + c;
    const float w0 = cw[gc], w1 = cw[768 + gc], w2 = cw[1536 + gc], b = cb[gc];
    const float* zg = ZAT + (size_t)gc * TT + r * 256;
    const float sk = P.in[I_HSKIP][(l * 2 + o) * 256 + c];
    float zn[2][4];
#pragma unroll
    for (int i = 0; i < 2; ++i) {
      const int tq = (w * 2 + i) * 16 + 4 * hq;
#pragma unroll
      for (int e = 0; e < 4; ++e) {
        const float g = short_conv(zg, tq + e, L, w0, w1, w2, b);
        zn[i][e] = g * (acc[i][e] + sk * V[r * 256 + tq + e]);
      }
    }
    __syncthreads();
    if (o == 0) {
#pragma unroll
      for (int i = 0; i < 2; ++i) {
        const int tq = (w * 2 + i) * 16 + 4 * hq;
        *(float4*)(V + r * 256 + tq) = make_float4(zn[i][0], zn[i][1], zn[i][2], zn[i][3]);
        uint2 o2; o2.x = pack2(zn[i][0], zn[i][1]); o2.y = pack2(zn[i][2], zn[i][3]);
        *(uint2*)(Ub + r * 264 + tq) = o2;
      }
      __syncthreads();
    } else {
#pragma unroll
      for (int i = 0; i < 2; ++i) {
        const int tq = (w * 2 + i) * 16 + 4 * hq;
        { uint2 o2; o2.x = pack2(zn[i][0], zn[i][1]); o2.y = pack2(zn[i][2], zn[i][3]); *(uint2*)((bfu*)(P.ws + OFF_YAT) + (size_t)c * TT + r * 256 + tq) = o2; }
      }
    }
  }
}

__device__ __forceinline__ void attn_item(const Params& P, int l, int seq, int g, int qb, char* lds) {
  char* Kl = lds;
  char* Vt = lds + 8192;
  const int tid = tidx(), lane = tid & 63, w = tid >> 6;
  const bool isS = seq >= 16;
  const int b = isS ? seq - 16 : seq;
  const int L = isS ? 4096 : 256;
  const int tok0 = isS ? 4096 + b * 4096 : b * 256;
  const int q0 = qb * 64;
  const int rr = w >> 1, qs = w & 1, ql = lane & 31, h = lane >> 5;
  const int tq = q0 + qs * 32 + ql;
  const int head = g * 4 + rr;
  const float2* RT = (const float2*)(P.ws + OFF_RT);
  bf16x8 qf[4];
  {
    const float* qp = (const float*)(P.ws + OFF_Q) + (size_t)(tok0 + tq) * 512 + head * 64 + 8 * h;
    float qv[4][8];
#pragma unroll
    for (int s = 0; s < 4; ++s) {
      float4 a = *(const float4*)(qp + 16 * s), bq = *(const float4*)(qp + 16 * s + 4);
      qv[s][0] = a.x; qv[s][1] = a.y; qv[s][2] = a.z; qv[s][3] = a.w; qv[s][4] = bq.x; qv[s][5] = bq.y; qv[s][6] = bq.z; qv[s][7] = bq.w;
    }
    if (isS) {
#pragma unroll
      for (int hp = 0; hp < 2; ++hp) {
        const int pos = hp == 0 ? (tq >> 6) : (tq & 63);
#pragma unroll
        for (int j = 0; j < 8; ++j) {
          float2 cs = RT[pos * 16 + 8 * h + j];
          float x1 = qv[2 * hp][j], x2 = qv[2 * hp + 1][j];
          qv[2 * hp][j] = x1 * cs.x - x2 * cs.y;
          qv[2 * hp + 1][j] = x1 * cs.y + x2 * cs.x;
        }
      }
    }
#pragma unroll
    for (int s = 0; s < 4; ++s) {
      union { bf16x8 v; unsigned u[4]; } cv;
#pragma unroll
      for (int j = 0; j < 4; ++j) cv.u[j] = pack2(qv[s][2 * j] * 0.125f, qv[s][2 * j + 1] * 0.125f);
      qf[s] = cv.v;
    }
  }
  float mrun = P.in[I_SINK][l * 8 + head];
  float lsum = h == 0 ? 1.f : 0.f;
  f32x16 oacc[2];
#pragma unroll
  for (int dt = 0; dt < 2; ++dt)
#pragma unroll
    for (int i = 0; i < 16; ++i) oacc[dt][i] = 0.f;

  const int ntile = isS ? 13 : 4;
  const int lk = tid >> 3, lc = tid & 7;
  for (int ti = 0; ti < ntile; ++ti) {
    int kstart = 0; bool win = false;
    const float* kbase; const float* vbase;
    if (!isS) {
      kstart = ti * 64;
      kbase = P.out + OUT_K + ((size_t)(b * 4 + l) * 256 + kstart) * 128 + g * 64;
      vbase = P.out + OUT_V + ((size_t)(b * 4 + l) * 256 + kstart) * 128 + g * 64;
    } else if (ti < 8) {
      kstart = ti * 64;
      kbase = P.in[I_CK] + ((size_t)(b * 4 + l) * 512 + kstart) * 128 + g * 64;
      vbase = P.in[I_CV] + ((size_t)(b * 4 + l) * 512 + kstart) * 128 + g * 64;
    } else {
      kstart = q0 - 128 + (ti - 8) * 64; win = true;
      if (kstart < 0 || kstart >= L) continue;
      kbase = (const float*)(P.ws + OFF_KS) + ((size_t)b * 4096 + kstart) * 128 + g * 64;
      vbase = (const float*)(P.ws + OFF_VS) + ((size_t)b * 4096 + kstart) * 128 + g * 64;
    }
    __syncthreads();
    {
      const float* kp = kbase + (size_t)lk * 128 + lc * 8;
      float4 a = *(const float4*)kp, bq = *(const float4*)(kp + 4);
      float kv[8] = {a.x, a.y, a.z, a.w, bq.x, bq.y, bq.z, bq.w};
      if (win) {
        const float* pp = kbase + (size_t)lk * 128 + (lc ^ 2) * 8;
        float4 pa = *(const float4*)pp, pb = *(const float4*)(pp + 4);
        float pv[8] = {pa.x, pa.y, pa.z, pa.w, pb.x, pb.y, pb.z, pb.w};
        const int kpos = kstart + lk;
        const int pos = lc < 4 ? (kpos >> 6) : (kpos & 63);
#pragma unroll
        for (int j = 0; j < 8; ++j) {
          float2 cs = RT[pos * 16 + (lc & 1) * 8 + j];
          kv[j] = (lc & 2) ? (pv[j] * cs.y + kv[j] * cs.x) : (kv[j] * cs.x - pv[j] * cs.y);
        }
      }
      uint4 o; o.x = pack2(kv[0], kv[1]); o.y = pack2(kv[2], kv[3]); o.z = pack2(kv[4], kv[5]); o.w = pack2(kv[6], kv[7]);
      *(uint4*)(Kl + lk * 128 + ((lc ^ ((lk >> 1) & 7)) << 4)) = o;
      const float* vp = vbase + (size_t)lk * 128 + lc * 8;
      float4 va = *(const float4*)vp, vb = *(const float4*)(vp + 4);
      float vv[8] = {va.x, va.y, va.z, va.w, vb.x, vb.y, vb.z, vb.w};
#pragma unroll
      for (int j = 0; j < 8; ++j) *(bfu*)(Vt + (lc * 8 + j) * 136 + lk * 2) = f2bf(vv[j]);
    }
    __syncthreads();
    f32x16 st[2];
#pragma unroll
    for (int k2 = 0; k2 < 2; ++k2) {
#pragma unroll
      for (int i = 0; i < 16; ++i) st[k2][i] = 0.f;
      const int row = k2 * 32 + ql;
#pragma unroll
      for (int s = 0; s < 4; ++s) {
        bf16x8 a = *(const bf16x8*)(Kl + row * 128 + (((2 * s + h) ^ ((row >> 1) & 7)) << 4));
        st[k2] = __builtin_amdgcn_mfma_f32_32x32x16_bf16(a, qf[s], st[k2], 0, 0, 0);
      }
    }
    if (win) {
#pragma unroll
      for (int k2 = 0; k2 < 2; ++k2)
#pragma unroll
        for (int i = 0; i < 16; ++i) {
          int kpos = kstart + k2 * 32 + (i & 3) + 8 * (i >> 2) + 4 * h;
          int dd = tq - kpos;
          if (dd > 128 || dd < -128) st[k2][i] = -1e30f;
        }
    }
    float mx = -1e30f;
#pragma unroll
    for (int k2 = 0; k2 < 2; ++k2)
#pragma unroll
      for (int i = 0; i < 16; ++i) mx = fmaxf(mx, st[k2][i]);
    mx = fmaxf(mx, __shfl_xor(mx, 32));
    const float mnew = fmaxf(mrun, mx);
    const float alpha = __expf(mrun - mnew);
    mrun = mnew;
    float ps = 0.f;
    bf16x8 pf[2][2];
#pragma unroll
    for (int k2 = 0; k2 < 2; ++k2) {
      float pv[16];
#pragma unroll
      for (int i = 0; i < 16; ++i) { pv[i] = __expf(st[k2][i] - mnew); ps += pv[i]; }
#pragma unroll
      for (int s2 = 0; s2 < 2; ++s2) {
        union { bf16x8 v; unsigned u[4]; } cv;
#pragma unroll
        for (int j = 0; j < 4; ++j) cv.u[j] = pack2(pv[8 * s2 + 2 * j], pv[8 * s2 + 2 * j + 1]);
        pf[k2][s2] = cv.v;
      }
    }
    lsum = lsum * alpha + ps;
#pragma unroll
    for (int dt = 0; dt < 2; ++dt) {
#pragma unroll
      for (int i = 0; i < 16; ++i) oacc[dt][i] *= alpha;
      const char* vrow = Vt + (dt * 32 + ql) * 136;
#pragma unroll
      for (int k2 = 0; k2 < 2; ++k2)
#pragma unroll
        for (int s2 = 0; s2 < 2; ++s2) {
          const int kb = k2 * 32 + 16 * s2 + 4 * h;
          union { bf16x8 v; uint2 u[2]; } av;
          av.u[0] = *(const uint2*)(vrow + kb * 2);
          av.u[1] = *(const uint2*)(vrow + (kb + 8) * 2);
          oacc[dt] = __builtin_amdgcn_mfma_f32_32x32x16_bf16(av.v, pf[k2][s2], oacc[dt], 0, 0, 0);
        }
    }
  }
  const float ltot = lsum + __shfl_xor(lsum, 32);
  const float inv = 1.f / ltot;
  bfu* yo = (bfu*)(P.ws + OFF_YCAT) + (size_t)(tok0 + tq) * 1024 + 512 + head * 64;
#pragma unroll
  for (int dt = 0; dt < 2; ++dt)
#pragma unroll
    for (int q4 = 0; q4 < 4; ++q4) {
      uint2 o; o.x = pack2(oacc[dt][4 * q4] * inv, oacc[dt][4 * q4 + 1] * inv); o.y = pack2(oacc[dt][4 * q4 + 2] * inv, oacc[dt][4 * q4 + 3] * inv);
      *(uint2*)(yo + dt * 32 + 8 * q4 + 4 * h) = o;
    }
  __syncthreads();
}

__device__ __forceinline__ void s5_chunk_info(int ci, bool& isS, int& b, int& ch, int& nch, int& tokbase) {
  isS = ci >= 128;
  if (isS) { b = (ci - 128) >> 7; ch = (ci - 128) & 127; nch = 128; tokbase = 4096 + b * 4096 + ch * 32; }
  else { b = ci >> 3; ch = ci & 7; nch = 8; tokbase = b * 256 + ch * 32; }
}

__device__ __forceinline__ void s5a_item(const Params& P, int l, int ci, char* lds) {
  float* U = (float*)lds;
  bool isS; int b, ch, nch, tokbase; s5_chunk_info(ci, isS, b, ch, nch, tokbase);
  const int tid = tidx(), lane = tid & 63, w = tid >> 6;
  __syncthreads();
  {
    const float4* src = (const float4*)((const float*)(P.ws + OFF_ZB) + (size_t)tokbase * 256);
    for (int i = tid; i < 2048; i += NTHR) ((float4*)U)[i] = src[i];
  }
  __syncthreads();
  const float2* lamb = (const float2*)(P.ws + OFF_LAMB);
  const float2* bbar = (const float2*)(P.ws + OFF_BBAR);
  float2* SE = (float2*)(P.ws + OFF_SE);
#pragma unroll 2
  for (int cb = 0; cb < 4; ++cb) {
    const int g = w * 2 + (cb >> 1), d = cb & 1;
    const int sidx = (d * 16 + g) * 64 + lane;
    float2 Bv[16];
#pragma unroll
    for (int c4 = 0; c4 < 8; ++c4) { float4 t = *(const float4*)(bbar + ((((sidx >> 6) * 8 + c4) * 64 + (sidx & 63)) << 1)); Bv[2 * c4] = make_float2(t.x, t.y); Bv[2 * c4 + 1] = make_float2(t.z, t.w); }
    const float2 lam = lamb[sidx];
    float2 hs = make_float2(0.f, 0.f);
#pragma unroll 2
    for (int i = 0; i < 32; ++i) {
      const int t = d ? 31 - i : i;
      const float* u = U + t * 256 + g * 16;
      float2 bu = make_float2(0.f, 0.f);
#pragma unroll
      for (int c4 = 0; c4 < 4; ++c4) {
        float4 uv = *(const float4*)(u + 4 * c4);
        bu.x += Bv[4 * c4].x * uv.x + Bv[4 * c4 + 1].x * uv.y + Bv[4 * c4 + 2].x * uv.z + Bv[4 * c4 + 3].x * uv.w;
        bu.y += Bv[4 * c4].y * uv.x + Bv[4 * c4 + 1].y * uv.y + Bv[4 * c4 + 2].y * uv.z + Bv[4 * c4 + 3].y * uv.w;
      }
      float2 t2 = cmul(lam, hs);
      hs = make_float2(t2.x + bu.x, t2.y + bu.y);
    }
    SE[((size_t)ci * 32 + g * 2 + d) * 64 + lane] = hs;
  }
}

__device__ __forceinline__ void s5b_item(const Params& P, int l, int ci2, char* lds) {
  float* U = (float*)lds;
  const int ci = ci2 >> 1, gh = ci2 & 1;
  bool isS; int b, ch, nch, tokbase; s5_chunk_info(ci, isS, b, ch, nch, tokbase);
  const int tid = tidx(), lane = tid & 63, w = tid >> 6;
  float2* Hb = (float2*)(lds + 32768) + w * 1024;
  __syncthreads();
  {
    const float4* src = (const float4*)((const float*)(P.ws + OFF_ZB) + (size_t)tokbase * 256);
    for (int i = tid; i < 1024; i += NTHR) { const int idx = (i >> 5) * 64 + gh * 32 + (i & 31); ((float4*)U)[idx] = src[idx]; }
  }
  __syncthreads();
  const float2* lamb = (const float2*)(P.ws + OFF_LAMB);
  const float2* bbar = (const float2*)(P.ws + OFF_BBAR);
  const float2* SE = (const float2*)(P.ws + OFF_SE);
  const int cbase = ci - ch;
  const int yc = lane & 15, ytq = lane >> 4;
  bfu* YS = (bfu*)(P.ws + OFF_YS5);
#pragma unroll 1
  for (int gi = 0; gi < 1; ++gi) {
    const int g = gh * 8 + w;
    float yacc[2][4];
#pragma unroll
    for (int a = 0; a < 2; ++a)
#pragma unroll
      for (int k = 0; k < 4; ++k) yacc[a][k] = 0.f;
#pragma unroll
    for (int d = 0; d < 2; ++d) {
      const int sidx = (d * 16 + g) * 64 + lane;
      float2 Bv[16];
#pragma unroll
      for (int c4 = 0; c4 < 8; ++c4) { float4 t = *(const float4*)(bbar + ((((sidx >> 6) * 8 + c4) * 64 + (sidx & 63)) << 1)); Bv[2 * c4] = make_float2(t.x, t.y); Bv[2 * c4 + 1] = make_float2(t.z, t.w); }
      const float2 lam = lamb[sidx];
      float2 hs = ((const float2*)(P.ws + OFF_CAR))[((size_t)ci * 32 + g * 2 + d) * 64 + lane];
      const float* cre = P.in[I_CRE] + ((size_t)((l * 2 + d) * 16 + g) * 16 + yc) * 64;
      const float* cim = P.in[I_CIM] + ((size_t)((l * 2 + d) * 16 + g) * 16 + yc) * 64;
#pragma unroll
      for (int sc = 0; sc < 2; ++sc) {
#pragma unroll 1
        for (int ii = 0; ii < 16; ++ii) {
          const int i = sc * 16 + ii;
          const int t = d ? 31 - i : i;
          const float* u = U + t * 256 + g * 16;
          float2 bu = make_float2(0.f, 0.f);
#pragma unroll
          for (int c4 = 0; c4 < 4; ++c4) {
            float4 uv = *(const float4*)(u + 4 * c4);
            bu.x += Bv[4 * c4].x * uv.x + Bv[4 * c4 + 1].x * uv.y + Bv[4 * c4 + 2].x * uv.z + Bv[4 * c4 + 3].x * uv.w;
            bu.y += Bv[4 * c4].y * uv.x + Bv[4 * c4 + 1].y * uv.y + Bv[4 * c4 + 2].y * uv.z + Bv[4 * c4 + 3].y * uv.w;
          }
          float2 t2 = cmul(lam, hs);
          hs = make_float2(t2.x + bu.x, t2.y + bu.y);
          ((float*)Hb)[ii * 64 + lane] = hs.x; ((float*)Hb)[1024 + ii * 64 + lane] = hs.y;
        }
        __builtin_amdgcn_fence(__ATOMIC_ACQ_REL, "workgroup");
        __builtin_amdgcn_wave_barrier();
        const int sc2 = d ? 1 - sc : sc;
#pragma unroll 4
        for (int pc = 0; pc < 8; ++pc) {
          const v4f ca = *(const v4f*)(cre + pc * 8), cb2 = *(const v4f*)(cre + pc * 8 + 4);
          const v4f ma = *(const v4f*)(cim + pc * 8), mb = *(const v4f*)(cim + pc * 8 + 4);
#pragma unroll
          for (int k = 0; k < 4; ++k) {
            const int tl = ytq * 4 + k;
            const int rowi = d ? 15 - tl : tl;
            const float* hre = (const float*)Hb + rowi * 64 + pc * 8;
            const v4f r0 = *(const v4f*)hre, r1 = *(const v4f*)(hre + 4), i0 = *(const v4f*)(hre + 1024), i1 = *(const v4f*)(hre + 1028);
            v2f ac = ca.xy * r0.xy;
            ac += ca.zw * r0.zw; ac += cb2.xy * r1.xy; ac += cb2.zw * r1.zw;
            ac -= ma.xy * i0.xy; ac -= ma.zw * i0.zw; ac -= mb.xy * i1.xy; ac -= mb.zw * i1.zw;
            yacc[sc2][k] += ac.x + ac.y;
          }
        }
        __builtin_amdgcn_fence(__ATOMIC_ACQ_REL, "workgroup");
        __builtin_amdgcn_wave_barrier();
      }
      if (!isS && ((d == 0 && ch == nch - 1) || (d == 1 && ch == 0))) {
        const int oidx = (((b * 4 + l) * 2 + d) * 16 + g) * 64 + lane;
        P.out[OUT_SRE + oidx] = hs.x; P.out[OUT_SIM + oidx] = hs.y;
      }
    }
    const float sk = P.in[I_S5SKIP][l * 256 + g * 16 + yc];
#pragma unroll
    for (int a = 0; a < 2; ++a)
#pragma unroll
      for (int k = 0; k < 4; ++k) {
        const int t = a * 16 + ytq * 4 + k;
        float y = yacc[a][k] + U[t * 256 + g * 16 + yc] * sk;
        YS[(size_t)(tokbase + t) * 256 + g * 16 + yc] = f2bf(y);
      }
  }
}

__device__ __forceinline__ void s5c_phase(const Params& P, int l, char* lds) {
  const int tid = tidx(), lane = tid & 63, w = tid >> 6;
  const float2* lamb = (const float2*)(P.ws + OFF_LAMB);
  const float2* SE = (const float2*)(P.ws + OFF_SE);
  float2* CAR = (float2*)(P.ws + OFF_CAR);
  float2* TL = (float2*)lds;
  for (int it = bidx(); it < 64; it += gdim()) {
    const int b = it >> 5, gd = it & 31, g = gd >> 1, d = gd & 1;
    const int cbase = 128 + b * 128;
    float2 lam32 = lamb[(d * 16 + g) * 64 + lane];
#pragma unroll
    for (int i = 0; i < 5; ++i) lam32 = cmul(lam32, lam32);
    float2 lam512 = lam32;
#pragma unroll
    for (int i = 0; i < 4; ++i) lam512 = cmul(lam512, lam512);
    float2 ev[16], loc[16];
#pragma unroll
    for (int t = 0; t < 16; ++t) {
      const int jj = w * 16 + t, j = d ? 127 - jj : jj;
      ev[t] = SE[((size_t)(cbase + j) * 32 + gd) * 64 + lane];
    }
    float2 run = make_float2(0.f, 0.f);
#pragma unroll
    for (int t = 0; t < 16; ++t) { loc[t] = run; const float2 t2 = cmul(lam32, run); run = make_float2(t2.x + ev[t].x, t2.y + ev[t].y); }
    __syncthreads();
    TL[w * 64 + lane] = run;
    __syncthreads();
    const int hidx = (((b * 4 + l) * 2 + d) * 16 + g) * 64 + lane;
    float2 st = make_float2(P.in[I_SRE][hidx], P.in[I_SIM][hidx]);
    for (int ww = 0; ww < w; ++ww) { const float2 t2 = cmul(lam512, st); const float2 tt = TL[ww * 64 + lane]; st = make_float2(t2.x + tt.x, t2.y + tt.y); }
#pragma unroll
    for (int t = 0; t < 16; ++t) {
      const int jj = w * 16 + t, j = d ? 127 - jj : jj;
      CAR[((size_t)(cbase + j) * 32 + gd) * 64 + lane] = make_float2(loc[t].x + st.x, loc[t].y + st.y);
      st = cmul(lam32, st);
    }
  }
  const int nb = gdim() > 64 ? gdim() - 64 : gdim(), b0 = gdim() > 64 ? bidx() - 64 : bidx();
  if (b0 >= 0)
  for (int wi = b0 * 8 + w; wi < 16 * 32; wi += nb * 8) {
    const int seq = wi >> 5, gd = wi & 31, g = gd >> 1, d = gd & 1;
    const int cbase = seq * 8;
    float2 lam32 = lamb[(d * 16 + g) * 64 + lane];
#pragma unroll
    for (int i = 0; i < 5; ++i) lam32 = cmul(lam32, lam32);
    float2 hs = make_float2(0.f, 0.f);
#pragma unroll
    for (int jj = 0; jj < 8; ++jj) {
      const int j = d ? 7 - jj : jj;
      const size_t idx = ((size_t)(cbase + j) * 32 + gd) * 64 + lane;
      CAR[idx] = hs;
      float2 e = SE[idx];
      float2 t2 = cmul(lam32, hs);
      hs = make_float2(t2.x + e.x, t2.y + e.y);
    }
  }
}

__device__ __forceinline__ void ya_transpose_items(const Params& P, char* lds) {
  const int tid = tidx();
  const bfu* YAT = (const bfu*)(P.ws + OFF_YAT);
  bfu* YC = (bfu*)(P.ws + OFF_YCAT);
  bfu* tl = (bfu*)lds;
  for (int it = bidx(); it < TT / 64; it += gdim()) {
    const int tok0 = it * 64;
    __syncthreads();
    {
      const int ch = tid >> 1, hf = tid & 1;
      const uint4* src = (const uint4*)(YAT + (size_t)ch * TT + tok0 + hf * 32);
#pragma unroll
      for (int q = 0; q < 4; ++q) {
        const uint4 v = src[q];
        const unsigned ww[4] = {v.x, v.y, v.z, v.w};
#pragma unroll
        for (int j = 0; j < 4; ++j) {
          const int tk = hf * 32 + q * 8 + 2 * j;
          tl[tk * 264 + ch] = (bfu)(ww[j] & 0xffffu);
          tl[(tk + 1) * 264 + ch] = (bfu)(ww[j] >> 16);
        }
      }
    }
    __syncthreads();
    {
      const int tk = tid >> 3, c0 = (tid & 7) * 32;
      const uint4* src = (const uint4*)(tl + tk * 264 + c0);
      uint4* dst = (uint4*)(YC + (size_t)(tok0 + tk) * 1024 + c0);
#pragma unroll
      for (int q = 0; q < 4; ++q) dst[q] = src[q];
    }
  }
  __syncthreads();
}

#define XB_TMO      128
#define XB_XCNT(j)  (256  + 64 * (j))
#define XB_XSUB(j)  (1280 + 64 * (j))
#define XB_XGEN(j)  (2304 + 64 * (j))
#define XB_TOP      3328
#define XB_TOPGEN   3392
#define XCD_BAR_WORDS 3456
#define XB_SPIN_CAP (1u << 18)
#define LAS __attribute__((address_space(3)))

__device__ __forceinline__ unsigned xb_ld(unsigned* p)              { return __hip_atomic_load(p, __ATOMIC_RELAXED, __HIP_MEMORY_SCOPE_AGENT); }
__device__ __forceinline__ unsigned xb_add(unsigned* p, unsigned v) { return __hip_atomic_fetch_add(p, v, __ATOMIC_RELAXED, __HIP_MEMORY_SCOPE_AGENT); }
__device__ __forceinline__ unsigned xb_xcc_id() { return (unsigned)__builtin_amdgcn_s_getreg((3 << 11) | 20) & 0xFu; }
#define XB_SPIN(cond, bar) do { unsigned _sp = 0; while (cond) { __builtin_amdgcn_s_sleep(1); \
    if ((++_sp & 255u) == 0u) { if (xb_ld(&(bar)[XB_TMO])) break; if (_sp > XB_SPIN_CAP) { atomicAdd(&(bar)[XB_TMO], 1u); break; } } } } while (0)

struct XcdBarrier {
    unsigned* bar; unsigned x;
    volatile LAS unsigned* st;
};

__device__ __forceinline__ XcdBarrier xcd_barrier_post(unsigned* bar, volatile LAS unsigned* st) {
    XcdBarrier b; b.bar = bar; b.x = xb_xcc_id(); b.st = st;
    if (tidx() == 0) (void)xb_add(&bar[XB_XCNT(b.x)], 1u);
    return b;
}
__device__ __forceinline__ void xcd_barrier_complete(unsigned* bar, unsigned x, unsigned& nloc, unsigned& nx) {
    const unsigned G = gdim() * gridDim.y * gridDim.z;
    unsigned sum, cnt, mine, sp = 0u;
    for (;;) {
        sum = 0u; cnt = 0u; mine = 0u;
#pragma unroll
        for (unsigned j = 0; j < 16; ++j) { const unsigned c = xb_ld(&bar[XB_XCNT(j)]); sum += c; cnt += (c > 0u) ? 1u : 0u; mine = (j == x) ? c : mine; }
        if (sum == G) break;
        __builtin_amdgcn_s_sleep(1);
        if ((++sp & 255u) == 0u) { if (xb_ld(&bar[XB_TMO])) break; if (sp > XB_SPIN_CAP) { atomicAdd(&bar[XB_TMO], 1u); break; } }
    }
    nloc = mine > 0u ? mine : 1u; nx = cnt > 0u ? cnt : 1u;
}

__device__ __forceinline__ void xcd_barrier(const XcdBarrier& b) {
    asm volatile("s_waitcnt vmcnt(0)" ::: "memory");
    __syncthreads();
    if (tidx() == 0) {
        unsigned* bar = b.bar;
        __builtin_amdgcn_s_waitcnt(0);
        unsigned nloc = b.st[0], nx = b.st[1];
        if (nloc == 0u) { xcd_barrier_complete(bar, b.x, nloc, nx); b.st[0] = nloc; b.st[1] = nx; }
        const unsigned old = xb_add(&bar[XB_XSUB(b.x)], 1u);
        const unsigned gen = old / nloc;
        if (old + 1u == (gen + 1u) * nloc) {
            __builtin_amdgcn_fence(__ATOMIC_RELEASE, "agent");
            asm volatile("s_waitcnt vmcnt(0)" ::: "memory");
            const unsigned og = xb_add(&bar[XB_TOP], 1u);
            const unsigned tg = og / nx;
            if (og + 1u == (tg + 1u) * nx) xb_add(&bar[XB_TOPGEN], 1u);
            else XB_SPIN(xb_ld(&bar[XB_TOPGEN]) == tg, bar);
            __builtin_amdgcn_fence(__ATOMIC_ACQUIRE, "agent");
            xb_add(&bar[XB_XGEN(b.x)], 1u);
            asm volatile("s_waitcnt vmcnt(0)" ::: "memory");
        } else {
            XB_SPIN(xb_ld(&bar[XB_XGEN(b.x)]) == gen, bar);
            __builtin_amdgcn_fence(__ATOMIC_ACQUIRE, "agent");
            asm volatile("s_waitcnt vmcnt(0)" ::: "memory");
        }
    }
    __syncthreads();
}


constexpr int NSP = 11;
#ifdef REP_SP
constexpr int NSPX = NSP + REP_N;
#else
constexpr int NSPX = NSP;
#endif
constexpr int N_PHASES = 1 + 4 * NSPX + 1;

__device__ __forceinline__ void prep_items(const Params& P, int l, int extra_first, char* lds) {
  const int nf = 136;
  if (bidx() == gdim() - 1) s5pre_item(P, l);
  if ((int)gdim() >= nf + 64) {
    if ((int)bidx() < nf) filt_item(P, l, bidx(), lds);
    else conv_stream(P, l, bidx() - nf, gdim() - nf, lds);
  } else {
    for (int it = bidx(); it < nf; it += gdim()) filt_item(P, l, it, lds);
    conv_stream(P, l, bidx(), gdim(), lds);
  }
}

__device__ __forceinline__ void mix1_phase(const Params& P, int l, char* lds) {
  const int total = 256 + 384 + 128;
  for (int it = bidx(); it < total; it += gdim()) {
    int i = it;
    if (i < 256) { hyena_sample_item(P, l, i, lds); continue; }
    i -= 256;
    if (i < 384) { s5a_item(P, l, i, lds); continue; }
    i -= 384;
    attn_item(P, l, i >> 3, (i >> 2) & 1, i & 3, lds);
  }
}
__device__ __forceinline__ void mix2_phase(const Params& P, int l, char* lds) {
  s5c_phase(P, l, lds);
  for (int i = bidx(); i < 256; i += gdim()) attn_item(P, l, 16 + (i >> 7), (i >> 6) & 1, i & 63, lds);
}
__device__ __forceinline__ void mix3_phase(const Params& P, int l, char* lds) {
  const int total = 768 + 256;
  for (int it = bidx(); it < total; it += gdim()) {
    if (it < 768) s5b_item(P, l, it, lds);
    else hyena_prompt_item(P, l, it - 768, lds);
  }
}

__device__ __forceinline__ void run_phase(const Params& P, int ph, char* lds) {
  if (ph == N_PHASES - 1) { final_phase(P); return; }
  if (ph == 0) {
    for (int it = bidx(); it < 385; it += gdim()) { if (it < 384) ada_item(P, it, lds); else tables_item(P); }
    __syncthreads();
  }
  const int l = ph == 0 ? 0 : (ph - 1) / NSPX;
  int sp = ph == 0 ? -1 : (ph - 1) % NSPX;
#ifdef REP_SP
  if (sp > REP_SP) sp = (sp <= REP_SP + REP_N) ? REP_SP : sp - REP_N;
#endif
  if (ph == 0 || (sp == 0 && l > 0)) prep_items(P, l, 0, lds);
  int gmode = -1;
  switch (sp) {
    case 0: norm_phase(P, l, 0); break;
    case 1: gmode = 0; break;
    case 2: mix1_phase(P, l, lds); break;
    case 3: mix2_phase(P, l, lds); break;
    case 4: mix3_phase(P, l, lds); break;
    case 5: glu_phase(P, l, lds); ya_transpose_items(P, lds); break;
    case 6: proj_phase(P, l, lds); break;
    case 7: gmode = 2; break;
    case 8: norm_phase(P, l, 1); break;
    case 9: gmode = 1; break;
    case 10: gmode = 3; break;
    default: break;
  }
  if (gmode >= 0) big_gemm_phase(P, l, gmode, lds);
}

__global__ void __launch_bounds__(NTHR) mk(Params P, int lo, int hi) {
  extern __shared__ __attribute__((aligned(16))) char lds[];
  __shared__ uint4 xb_words;
  cg::grid_group grid = cg::this_grid();
  if (tidx() == 0) xb_words = make_uint4(0u, 0u, 0u, 0u);
  __syncthreads();
  XcdBarrier xb = xcd_barrier_post((unsigned*)(P.ws + OFF_BAR), (volatile LAS unsigned*)&xb_words);
  for (int ph = lo; ph < hi; ++ph) {
    run_phase(P, ph, lds);
    if (ph + 1 < hi) {
      if (P.ws == nullptr) grid.sync();
      xcd_barrier(xb);
    }
  }
}

extern "C" void kernel_launch(void* const* d_in, const int* in_sizes, int n_in, void* d_out, int out_size, void* d_ws, size_t ws_size,
                              hipStream_t stream) {
  static int grid_blocks = 0;
  if (!grid_blocks) {
    int dev = 0, cus = 0, per_cu = 0;
    hipGetDevice(&dev);
    hipDeviceGetAttribute(&cus, hipDeviceAttributeMultiprocessorCount, dev);
    hipFuncSetAttribute((const void*)mk, hipFuncAttributeMaxDynamicSharedMemorySize, LDS_BYTES);
    hipOccupancyMaxActiveBlocksPerMultiprocessor(&per_cu, (const void*)mk, NTHR, LDS_BYTES);
    if (per_cu < 1) per_cu = 1;
    grid_blocks = cus * per_cu;
    if (ws_size < WS_END) fprintf(stderr, "kernel_launch: workspace too small: %zu < %zu\n", ws_size, (size_t)WS_END);
  }
  Params p{};
  for (int i = 0; i < 42; ++i) p.in[i] = (const float*)d_in[i];
  p.out = (float*)d_out; p.ws = (char*)d_ws;
  (void)hipMemsetAsync((char*)d_ws + OFF_BAR, 0, 16384, stream);
#if MULTI_LAUNCH
  for (int ph = 0; ph < N_PHASES; ++ph) {
    int lo = ph, hi = ph + 1;
    hipLaunchKernelGGL(mk, dim3(grid_blocks), dim3(NTHR), LDS_BYTES, stream, p, lo, hi);
  }
#else
  int lo = 0, hi = N_PHASES;
  void* args[] = {&p, &lo, &hi};
  hipError_t e = hipLaunchCooperativeKernel((const void*)mk, dim3(grid_blocks), dim3(NTHR), args, LDS_BYTES, stream);
  if (e != hipSuccess) fprintf(stderr, "cooperative launch failed: %s (grid %d)\n", hipGetErrorString(e), grid_blocks);
#endif
}
```
